# Optimizing an MI355X kernel written in HIP

```python
import math
import jax, jax.numpy as jnp
from jax import lax
import numpy as np

D_MODEL = 1024
BATCH = 8
SEQ = 8192
DEPTH = 1
DEC_BATCH = 8
DEC_SEQ = 32
PAST_LEN = 1024

CHUNK = 64
Q_BLOCK = 128
N_HEADS = 8
HEAD_DIM = 64
V_DIM = 2 * HEAD_DIM
ATTN_DIM = N_HEADS * V_DIM
CONV_DIM = D_MODEL
CONV_WIDTH = 3
D_FF = -(-8 * D_MODEL // (3 * 256)) * 256
EPS = 1e-6
IN_SIZES = (N_HEADS * 2 * HEAD_DIM,
            N_HEADS * 2 * HEAD_DIM,
            ATTN_DIM,
            CONV_DIM,
            CONV_DIM,
            CONV_DIM,
            D_MODEL,
            D_MODEL)
IN_COLS = sum(IN_SIZES)
IN_SPLITS = tuple(int(s) for s in np.cumsum(IN_SIZES)[:-1])

kernel_name = "hybrid_diffattn_shortconv_streaming_step"


def _rms_norm(x, g):
    xf = x.astype(jnp.float32)
    y = xf * lax.rsqrt(jnp.mean(xf * xf, axis=-1, keepdims=True) + EPS)
    return (y * g.astype(jnp.float32)).astype(x.dtype)


def _lambda_init(layer_idx):
    return 0.8 - 0.6 * math.exp(-0.3 * layer_idx)


def _diff_core(q, k, v, mask, lam):
    s = jnp.einsum('bqhmd,bkhmd->bhmqk', q, k,
                   preferred_element_type=jnp.float32) * (HEAD_DIM ** -0.5)
    if mask is not None:
        s = jnp.where(mask, s, -jnp.inf)
    p = jax.nn.softmax(s, axis=-1)
    a = p[:, :, 0] - lam * p[:, :, 1]
    return jnp.einsum('bhqk,bkhd->bqhd', a.astype(v.dtype), v)


def _attend_prompt(q, k, v, lam):
    B, S = q.shape[0], q.shape[1]
    nb = S // Q_BLOCK
    qb = q.reshape(B, nb, Q_BLOCK, N_HEADS, 2, HEAD_DIM).swapaxes(0, 1)
    kpos = jnp.arange(S)

    def one(args):
        i, qi = args
        qpos = i * Q_BLOCK + jnp.arange(Q_BLOCK)
        limit = (qpos // CHUNK + 1) * CHUNK
        mask = kpos[None, :] < limit[:, None]
        return _diff_core(qi, k, v, mask, lam)

    out = lax.map(one, (jnp.arange(nb), qb))
    return out.swapaxes(0, 1).reshape(B, S, N_HEADS, V_DIM)


def _short_conv(u, prev, w):
    T = u.shape[1]
    up = jnp.concatenate([prev, u], axis=1)
    y = up[:, 0:T] * w[0]
    for j in range(1, CONV_WIDTH):
        y = y + up[:, j:j + T] * w[j]
    return y, up[:, -(CONV_WIDTH - 1):]


def _layer(x, c, past_k, past_v, conv_prev, lambda_init,
           w_ada, b_ada, norm1_g, norm2_g, w_in, q_norm_g, k_norm_g,
           lambda_q1, lambda_k1, lambda_q2, lambda_k2, sub_norm_g,
           w_attn_out, conv_w, w_conv_out, w_out, w_gate_up, w_down):
    B, T = x.shape[0], x.shape[1]
    mod = (jax.nn.silu(c) @ w_ada + b_ada).reshape(B, 6, 1, D_MODEL)
    shift1, scale1, gate1, shift2, scale2, gate2 = [mod[:, i] for i in range(6)]

    h = _rms_norm(x, norm1_g) * (1 + scale1) + shift1
    proj = h @ w_in
    q, k, v, xin, gb, gc, ga_br, gb_br = jnp.split(proj, IN_SPLITS, axis=-1)

    q = _rms_norm(q.reshape(B, T, N_HEADS, 2, HEAD_DIM), q_norm_g)
    k = _rms_norm(k.reshape(B, T, N_HEADS, 2, HEAD_DIM), k_norm_g)
    v = v.reshape(B, T, N_HEADS, V_DIM)
    lam = (jnp.exp(jnp.sum(lambda_q1.astype(jnp.float32) * lambda_k1.astype(jnp.float32)))
           - jnp.exp(jnp.sum(lambda_q2.astype(jnp.float32) * lambda_k2.astype(jnp.float32)))
           + lambda_init)
    if past_k is None:
        o = _attend_prompt(q, k, v, lam)
    else:
        k_all = jnp.concatenate([past_k, k], axis=1)
        v_all = jnp.concatenate([past_v, v], axis=1)
        o = _diff_core(q, k_all, v_all, None, lam)
    o = _rms_norm(o, sub_norm_g) * (1.0 - lambda_init)
    y_a = o.reshape(B, T, ATTN_DIM) @ w_attn_out

    u = gc * xin
    cv, conv_tail = _short_conv(u, conv_prev, conv_w)
    y_b = (gb * cv) @ w_conv_out

    m = jax.nn.sigmoid(ga_br) * y_a + jax.nn.sigmoid(gb_br) * y_b
    x = x + gate1 * (m @ w_out)

    h2 = _rms_norm(x, norm2_g) * (1 + scale2) + shift2
    g, up = jnp.split(h2 @ w_gate_up, 2, axis=-1)
    x = x + gate2 * ((jax.nn.silu(g) * up) @ w_down)
    return x, k, v, conv_tail


def setup_inputs(seed: int = 0) -> dict:
    key = jax.random.key(seed)
    ks = jax.random.split(key, 28)
    f32 = jnp.float32

    def nrm(k, shape, scale):
        return jax.random.normal(k, shape, f32) * scale

    return {
        "x_prompt": nrm(ks[0], (BATCH, SEQ, D_MODEL), 1.0),
        "x_sample": nrm(ks[1], (DEC_BATCH, DEC_SEQ, D_MODEL), 1.0),
        "cache_k": nrm(ks[2], (DEPTH, DEC_BATCH, PAST_LEN, N_HEADS, 2, HEAD_DIM), 1.0),
        "cache_v": nrm(ks[3], (DEPTH, DEC_BATCH, PAST_LEN, N_HEADS, V_DIM), 1.0),
        "state_conv": nrm(ks[4], (DEPTH, DEC_BATCH, CONV_WIDTH - 1, CONV_DIM), 1.0),
        "c_prompt": nrm(ks[5], (BATCH, D_MODEL), 1.0),
        "c_sample": nrm(ks[6], (DEC_BATCH, D_MODEL), 1.0),
        "w_ada": nrm(ks[7], (DEPTH, D_MODEL, 6 * D_MODEL), 0.5 * D_MODEL ** -0.5),
        "b_ada": nrm(ks[8], (DEPTH, 6 * D_MODEL), 0.02),
        "norm1_g": 1.0 + nrm(ks[9], (DEPTH, D_MODEL), 0.02),
        "norm2_g": 1.0 + nrm(ks[10], (DEPTH, D_MODEL), 0.02),
        "w_in": nrm(ks[11], (DEPTH, D_MODEL, IN_COLS), D_MODEL ** -0.5),
        "q_norm_g": 1.0 + nrm(ks[12], (DEPTH, HEAD_DIM), 0.02),
        "k_norm_g": 1.0 + nrm(ks[13], (DEPTH, HEAD_DIM), 0.02),
        "lambda_q1": nrm(ks[14], (DEPTH, HEAD_DIM), 0.1),
        "lambda_k1": nrm(ks[15], (DEPTH, HEAD_DIM), 0.1),
        "lambda_q2": nrm(ks[16], (DEPTH, HEAD_DIM), 0.1),
        "lambda_k2": nrm(ks[17], (DEPTH, HEAD_DIM), 0.1),
        "sub_norm_g": 1.0 + nrm(ks[18], (DEPTH, V_DIM), 0.02),
        "w_attn_out": nrm(ks[19], (DEPTH, ATTN_DIM, D_MODEL), ATTN_DIM ** -0.5),
        "conv_w": nrm(ks[20], (DEPTH, CONV_WIDTH, CONV_DIM), CONV_WIDTH ** -0.5),
        "w_conv_out": nrm(ks[21], (DEPTH, CONV_DIM, D_MODEL), CONV_DIM ** -0.5),
        "w_out": nrm(ks[22], (DEPTH, D_MODEL, D_MODEL), D_MODEL ** -0.5),
        "w_gate_up": nrm(ks[23], (DEPTH, D_MODEL, 2 * D_FF), D_MODEL ** -0.5),
        "w_down": nrm(ks[24], (DEPTH, D_FF, D_MODEL), D_FF ** -0.5),
    }


def reference(x_prompt, x_sample, cache_k, cache_v, state_conv, c_prompt, c_sample,
              w_ada, b_ada, norm1_g, norm2_g, w_in, q_norm_g, k_norm_g,
              lambda_q1, lambda_k1, lambda_q2, lambda_k2, sub_norm_g,
              w_attn_out, conv_w, w_conv_out, w_out, w_gate_up, w_down):
    xp, xs = x_prompt, x_sample
    kp_l, vp_l, cp_l, ksl, vsl, csl = [], [], [], [], [], []
    for l in range(DEPTH):
        lam0 = _lambda_init(l)
        wl = (w_ada[l], b_ada[l], norm1_g[l], norm2_g[l], w_in[l], q_norm_g[l], k_norm_g[l],
              lambda_q1[l], lambda_k1[l], lambda_q2[l], lambda_k2[l], sub_norm_g[l],
              w_attn_out[l], conv_w[l], w_conv_out[l], w_out[l], w_gate_up[l], w_down[l])
        zeros_prev = jnp.zeros((xp.shape[0], CONV_WIDTH - 1, CONV_DIM), xp.dtype)
        xp, kp, vp, cp = _layer(xp, c_prompt, None, None, zeros_prev, lam0, *wl)
        xs, ksn, vsn, csn = _layer(xs, c_sample, cache_k[l], cache_v[l], state_conv[l], lam0, *wl)
        kp_l.append(kp); vp_l.append(vp); cp_l.append(cp)
        ksl.append(ksn); vsl.append(vsn); csl.append(csn)
    k_prompt = jnp.stack(kp_l)
    v_prompt = jnp.stack(vp_l)
    conv_prompt = jnp.stack(cp_l)
    k_sample = jnp.stack(ksl)
    v_sample = jnp.stack(vsl)
    conv_sample = jnp.stack(csl)
    return (xp, xs, k_prompt, v_prompt, conv_prompt, k_sample, v_sample, conv_sample)
```

```cpp
#include <hip/hip_runtime.h>
#include <cstdio>
#include <cstdint>
namespace pg8 {
#define PG8_LAS __attribute__((address_space(3)))
typedef unsigned short bf16_t;
typedef short bf16x8 __attribute__((ext_vector_type(8)));
typedef float f32x4 __attribute__((ext_vector_type(4)));
typedef unsigned u32x4 __attribute__((ext_vector_type(4)));
constexpr int BM = 256, BK = 64, HALF = 128, HTB = HALF * BK * 2  , STAGE_BYTES = 8 * HTB, NXCD = 8, WGM = 8;

__host__ __device__ __forceinline__ int lds_byte(int r, int c) { const int st = (r >> 4) * 2 + (c >> 5), rr = r & 15, cc = c & 31, ob = rr * 64 + cc * 2; return st * 1024 + (ob ^ (((ob >> 9) & 1) << 5)); }
__host__ __device__ __forceinline__ void stage_rc(int b, int& R, int& C) { const int st = b / 1024, sb = b % 1024, swz = sb ^ (((sb >> 9) & 1) << 5); R = (st >> 1) * 16 + swz / 64; C = (st & 1) * 32 + (swz % 64) / 2; }
__host__ __device__ __forceinline__ int perm32(int rho) { const int n = rho >> 4, i = rho & 15; return 8 * (i >> 2) + 4 * n + (i & 3); }

struct Unit { int pm, pn, seg; };
struct Gemm { const bf16_t* A; const bf16_t* Bt; int M, N, K; const bf16_t* A2; const bf16_t* Bt2; };

struct StaticOrder {
    int nM, nN, nwg, G, c;
    __host__ __device__ void init(int M, int N, int G_, int c_) { nM = M / BM; nN = N / BM; nwg = nM * nN; G = G_; c = c_; }
    __host__ __device__ bool next(int i, Unit& u) const {
        const long L = (long)i * G + c; if (L >= nwg) return false;
        int wgid = (int)L; { const int q = nwg / NXCD, r = nwg % NXCD, xcd = wgid % NXCD, off = wgid / NXCD; wgid = (xcd < r ? xcd * (q + 1) : r * (q + 1) + (xcd - r) * q) + off; }
        const int nig = WGM * nN, gid = wgid / nig, fm = gid * WGM, gsz = (nM - fm) < WGM ? (nM - fm) : WGM;
        u.pm = fm + ((wgid % nig) % gsz); u.pn = (wgid % nig) / gsz; u.seg = 0; return true;
    }
    __device__ __forceinline__ void a_ready(const Unit&) const {}
    __device__ __forceinline__ void done(const Unit&) const {}
};

__device__ __forceinline__ unsigned cvt_pk_bf16(float lo, float hi) { unsigned r; asm volatile("v_cvt_pk_bf16_f32 %0, %1, %2" : "=v"(r) : "v"(lo), "v"(hi)); return r; }
typedef float f32x2 __attribute__((ext_vector_type(2)));
constexpr int MP = 65536, MS = 256, MT = MP + MS;
constexpr size_t O_Y = 0, O_KP = (size_t)MT * 1024, O_VP = O_KP + (size_t)MP * 1024, O_CP = O_VP + (size_t)MP * 1024, O_KS = O_CP + 16384, O_VS = O_KS + (size_t)MS * 1024, O_CS = O_VS + (size_t)MS * 1024, O_END = O_CS + 16384;
constexpr float QK_C2 = 0.125f * 1.4426950408889634f;
constexpr float RMS_EPS = 1e-6f;
__device__ __forceinline__ float bf_lo(unsigned w) { return __uint_as_float(w << 16); }
__device__ __forceinline__ float bf_hi(unsigned w) { return __uint_as_float(w & 0xffff0000u); }
__device__ __forceinline__ float sigm(float x) { return __builtin_amdgcn_rcpf(1.0f + __builtin_amdgcn_exp2f(-1.4426950408889634f * x)); }
__device__ __forceinline__ u32x4 pack8(f32x4 a, f32x4 b) { u32x4 w; w.x = cvt_pk_bf16(a[0], a[1]); w.y = cvt_pk_bf16(a[2], a[3]); w.z = cvt_pk_bf16(b[0], b[1]); w.w = cvt_pk_bf16(b[2], b[3]); return w; }

struct EpiInProj {
    static constexpr bool PERM = true, AFTER_DRAIN = false, PAIRED = false;
    bf16_t *Q, *Kb, *Vb, *U, *GB, *GA2, *GB2; float* out; const float *qg, *kg;
    __device__ __forceinline__ void operator()(const f32x4 (&acc)[2][2][4][2], const Unit& u, int wr, int wc, int fr, int fq) const {
        const int pn = u.pn, pm = u.pm; const bool smp = pm >= (MP / BM);
        const int row0 = pm * BM + wr * 64 + fr;
        if (pn >= 12 && pn < 20) {
            const int col = 128 * (pn - 12) + 32 * wc + 8 * fq;
#pragma unroll
            for (int ai = 0; ai < 2; ++ai)
#pragma unroll
                for (int m = 0; m < 4; ++m) { const int row = row0 + ai * HALF + m * 16;
                    const f32x4 a0 = acc[ai][0][m][0] * acc[ai][1][m][0], a1 = acc[ai][0][m][1] * acc[ai][1][m][1];
                    *(u32x4*)(U + (size_t)row * 1024 + col) = pack8(a0, a1);
                    if (!smp) { const int t = row & 8191; if (t >= 8190) { float* o = out + O_CP + (size_t)((row >> 13) * 2 + (t - 8190)) * 1024 + col; *(f32x4*)o = a0; *(f32x4*)(o + 4) = a1; } }
                    else { const int lr = row - MP, t = lr & 31; if (t >= 30) { float* o = out + O_CS + (size_t)((lr >> 5) * 2 + (t - 30)) * 1024 + col; *(f32x4*)o = a0; *(f32x4*)(o + 4) = a1; } }
                }
            return;
        }
        int sect, tloc; if (pn < 12) { sect = pn >> 2; tloc = pn & 3; } else { sect = 3 + ((pn - 20) >> 2); tloc = (pn - 20) & 3; }
        bf16_t* dst = sect == 0 ? Q : sect == 1 ? Kb : sect == 2 ? Vb : sect == 3 ? GB : sect == 4 ? GA2 : GB2;
        const int col0 = 256 * tloc + 64 * wc + 8 * fq;
        float* fo = nullptr;
        if (sect == 1 && smp) fo = out + O_KS - (size_t)MP * 1024;
        if (sect == 2 && smp) fo = out + O_VS - (size_t)MP * 1024;
        f32x4 g[2][2];
        if (sect < 2) { const float* gp = (sect == 0 ? qg : kg) + 8 * fq; const float sc = sect == 0 ? QK_C2 : 1.0f;
#pragma unroll
            for (int bj = 0; bj < 2; ++bj)
#pragma unroll
                for (int n = 0; n < 2; ++n) g[bj][n] = *(const f32x4*)(gp + 32 * bj + 4 * n) * sc; }
#pragma unroll
        for (int ai = 0; ai < 2; ++ai)
#pragma unroll
            for (int m = 0; m < 4; ++m) { const int row = row0 + ai * HALF + m * 16;
                f32x4 v[2][2];
#pragma unroll
                for (int bj = 0; bj < 2; ++bj)
#pragma unroll
                    for (int n = 0; n < 2; ++n) v[bj][n] = acc[ai][bj][m][n];
                if (sect < 2) { float ss = 0.f;
#pragma unroll
                    for (int bj = 0; bj < 2; ++bj)
#pragma unroll
                        for (int n = 0; n < 2; ++n) { const f32x4 x = v[bj][n]; ss += (x[0] * x[0] + x[1] * x[1]) + (x[2] * x[2] + x[3] * x[3]); }
                    ss += __shfl_xor(ss, 16); ss += __shfl_xor(ss, 32);
                    const float rstd = __builtin_amdgcn_rsqf(ss * (1.0f / 64.0f) + RMS_EPS);
#pragma unroll
                    for (int bj = 0; bj < 2; ++bj)
#pragma unroll
                        for (int n = 0; n < 2; ++n) v[bj][n] = v[bj][n] * rstd * g[bj][n]; }
#pragma unroll
                for (int bj = 0; bj < 2; ++bj) { *(u32x4*)(dst + (size_t)row * 1024 + col0 + 32 * bj) = pack8(v[bj][0], v[bj][1]);
                    if (fo) { float* o = fo + (size_t)row * 1024 + col0 + 32 * bj; *(f32x4*)o = v[bj][0]; *(f32x4*)(o + 4) = v[bj][1]; } }
            }
    }
};
template <int STEP> struct EpiGate {
    static constexpr bool PERM = true, AFTER_DRAIN = false, PAIRED = false;
    const bf16_t* G; float* T; bf16_t* Mx;
    __device__ __forceinline__ void operator()(const f32x4 (&acc)[2][2][4][2], const Unit& u, int wr, int wc, int fr, int fq) const {
        const int row0 = u.pm * BM + wr * 64 + fr, col0 = u.pn * BM + wc * 32 + 8 * fq;
#pragma unroll
        for (int ai = 0; ai < 2; ++ai)
#pragma unroll
            for (int m = 0; m < 4; ++m) { const size_t ro = (size_t)(row0 + ai * HALF + m * 16) * 1024 + col0;
#pragma unroll
                for (int bj = 0; bj < 2; ++bj) { const size_t o = ro + bj * HALF; const u32x4 gw = *(const u32x4*)(G + o);
                    f32x4 s0, s1; s0[0] = sigm(bf_lo(gw.x)); s0[1] = sigm(bf_hi(gw.x)); s0[2] = sigm(bf_lo(gw.y)); s0[3] = sigm(bf_hi(gw.y));
                    s1[0] = sigm(bf_lo(gw.z)); s1[1] = sigm(bf_hi(gw.z)); s1[2] = sigm(bf_lo(gw.w)); s1[3] = sigm(bf_hi(gw.w));
                    f32x4 v0 = s0 * acc[ai][bj][m][0], v1 = s1 * acc[ai][bj][m][1];
                    if (STEP == 0) { *(f32x4*)(T + o) = v0; *(f32x4*)(T + o + 4) = v1; }
                    else { v0 += *(const f32x4*)(T + o); v1 += *(const f32x4*)(T + o + 4); *(u32x4*)(Mx + o) = pack8(v0, v1); } } }
    }
};
struct EpiRes {
    static constexpr bool PERM = true, AFTER_DRAIN = false, PAIRED = false;
    const float* baseP; const float* baseS; float* out; const float* gate;
    __device__ __forceinline__ void operator()(const f32x4 (&acc)[2][2][4][2], const Unit& u, int wr, int wc, int fr, int fq) const {
        const bool smp = u.pm >= (MP / BM); const float* base = smp ? baseS : baseP;
        const int lr0 = wr * 64 + fr, row0 = u.pm * BM + lr0, col0 = u.pn * BM + wc * 32 + 8 * fq;
#pragma unroll
        for (int ai = 0; ai < 2; ++ai)
#pragma unroll
            for (int m = 0; m < 4; ++m) { const int lr = lr0 + ai * HALF + m * 16; const size_t ro = (size_t)(row0 + ai * HALF + m * 16) * 1024 + col0;
                const int mrow = smp ? 8 + (lr >> 5) : (u.pm >> 5); const float* gp = gate + (size_t)mrow * 6144 + col0;
#pragma unroll
                for (int bj = 0; bj < 2; ++bj) { const size_t o = ro + bj * HALF;
                    const f32x4 g0 = *(const f32x4*)(gp + bj * HALF), g1 = *(const f32x4*)(gp + bj * HALF + 4);
                    const f32x4 b0 = *(const f32x4*)(base + o), b1 = *(const f32x4*)(base + o + 4);
                    *(f32x4*)(out + o) = b0 + g0 * acc[ai][bj][m][0]; *(f32x4*)(out + o + 4) = b1 + g1 * acc[ai][bj][m][1]; } }
    }
};
struct EpiSwiglu {
    static constexpr bool PERM = true, AFTER_DRAIN = false, PAIRED = false;
    bf16_t* ACT;
    __device__ __forceinline__ void operator()(const f32x4 (&acc)[2][2][4][2], const Unit& u, int wr, int wc, int fr, int fq) const {
        const int row0 = u.pm * BM + wr * 64 + fr, col0 = u.pn * HALF + wc * 32 + 8 * fq;
#pragma unroll
        for (int ai = 0; ai < 2; ++ai)
#pragma unroll
            for (int m = 0; m < 4; ++m) { f32x4 r[2];
#pragma unroll
                for (int n = 0; n < 2; ++n) { const f32x4 g = acc[ai][0][m][n], up = acc[ai][1][m][n];
#pragma unroll
                    for (int i = 0; i < 4; ++i) r[n][i] = g[i] * sigm(g[i]) * up[i]; }
                *(u32x4*)(ACT + (size_t)(row0 + ai * HALF + m * 16) * 2816 + col0) = pack8(r[0], r[1]); }
    }
};
struct PairOrder { StaticOrder base;
    __device__ __forceinline__ bool next(int i, Unit& u) const { if (!base.next(i >> 1, u)) return false; u.seg = i & 1; return true; }
    __device__ __forceinline__ void a_ready(const Unit&) const {}
    __device__ __forceinline__ void done(const Unit&) const {} };
struct EpiGatePair {
    static constexpr bool PERM = true, AFTER_DRAIN = false, PAIRED = true;
    const bf16_t* GA; const bf16_t* GBr; bf16_t* Mx;
    static __device__ __forceinline__ float em(float x) { return __builtin_amdgcn_exp2f(-1.4426950408889634f * x); }
    __device__ __forceinline__ void mid(f32x4 (&acc)[2][2][4][2], const Unit& u, int wr, int wc, int fr, int fq) const {
        const int row0 = u.pm * BM + wr * 64 + fr, col0 = u.pn * BM + wc * 32 + 8 * fq;
#pragma unroll
        for (int ai = 0; ai < 2; ++ai)
#pragma unroll
            for (int m = 0; m < 4; ++m) { const size_t ro = (size_t)(row0 + ai * HALF + m * 16) * 1024 + col0;
#pragma unroll
                for (int bj = 0; bj < 2; ++bj) { const size_t o = ro + bj * HALF; const u32x4 a = *(const u32x4*)(GA + o), b = *(const u32x4*)(GBr + o);
                    const unsigned aw[4] = {a.x, a.y, a.z, a.w}, bw[4] = {b.x, b.y, b.z, b.w};
#pragma unroll
                    for (int j = 0; j < 4; ++j) { const float r0 = (1.0f + em(fmaxf(bf_lo(bw[j]), -30.f))) * __builtin_amdgcn_rcpf(1.0f + em(bf_lo(aw[j]))), r1 = (1.0f + em(fmaxf(bf_hi(bw[j]), -30.f))) * __builtin_amdgcn_rcpf(1.0f + em(bf_hi(aw[j])));
                        acc[ai][bj][m][j >> 1][2 * (j & 1)] *= r0; acc[ai][bj][m][j >> 1][2 * (j & 1) + 1] *= r1; } } }
    }
    __device__ __forceinline__ void operator()(const f32x4 (&acc)[2][2][4][2], const Unit& u, int wr, int wc, int fr, int fq) const {
        const int row0 = u.pm * BM + wr * 64 + fr, col0 = u.pn * BM + wc * 32 + 8 * fq;
#pragma unroll
        for (int ai = 0; ai < 2; ++ai)
#pragma unroll
            for (int m = 0; m < 4; ++m) { const size_t ro = (size_t)(row0 + ai * HALF + m * 16) * 1024 + col0;
#pragma unroll
                for (int bj = 0; bj < 2; ++bj) { const size_t o = ro + bj * HALF; const u32x4 b = *(const u32x4*)(GBr + o);
                    f32x4 s0, s1; s0[0] = sigm(fmaxf(bf_lo(b.x), -30.f)); s0[1] = sigm(fmaxf(bf_hi(b.x), -30.f)); s0[2] = sigm(fmaxf(bf_lo(b.y), -30.f)); s0[3] = sigm(fmaxf(bf_hi(b.y), -30.f));
                    s1[0] = sigm(fmaxf(bf_lo(b.z), -30.f)); s1[1] = sigm(fmaxf(bf_hi(b.z), -30.f)); s1[2] = sigm(fmaxf(bf_lo(b.w), -30.f)); s1[3] = sigm(fmaxf(bf_hi(b.w), -30.f));
                    *(u32x4*)(Mx + o) = pack8(s0 * acc[ai][bj][m][0], s1 * acc[ai][bj][m][1]); } }
    }
};
template <class Epi, class Sched, bool ALIGN_EPI = false, bool SP2 = false>
__device__ __forceinline__ void gemm_phase(PG8_LAS unsigned char* lds, const Gemm g, const Sched& S, const Epi& E) {
    int tid_ = threadIdx.x; asm volatile("" : "+v"(tid_));
    const int tid = tid_, wid = __builtin_amdgcn_readfirstlane(tid >> 6), lane = tid & 63, wr = wid >> 2, wc = wid & 3, fr = lane & 15, fq = lane >> 4;
    const int K = g.K, nt = K / BK;
    unsigned voffA[2], voffB[2];
#pragma unroll
    for (int i = 0; i < 2; ++i) { int R, C; stage_rc(tid * 16 + i * 8192, R, C); const int Rb = Epi::PERM ? ((R & ~31) + perm32(R & 31)) : R;
        voffA[i] = (unsigned)(R * K + C) * 2u; voffB[i] = (unsigned)(Rb * K + C) * 2u; }
    const size_t kstep = (size_t)(BK * 2);
    const size_t hstep = (size_t)HALF * K * 2;
    const size_t tstep = 2 * hstep;
    const unsigned ldsw = (unsigned)wid * 1024u;
    const int aoff = lds_byte(wr * 64 + fr, fq * 8), boff = lds_byte(wc * 32 + fr, fq * 8);
#define PG8_SA(b, h) (((b) * 2 + (h)) * HTB)
#define PG8_SB(b, h) ((4 + (b) * 2 + (h)) * HTB)
#define PG8_STAGE(bufoff, gbase, voff) do { _Pragma("unroll") for (int _i = 0; _i < 2; ++_i) \
        __builtin_amdgcn_global_load_lds((const unsigned*)((const char*)(gbase) + (voff)[_i]), (PG8_LAS unsigned*)(lds + (bufoff) + ldsw + _i * 8192), 16, 0, 0); } while (0)
#define PG8_LDA(dst, b, h) do { _Pragma("unroll") for (int m = 0; m < 4; ++m) _Pragma("unroll") for (int k = 0; k < 2; ++k) dst[m][k] = *(const PG8_LAS bf16x8*)(lds + PG8_SA(b, h) + aoff + m * 2048 + k * 1024); } while (0)
#define PG8_LDB(dst, b, h) do { _Pragma("unroll") for (int n = 0; n < 2; ++n) _Pragma("unroll") for (int k = 0; k < 2; ++k) dst[n][k] = *(const PG8_LAS bf16x8*)(lds + PG8_SB(b, h) + boff + n * 2048 + k * 1024); } while (0)
#define PG8_MMA(ai, bj, At, Bt) do { __builtin_amdgcn_s_setprio(1); _Pragma("unroll") for (int m = 0; m < 4; ++m) _Pragma("unroll") for (int n = 0; n < 2; ++n) _Pragma("unroll") for (int k = 0; k < 2; ++k) \
        acc[ai][bj][m][n] = __builtin_amdgcn_mfma_f32_16x16x32_bf16(Bt[n][k], At[m][k], acc[ai][bj][m][n], 0, 0, 0); __builtin_amdgcn_s_setprio(0); } while (0)
#define PG8_WAIT_V(n) asm volatile("s_waitcnt vmcnt(" #n ")" ::: "memory")
#define PG8_WAIT_L(n) asm volatile("s_waitcnt lgkmcnt(" #n ")" ::: "memory")
#define PG8_BAR __builtin_amdgcn_s_barrier()
#define PG8_SCHED __builtin_amdgcn_sched_barrier(0)
    Unit cur, nxt; int ui = 0;
    if (!S.next(0, cur)) return;
    f32x4 acc[2][2][4][2];
#pragma unroll
    for (int a = 0; a < 2; ++a)
#pragma unroll
        for (int b = 0; b < 2; ++b)
#pragma unroll
            for (int m = 0; m < 4; ++m)
#pragma unroll
                for (int n = 0; n < 2; ++n) acc[a][b][m][n] = (f32x4){0.f, 0.f, 0.f, 0.f};
    bf16x8 At[4][2], B0[2][2], B1[2][2];
#define PG8_ABASE(u) ((const char*)((u).seg ? g.A2 : g.A) + (size_t)(u).pm * tstep)
#define PG8_BBASE(u) ((const char*)((u).seg ? g.Bt2 : g.Bt) + (size_t)(u).pn * tstep)
    const char* cA = PG8_ABASE(cur); const char* cB = PG8_BBASE(cur);
    S.a_ready(cur);
    if constexpr (SP2) {
        PG8_STAGE(PG8_SB(0, 0), cB, voffB); PG8_STAGE(PG8_SB(0, 1), cB + hstep, voffB); PG8_STAGE(PG8_SA(0, 0), cA, voffA); PG8_STAGE(PG8_SA(0, 1), cA + hstep, voffA);
        if (wr == 1) PG8_BAR;
        PG8_WAIT_V(2); PG8_BAR;
        PG8_STAGE(PG8_SB(1, 0), cB + kstep, voffB); PG8_STAGE(PG8_SA(1, 0), cA + kstep, voffA); PG8_STAGE(PG8_SB(1, 1), cB + hstep + kstep, voffB);
        PG8_WAIT_V(6); PG8_BAR;
    } else {
        PG8_STAGE(PG8_SB(0, 0), cB, voffB); PG8_STAGE(PG8_SA(0, 0), cA, voffA); PG8_STAGE(PG8_SB(0, 1), cB + hstep, voffB); PG8_STAGE(PG8_SA(0, 1), cA + hstep, voffA);
        if (wr == 1) PG8_BAR;
        PG8_WAIT_V(4); PG8_BAR;
        PG8_STAGE(PG8_SB(1, 0), cB + kstep, voffB); PG8_STAGE(PG8_SA(1, 0), cA + kstep, voffA); PG8_STAGE(PG8_SB(1, 1), cB + hstep + kstep, voffB);
        PG8_WAIT_V(6); PG8_BAR;
    }
    for (;;) {
        const bool has_next = S.next(ui + 1, nxt);
        const char* nA = has_next ? PG8_ABASE(nxt) : cA; const char* nB = has_next ? PG8_BBASE(nxt) : cB;
        for (int t = 0; t < nt; t += 2) {
            const bool last = (t == nt - 2);
            const char* a1 = cA + (size_t)(t + 1) * kstep;
            const char* a2 = last ? nA : cA + (size_t)(t + 2) * kstep; const char* b2 = last ? nB : cB + (size_t)(t + 2) * kstep;
            const char* a3 = a2 + kstep; const char* b3 = b2 + kstep;
            if (last && has_next) S.a_ready(nxt);
            if constexpr (SP2) {
            PG8_LDB(B0, 0, 0); PG8_LDB(B1, 0, 1); PG8_SCHED; PG8_LDA(At, 0, 0); PG8_STAGE(PG8_SA(1, 1), a1 + hstep, voffA);
            PG8_WAIT_V(8); PG8_WAIT_L(0); PG8_BAR; PG8_MMA(0, 0, At, B0); PG8_MMA(0, 1, At, B1); PG8_BAR; PG8_SCHED;
            PG8_LDA(At, 0, 1); PG8_STAGE(PG8_SB(0, 0), b2, voffB); PG8_STAGE(PG8_SB(0, 1), b2 + hstep, voffB); PG8_STAGE(PG8_SA(0, 0), a2, voffA);
            PG8_WAIT_V(8); PG8_WAIT_L(0); PG8_BAR; PG8_MMA(1, 0, At, B0); PG8_MMA(1, 1, At, B1); PG8_BAR; PG8_SCHED;
            PG8_LDB(B0, 1, 0); PG8_LDB(B1, 1, 1); PG8_SCHED; PG8_LDA(At, 1, 0); PG8_STAGE(PG8_SA(0, 1), a2 + hstep, voffA);
            PG8_WAIT_V(8); PG8_WAIT_L(0); PG8_BAR; PG8_MMA(0, 0, At, B0); PG8_MMA(0, 1, At, B1); PG8_BAR; PG8_SCHED;
            PG8_LDA(At, 1, 1); PG8_STAGE(PG8_SB(1, 0), b3, voffB); PG8_STAGE(PG8_SB(1, 1), b3 + hstep, voffB); PG8_STAGE(PG8_SA(1, 0), a3, voffA);
            PG8_WAIT_V(8); PG8_WAIT_L(0); PG8_BAR; PG8_MMA(1, 0, At, B0); PG8_MMA(1, 1, At, B1); PG8_BAR; PG8_SCHED;
            } else {
            PG8_LDB(B0, 0, 0); PG8_SCHED; PG8_LDA(At, 0, 0); PG8_STAGE(PG8_SA(1, 1), a1 + hstep, voffA);
            PG8_WAIT_L(8); PG8_BAR; PG8_WAIT_L(0); PG8_MMA(0, 0, At, B0); PG8_BAR; PG8_SCHED;
            PG8_LDB(B1, 0, 1); PG8_STAGE(PG8_SB(0, 0), b2, voffB);
            PG8_BAR; PG8_WAIT_L(0); PG8_MMA(0, 1, At, B1); PG8_BAR;
            PG8_LDA(At, 0, 1); PG8_STAGE(PG8_SA(0, 0), a2, voffA);
            PG8_BAR; PG8_WAIT_L(0); PG8_MMA(1, 0, At, B0); PG8_BAR; PG8_SCHED;
            PG8_STAGE(PG8_SB(0, 1), b2 + hstep, voffB);
            PG8_WAIT_V(6); PG8_BAR; PG8_MMA(1, 1, At, B1); PG8_BAR;
            PG8_LDB(B0, 1, 0); PG8_SCHED; PG8_LDA(At, 1, 0); PG8_STAGE(PG8_SA(0, 1), a2 + hstep, voffA);
            PG8_WAIT_L(8); PG8_BAR; PG8_WAIT_L(0); PG8_MMA(0, 0, At, B0); PG8_BAR; PG8_SCHED;
            PG8_LDB(B1, 1, 1); PG8_STAGE(PG8_SB(1, 0), b3, voffB);
            PG8_BAR; PG8_WAIT_L(0); PG8_MMA(0, 1, At, B1); PG8_BAR;
            PG8_LDA(At, 1, 1); PG8_STAGE(PG8_SA(1, 0), a3, voffA);
            PG8_BAR; PG8_WAIT_L(0); PG8_MMA(1, 0, At, B0); PG8_BAR; PG8_SCHED;
            PG8_STAGE(PG8_SB(1, 1), b3 + hstep, voffB);
            PG8_WAIT_V(6); PG8_BAR; PG8_MMA(1, 1, At, B1); PG8_BAR;
            }
        }
        if constexpr (ALIGN_EPI) { if (wr == 0) PG8_BAR; }
        bool keep_acc = false;
        if constexpr (Epi::PAIRED) { if (cur.seg == 0) { E.mid(acc, cur, wr, wc, fr, fq); keep_acc = true; } else E(acc, cur, wr, wc, fr, fq); S.done(cur); }
        else if constexpr (!Epi::AFTER_DRAIN) { E(acc, cur, wr, wc, fr, fq); S.done(cur); }
        if (!has_next) break;
        if (!keep_acc)
#pragma unroll
        for (int a = 0; a < 2; ++a)
#pragma unroll
            for (int b = 0; b < 2; ++b)
#pragma unroll
                for (int m = 0; m < 4; ++m)
#pragma unroll
                    for (int n = 0; n < 2; ++n) acc[a][b][m][n] = (f32x4){0.f, 0.f, 0.f, 0.f};
        cur = nxt; cA = nA; cB = nB; ++ui;
        if constexpr (ALIGN_EPI) { if (wr == 1) PG8_BAR; }
    }
    PG8_WAIT_V(0);
    if constexpr (!ALIGN_EPI) { if (wr == 0) PG8_BAR; }
    PG8_BAR;
    if constexpr (Epi::AFTER_DRAIN) { E.fused(acc, cur, wr, wc, fr, fq, lds, wid, lane); S.done(cur); }
#undef PG8_ABASE
#undef PG8_BBASE
#undef PG8_SA
#undef PG8_SB
#undef PG8_STAGE
#undef PG8_LDA
#undef PG8_LDB
#undef PG8_MMA
#undef PG8_WAIT_V
#undef PG8_WAIT_L
#undef PG8_BAR
#undef PG8_SCHED
}
}
#include <hip/hip_bf16.h>
#include <cmath>
namespace attn2 {
using bf16=__hip_bfloat16;
using bf16x8=__attribute__((ext_vector_type(8)))short;
using s16x4=__attribute__((ext_vector_type(4)))short;
using f32x16=__attribute__((ext_vector_type(16)))float;
using u32x4=__attribute__((ext_vector_type(4)))unsigned;
constexpr int SEQ=8192,DM=1024;
constexpr int NW=8,QBLK=32,QB=QBLK*NW,KVBLK=64;
__device__ __forceinline__ int crow(int r,int hi){return (r&3)+8*(r>>2)+4*hi;}
#define SBAR() __builtin_amdgcn_sched_barrier(0)
constexpr int NSLOT=3, SLOTB=8192;
constexpr int LDS_K=0, LDS_V=NSLOT*SLOTB, LDS_WS=LDS_V+2*NSLOT*SLOTB, LDS_OST=LDS_WS+NW*64*4, LDS_BYTES=LDS_OST+NW*4096;
__device__ __forceinline__ void glds16(const void*gsrc,unsigned lds_dst){unsigned keep;
  asm volatile("s_mov_b32 %0, m0\n\ts_mov_b32 m0, %2\n\ts_nop 0\n\tglobal_load_lds_dwordx4 %1, off\n\ts_mov_b32 m0, %0":"=&s"(keep):"v"(gsrc),"s"(lds_dst):"memory");}
typedef float f32x2_t __attribute__((ext_vector_type(2))); typedef __bf16 bf16x2_t __attribute__((ext_vector_type(2)));
__device__ __forceinline__ unsigned cvtpk_s(float lo,float hi){f32x2_t v={lo,hi};bf16x2_t b=__builtin_convertvector(v,bf16x2_t);return __builtin_bit_cast(unsigned,b);}
#define WAIT_BAR(N) asm volatile("s_waitcnt vmcnt(" #N ") lgkmcnt(0)\n\ts_barrier":::"memory")
typedef __attribute__((address_space(3))) const char* lds_cptr;
typedef short v4i16_t __attribute__((ext_vector_type(4)));
__device__ __forceinline__ void qkt0(f32x16&p0,f32x16&p1,const char*Kslot,const bf16x8*qr,int r32,int hi){
  const char*kb=Kslot+hi*1024+r32*16; const f32x16 z=f32x16{};
  #pragma unroll
  for(int d0=0;d0<4;++d0){
    const bf16x8 b0=*reinterpret_cast<const bf16x8*>(kb+d0*2048);
    const bf16x8 b1=*reinterpret_cast<const bf16x8*>(kb+d0*2048+512);
    if(d0==0){p0=__builtin_amdgcn_mfma_f32_32x32x16_bf16(b0,qr[0],z,0,0,0);p1=__builtin_amdgcn_mfma_f32_32x32x16_bf16(b1,qr[0],z,0,0,0);}
    else{p0=__builtin_amdgcn_mfma_f32_32x32x16_bf16(b0,qr[d0],p0,0,0,0);p1=__builtin_amdgcn_mfma_f32_32x32x16_bf16(b1,qr[d0],p1,0,0,0);}}
}
__device__ __forceinline__ void kload8(bf16x8*kf,lds_cptr kp){
  kf[0]=*(const __attribute__((address_space(3))) bf16x8*)(kp);      kf[1]=*(const __attribute__((address_space(3))) bf16x8*)(kp+512);
  kf[2]=*(const __attribute__((address_space(3))) bf16x8*)(kp+2048); kf[3]=*(const __attribute__((address_space(3))) bf16x8*)(kp+2560);
  kf[4]=*(const __attribute__((address_space(3))) bf16x8*)(kp+4096); kf[5]=*(const __attribute__((address_space(3))) bf16x8*)(kp+4608);
  kf[6]=*(const __attribute__((address_space(3))) bf16x8*)(kp+6144); kf[7]=*(const __attribute__((address_space(3))) bf16x8*)(kp+6656);
}
__device__ __forceinline__ void kload2(bf16x8*kf,lds_cptr kp,int j){ kf[2*j]=*(const __attribute__((address_space(3))) bf16x8*)(kp+j*2048); kf[2*j+1]=*(const __attribute__((address_space(3))) bf16x8*)(kp+j*2048+512); }
__device__ __forceinline__ s16x4 vtr(lds_cptr p){ return __builtin_bit_cast(s16x4,__builtin_amdgcn_ds_read_tr16_b64_v4i16((__attribute__((address_space(3))) v4i16_t*)p)); }
__device__ __forceinline__ void pv4(f32x16*o,int vb,bf16x8 pa0,bf16x8 pa1,bf16x8 pa2,bf16x8 pa3){
  #pragma unroll
  for(int d0=0;d0<4;++d0){s16x4 lo[4],hi[4];
    #pragma unroll
    for(int ks=0;ks<4;++ks){
      asm volatile("ds_read_b64_tr_b16 %0,%1 offset:%c2":"=&v"(lo[ks]):"v"(vb),"i"(d0*4096+ks*1024):"memory");
      asm volatile("ds_read_b64_tr_b16 %0,%1 offset:%c2":"=&v"(hi[ks]):"v"(vb),"i"(d0*4096+ks*1024+512):"memory");}
    asm volatile("s_waitcnt lgkmcnt(0)":::"memory");SBAR();
    #define PK(k) (bf16x8){lo[k][0],lo[k][1],lo[k][2],lo[k][3],hi[k][0],hi[k][1],hi[k][2],hi[k][3]}
    o[d0]=__builtin_amdgcn_mfma_f32_32x32x16_bf16(pa0,PK(0),o[d0],0,0,0);
    o[d0]=__builtin_amdgcn_mfma_f32_32x32x16_bf16(pa1,PK(1),o[d0],0,0,0);
    o[d0]=__builtin_amdgcn_mfma_f32_32x32x16_bf16(pa2,PK(2),o[d0],0,0,0);
    o[d0]=__builtin_amdgcn_mfma_f32_32x32x16_bf16(pa3,PK(3),o[d0],0,0,0);
    #undef PK
  }
}
#ifndef ATTN_STORE16
#define ATTN_STORE16(p,v) (*(u32x4*)(p)=(v))
#endif
template<bool SHIFT,int OP> __device__ __forceinline__ void attn_unit(int b,int qcol,int vcol,int ocol,int qb,float mshift,int mode,float lam,const float*subg,float gmul,float*o2s,float*kout,float*vout,const bf16*Q,const bf16*__restrict__ K,const bf16*__restrict__ V,bf16*O,char*shm){
  int tid_=threadIdx.x; asm volatile("":"+v"(tid_)); const int tid=tid_,lane=tid&63,r32=lane&31,hi=lane>>5; const int wid=__builtin_amdgcn_readfirstlane(tid>>6);
  const long rowbase=(long)b*SEQ; const int q0=qb*QB;
  const bf16*Qw=Q+(rowbase+q0+wid*QBLK)*DM+qcol;
  const bf16*Kh=K+rowbase*DM+qcol,*Vh=V+rowbase*DM+vcol;
  const unsigned lds0=(unsigned)(uintptr_t)shm;
  float*wsf=(float*)(shm+LDS_WS)+wid*64;
  const bf16*ksrc=Kh+(long)lane*DM+wid*8;
  const bf16*vsrc=Vh+(long)(16*(wid&3)+(lane>>2))*DM+(wid>>2)*32+(lane&3)*8;
  const unsigned kdst=lds0+LDS_K+wid*1024, vdst=lds0+LDS_V+wid*1024;
  #define DMA_K(t,slot) glds16(ksrc+(long)(t)*KVBLK*DM,(unsigned)__builtin_amdgcn_readfirstlane(kdst+(slot)))
  #define DMA_V(t,slot) do{ glds16(vsrc+(long)(t)*KVBLK*DM,(unsigned)__builtin_amdgcn_readfirstlane(vdst+2*(slot))); glds16(vsrc+(long)(t)*KVBLK*DM+64,(unsigned)__builtin_amdgcn_readfirstlane(vdst+2*(slot)+8192)); }while(0)
  const int vb0=(int)(lds0+LDS_V)+((lane>>4)&1)*32+(lane&3)*8+(4*hi+((lane&15)>>2))*64;
  const char*Kbase=shm+LDS_K; bf16x8 kf[8];
  const lds_cptr shm3=(lds_cptr)shm; const lds_cptr kp0=shm3+LDS_K+hi*1024+r32*16; const lds_cptr vp0=shm3+LDS_V+((lane>>4)&1)*32+(lane&3)*8+(4*hi+((lane&15)>>2))*64;
  const int NT=(q0+QB)/KVBLK;
  DMA_K(0,0);DMA_V(0,0);DMA_K(1,SLOTB);
  bf16x8 qr[4];
  #pragma unroll
  for(int d0=0;d0<4;++d0)qr[d0]=*reinterpret_cast<const bf16x8*>(&Qw[(long)r32*DM+d0*16+hi*8]);
  float l_reg=0.f;f32x16 o[4];o[0]=f32x16{};o[1]=f32x16{};o[2]=f32x16{};o[3]=f32x16{};
  const int chunkw=wid>>1;
  #define CMASK_BAND(P0,P1,t) do{int jb_=(t)-(NT-4); if(jb_>chunkw){ asm volatile("":::"memory"); _Pragma("unroll") for(int r=0;r<16;++r){P0[r]=-INFINITY;P1[r]=-INFINITY;} } }while(0)
  #define CMASK(P0,P1,t) CMASK_BAND(P0,P1,t)
  #define EX(v) __builtin_amdgcn_exp2f(v)
  #define EXS(v) (SHIFT?EX((v)-mshift):EX(v))
  f32x16 pA0,pA1,pB0,pB1;
  int sl_prev=0,sl_cur=0,sl_next=SLOTB;
  #define ROT() do{sl_prev=sl_cur;sl_cur=sl_next;sl_next=(sl_next==(NSLOT-1)*SLOTB)?0:sl_next+SLOTB;}while(0)
  DMA_K(2,2*SLOTB);
  WAIT_BAR(4);
  qkt0(pA0,pA1,Kbase,qr,r32,hi);CMASK(pA0,pA1,0);
  _Pragma("unroll") for(int r=0;r<16;++r){pA0[r]=EXS(pA0[r]);pA1[r]=EXS(pA1[r]);}
  WAIT_BAR(0);
  DMA_K(3,0);DMA_V(1,SLOTB);
  ROT();
  kload8(kf,kp0+sl_cur);
  WAIT_BAR(3);
  s16x4 vlo[8],vhi[8]; u32x4 pw0,pw1,pw2,pw3;
  #define PKW(P,B) cvtpk_s(P[B],P[B+1])
  #define PAF(k) __builtin_bit_cast(bf16x8,pw##k)
  #define VFR(i) (bf16x8){vlo[i][0],vlo[i][1],vlo[i][2],vlo[i][3],vhi[i][0],vhi[i][1],vhi[i][2],vhi[i][3]}
  #define PIN(x) asm volatile("":"+v"(x))
  #define GAPA(MF,A0,A1,A2,A3,W0,W1,PW) do{ MF; sacc+=A0; sacc+=A1; sacc+=A2; sacc+=A3; PIN(sacc); W0; W1; PIN(PW); SBAR(); }while(0)
  #define GAPB(MF,X,B) do{ MF; X[B]=EXS(X[B]); X[B+1]=EXS(X[B+1]); PIN(X); SBAR(); }while(0)
  #define VRD(i,db) do{ vlo[i]=vtr(vp_+((db)*4096+((i)&3)*1024)); vhi[i]=vtr(vp_+((db)*4096+((i)&3)*1024+512)); }while(0)
  #define KRD(G,j) do{ if(G){ kload2(kf,kp0+sl_next,j); SBAR(); } }while(0)
  #define STEP(C0,C1,P0,P1,t,GK,GV,GL) do{ SBAR(); \
    const lds_cptr vp_=vp0+2*sl_prev; const f32x16 z_=f32x16{}; \
    VRD(0,0); SBAR(); float sacc=(P0[0]+P0[1]); \
    GAPA(C0=__builtin_amdgcn_mfma_f32_32x32x16_bf16(kf[0],qr[0],z_,0,0,0), P0[2],P0[3],P0[4],P0[5],     pw0[0]=PKW(P0,0), pw0[1]=PKW(P0,2), pw0); \
    VRD(4,1); SBAR(); GAPA(C1=__builtin_amdgcn_mfma_f32_32x32x16_bf16(kf[1],qr[0],z_,0,0,0), P0[6],P0[7],P0[8],P0[9],     pw0[2]=PKW(P0,4), pw0[3]=PKW(P0,6), pw0); \
    VRD(1,0); SBAR(); GAPA(C0=__builtin_amdgcn_mfma_f32_32x32x16_bf16(kf[2],qr[1],C0,0,0,0),   P0[10],P0[11],P0[12],P0[13], pw1[0]=PKW(P0,8), pw1[1]=PKW(P0,10), pw1); \
    VRD(5,1); SBAR(); GAPA(C1=__builtin_amdgcn_mfma_f32_32x32x16_bf16(kf[3],qr[1],C1,0,0,0),   P0[14],P0[15],P1[0],P1[1],   pw1[2]=PKW(P0,12),pw1[3]=PKW(P0,14), pw1); \
    VRD(2,0); SBAR(); GAPA(C0=__builtin_amdgcn_mfma_f32_32x32x16_bf16(kf[4],qr[2],C0,0,0,0),   P1[2],P1[3],P1[4],P1[5],     pw2[0]=PKW(P1,0), pw2[1]=PKW(P1,2), pw2); \
    VRD(6,1); SBAR(); GAPA(C1=__builtin_amdgcn_mfma_f32_32x32x16_bf16(kf[5],qr[2],C1,0,0,0),   P1[6],P1[7],P1[8],P1[9],     pw2[2]=PKW(P1,4), pw2[3]=PKW(P1,6), pw2); \
    VRD(3,0); SBAR(); GAPA(C0=__builtin_amdgcn_mfma_f32_32x32x16_bf16(kf[6],qr[3],C0,0,0,0),   P1[10],P1[11],P1[12],P1[13], pw3[0]=PKW(P1,8), pw3[1]=PKW(P1,10), pw3); \
    VRD(7,1); SBAR(); GAPA(C1=__builtin_amdgcn_mfma_f32_32x32x16_bf16(kf[7],qr[3],C1,0,0,0),   P1[14],P1[15],0.f,0.f,       pw3[2]=PKW(P1,12),pw3[3]=PKW(P1,14), pw3); \
    l_reg+=sacc; \
    if(GK){DMA_K((t)+3,sl_cur);} if(GV){DMA_V((t)+1,sl_next);} \
    CMASK(C0,C1,t); \
    SBAR(); \
    GAPB(o[0]=__builtin_amdgcn_mfma_f32_32x32x16_bf16(PAF(0),VFR(0),o[0],0,0,0), C0,0);  VRD(0,2); SBAR(); \
    GAPB(o[1]=__builtin_amdgcn_mfma_f32_32x32x16_bf16(PAF(0),VFR(4),o[1],0,0,0), C0,2);  VRD(4,3); SBAR(); \
    KRD(GL,0); GAPB(o[0]=__builtin_amdgcn_mfma_f32_32x32x16_bf16(PAF(1),VFR(1),o[0],0,0,0), C0,4);  VRD(1,2); SBAR(); \
    KRD(GL,1); GAPB(o[1]=__builtin_amdgcn_mfma_f32_32x32x16_bf16(PAF(1),VFR(5),o[1],0,0,0), C0,6);  VRD(5,3); SBAR(); \
    KRD(GL,2); GAPB(o[0]=__builtin_amdgcn_mfma_f32_32x32x16_bf16(PAF(2),VFR(2),o[0],0,0,0), C0,8);  VRD(2,2); SBAR(); \
    KRD(GL,3); GAPB(o[1]=__builtin_amdgcn_mfma_f32_32x32x16_bf16(PAF(2),VFR(6),o[1],0,0,0), C0,10); VRD(6,3); SBAR(); \
    GAPB(o[0]=__builtin_amdgcn_mfma_f32_32x32x16_bf16(PAF(3),VFR(3),o[0],0,0,0), C0,12); VRD(3,2); SBAR(); \
    GAPB(o[1]=__builtin_amdgcn_mfma_f32_32x32x16_bf16(PAF(3),VFR(7),o[1],0,0,0), C0,14); VRD(7,3); SBAR(); \
    GAPB(o[2]=__builtin_amdgcn_mfma_f32_32x32x16_bf16(PAF(0),VFR(0),o[2],0,0,0), C1,0); \
    GAPB(o[3]=__builtin_amdgcn_mfma_f32_32x32x16_bf16(PAF(0),VFR(4),o[3],0,0,0), C1,2); \
    GAPB(o[2]=__builtin_amdgcn_mfma_f32_32x32x16_bf16(PAF(1),VFR(1),o[2],0,0,0), C1,4); \
    GAPB(o[3]=__builtin_amdgcn_mfma_f32_32x32x16_bf16(PAF(1),VFR(5),o[3],0,0,0), C1,6); \
    GAPB(o[2]=__builtin_amdgcn_mfma_f32_32x32x16_bf16(PAF(2),VFR(2),o[2],0,0,0), C1,8); \
    GAPB(o[3]=__builtin_amdgcn_mfma_f32_32x32x16_bf16(PAF(2),VFR(6),o[3],0,0,0), C1,10); \
    GAPB(o[2]=__builtin_amdgcn_mfma_f32_32x32x16_bf16(PAF(3),VFR(3),o[2],0,0,0), C1,12); \
    GAPB(o[3]=__builtin_amdgcn_mfma_f32_32x32x16_bf16(PAF(3),VFR(7),o[3],0,0,0), C1,14); \
    }while(0)
  if(wid>=4)__builtin_amdgcn_s_setprio(1);
  int t=1;
  #undef CMASK
  #define CMASK(P0,P1,t) do{}while(0)
  for(;t+5<NT;t+=2){
    STEP(pB0,pB1,pA0,pA1,t,true,true,true);     WAIT_BAR(3); ROT();
    STEP(pA0,pA1,pB0,pB1,t+1,true,true,true);   WAIT_BAR(3); ROT();
  }
  #undef CMASK
  #define CMASK(P0,P1,t) CMASK_BAND(P0,P1,t)
  #define ENDW(tt) do{ if((tt)+3<NT){WAIT_BAR(3);} else if((tt)+2<NT){WAIT_BAR(2);} else {WAIT_BAR(0);} }while(0)
  for(;t+1<NT;t+=2){
    STEP(pB0,pB1,pA0,pA1,t,(t+3<NT),(t+1<NT),(t+1<NT));       ENDW(t);   ROT();
    STEP(pA0,pA1,pB0,pB1,t+1,(t+4<NT),(t+2<NT),(t+2<NT));     ENDW(t+1); ROT();
  }
  STEP(pB0,pB1,pA0,pA1,NT-1,false,false,false);
  { float sacc=pB0[0]+pB0[1]; _Pragma("unroll") for(int r=2;r<16;++r)sacc+=pB0[r]; _Pragma("unroll") for(int r=0;r<16;++r)sacc+=pB1[r]; l_reg+=sacc;
    pw0=(u32x4){PKW(pB0,0),PKW(pB0,2),PKW(pB0,4),PKW(pB0,6)};pw1=(u32x4){PKW(pB0,8),PKW(pB0,10),PKW(pB0,12),PKW(pB0,14)};pw2=(u32x4){PKW(pB1,0),PKW(pB1,2),PKW(pB1,4),PKW(pB1,6)};pw3=(u32x4){PKW(pB1,8),PKW(pB1,10),PKW(pB1,12),PKW(pB1,14)};
    SBAR(); pv4(o,vb0+2*sl_cur,PAF(0),PAF(1),PAF(2),PAF(3)); }
  #undef PKW
  #undef PAF
  #undef VFR
  #undef PIN
  #undef GAPA
  #undef GAPB
  #undef EX
  #undef EXS
  #undef VRD
  #undef KRD
  #undef STEP
  #undef ENDW
  __builtin_amdgcn_s_setprio(0);
  {auto rr=__builtin_amdgcn_permlane32_swap(__float_as_uint(l_reg),__float_as_uint(l_reg),false,false);l_reg=__uint_as_float(rr[0])+__uint_as_float(rr[1]);}
  if(hi==0)wsf[32+r32]=l_reg;asm volatile("s_waitcnt lgkmcnt(0)":::"memory");
  { float rli[16];
  #pragma unroll
  for(int r=0;r<16;++r)rli[r]=__builtin_amdgcn_rcpf(wsf[32+crow(r,hi)]);
  #pragma unroll
  for(int d0=0;d0<4;++d0)
    #pragma unroll
    for(int r=0;r<16;++r)o[d0][r]*=rli[r]; }
  float*o2w=o2s+(size_t)wid*4096+lane;
  if(mode==0){
    #pragma unroll
    for(int d0=0;d0<4;++d0)
      #pragma unroll
      for(int r=0;r<16;++r)o2w[(d0*16+r)*64]=o[d0][r];
  } else {
    #pragma unroll
    for(int d0=0;d0<4;++d0)
      #pragma unroll
      for(int r=0;r<16;++r)o[d0][r]-=lam*o2w[(d0*16+r)*64];
    float sg[4];
    #pragma unroll
    for(int d0=0;d0<4;++d0)sg[d0]=subg[32*d0+r32]*gmul;
    #pragma unroll
    for(int r=0;r<16;++r){ float ss=(o[0][r]*o[0][r]+o[1][r]*o[1][r])+(o[2][r]*o[2][r]+o[3][r]*o[3][r]);
      ss+=__shfl_xor(ss,1);ss+=__shfl_xor(ss,2);ss+=__shfl_xor(ss,4);ss+=__shfl_xor(ss,8);ss+=__shfl_xor(ss,16);
      const float rs=__builtin_amdgcn_rsqf(ss*(1.0f/128.0f)+1e-6f);
      #pragma unroll
      for(int d0=0;d0<4;++d0)o[d0][r]*=rs*sg[d0]; }
    bf16*Ow=O+(rowbase+q0+wid*QBLK)*OP+ocol;
    bf16*stg=(bf16*)(shm+LDS_OST)+wid*2048;
    #pragma unroll
    for(int ps=0;ps<2;++ps){
      #pragma unroll
      for(int r=0;r<16;++r){const int orow=crow(r,hi);
        #pragma unroll
        for(int d0=0;d0<2;++d0)stg[orow*64+d0*32+r32]=__float2bfloat16(o[2*ps+d0][r]);}
      asm volatile("s_waitcnt lgkmcnt(0)":::"memory");
      #pragma unroll
      for(int i=0;i<4;++i){const int row=i*8+(lane>>3),ch=lane&7; const u32x4 v=*(const u32x4*)(stg+row*64+ch*8); ATTN_STORE16(Ow+(long)row*OP+ps*64+ch*8,v);}
      asm volatile("s_waitcnt lgkmcnt(0)":::"memory"); } }
  { typedef float f32x4a __attribute__((ext_vector_type(4)));
    #pragma unroll
    for(int i=0;i<4;++i){ const int gI=tid+512*i,row=gI>>3,c8=gI&7; const u32x4 w=*(const u32x4*)(Kh+(long)(q0+row)*DM+c8*8); float*dst=kout+(rowbase+q0+row)*DM+qcol+c8*8;
      *(f32x4a*)dst=(f32x4a){__uint_as_float(w.x<<16),__uint_as_float(w.x&0xffff0000u),__uint_as_float(w.y<<16),__uint_as_float(w.y&0xffff0000u)};
      *(f32x4a*)(dst+4)=(f32x4a){__uint_as_float(w.z<<16),__uint_as_float(w.z&0xffff0000u),__uint_as_float(w.w<<16),__uint_as_float(w.w&0xffff0000u)}; }
    if(mode==1){
      #pragma unroll
      for(int i=0;i<8;++i){ const int gI=tid+512*i,row=gI>>4,c8=gI&15; const u32x4 w=*(const u32x4*)(Vh+(long)(q0+row)*DM+c8*8); float*dst=vout+(rowbase+q0+row)*DM+vcol+c8*8;
        *(f32x4a*)dst=(f32x4a){__uint_as_float(w.x<<16),__uint_as_float(w.x&0xffff0000u),__uint_as_float(w.y<<16),__uint_as_float(w.y&0xffff0000u)};
        *(f32x4a*)(dst+4)=(f32x4a){__uint_as_float(w.z<<16),__uint_as_float(w.z&0xffff0000u),__uint_as_float(w.w<<16),__uint_as_float(w.w&0xffff0000u)}; } } }
  asm volatile("s_waitcnt lgkmcnt(0)\n\ts_barrier":::"memory");
  #undef DMA_K
  #undef DMA_V
  #undef CMASK
  #undef CMASK_BAND
  #undef ROT
}
#undef SBAR
#undef WAIT_BAR
}
#include <hip/hip_cooperative_groups.h>
namespace cg = cooperative_groups;
constexpr int NWAVES = 8;
constexpr int MP = pg8::MP, MS = pg8::MS, MT = pg8::MT, D = 1024, TP = 8192, TS = 32, PAST = 1024, NIN = 8192, FF = 2816, NGU = 2 * FF;
constexpr float LAM0 = 0.2f;
constexpr size_t MiB = 1u << 20;
constexpr size_t ROWB = (size_t)MT * D * 2;
constexpr size_t WS_MOD = 0;
constexpr size_t WS_WIN = 1 * MiB, WS_WAO = 17 * MiB, WS_WCO = 19 * MiB, WS_WOUT = 21 * MiB, WS_WGU = 23 * MiB, WS_WDN = 34 * MiB;
constexpr size_t WS_XN = 40 * MiB;
constexpr size_t WS_O12 = 40 * MiB;
constexpr size_t WS_T = WS_O12;
constexpr size_t WS_Q = WS_O12 + 2 * ROWB, WS_K = WS_Q + ROWB, WS_V = WS_K + ROWB, WS_U = WS_V + ROWB, WS_GB = WS_U + ROWB, WS_END = WS_GB + ROWB;
constexpr size_t WS_ON = WS_Q;
constexpr size_t WS_MX = WS_K;
constexpr size_t WS_XN2 = WS_V;
constexpr size_t WS_ACT = 40 * MiB;
static_assert(WS_ACT + (size_t)MT * FF * 2 <= WS_MX && WS_END <= 1024 * MiB, "d_ws map");
constexpr int LDS_BYTES = 147456;
constexpr size_t WS_BAR = 512 * 1024;
constexpr int XBAR_LDS_OFF = 147456 - 64;

#define GAS __attribute__((address_space(1)))
#define LAS __attribute__((address_space(3)))
typedef unsigned short bf16;
typedef unsigned v4u __attribute__((ext_vector_type(4)));
typedef unsigned v2u __attribute__((ext_vector_type(2)));
typedef float f32x4 __attribute__((ext_vector_type(4)));
#define LDS_WAIT() asm volatile("s_waitcnt lgkmcnt(0)" ::: "memory")
__device__ __forceinline__ unsigned f2bf(float f) { unsigned u = __builtin_bit_cast(unsigned, f); return (u + 0x7fffu + ((u >> 16) & 1u)) >> 16; }
__device__ __forceinline__ unsigned pk2(float lo, float hi) { return f2bf(lo) | (f2bf(hi) << 16); }
__device__ __forceinline__ float bflo(unsigned w) { return __uint_as_float(w << 16); }
__device__ __forceinline__ float bfhi(unsigned w) { return __uint_as_float(w & 0xffff0000u); }
__device__ __forceinline__ float bf1(bf16 b) { return __uint_as_float((unsigned)b << 16); }
__device__ __forceinline__ float wave_sum(float v) {
#pragma unroll
    for (int o = 1; o < 64; o <<= 1) v += __shfl_xor(v, o);
    return v;
}
__device__ __forceinline__ float wave_max(float v) {
#pragma unroll
    for (int o = 1; o < 64; o <<= 1) v = fmaxf(v, __shfl_xor(v, o));
    return v;
}

__device__ __forceinline__ void ld16(const bf16* p, float (&d)[16]) { const v4u* q = (const v4u*)p;
#pragma unroll
    for (int e = 0; e < 2; ++e) { const v4u a = q[e]; d[8 * e + 0] = bflo(a.x); d[8 * e + 1] = bfhi(a.x); d[8 * e + 2] = bflo(a.y); d[8 * e + 3] = bfhi(a.y); d[8 * e + 4] = bflo(a.z); d[8 * e + 5] = bfhi(a.z); d[8 * e + 6] = bflo(a.w); d[8 * e + 7] = bfhi(a.w); } }
__device__ __forceinline__ void ldf(const float* p, float (&d)[16]) { const f32x4* q = (const f32x4*)p;
#pragma unroll
    for (int e = 0; e < 4; ++e) { const f32x4 a = q[e]; d[4 * e] = a.x; d[4 * e + 1] = a.y; d[4 * e + 2] = a.z; d[4 * e + 3] = a.w; } }
struct Args {
    const float *x_prompt, *x_sample, *cache_k, *cache_v, *state_conv, *c_prompt, *c_sample, *w_ada, *b_ada, *norm1_g, *norm2_g, *w_in, *q_norm_g, *k_norm_g,
        *lq1, *lk1, *lq2, *lk2, *sub_g, *w_ao, *conv_w, *w_co, *w_out, *w_gu, *w_dn;
    float* out; unsigned char* ws;
};

__device__ __forceinline__ void transpose_item(const float* W, int K, int N, bf16* WT, int kb, int n0, int drow, LAS float* scr, int lane) {
    const int k0 = 64 * kb;
#pragma unroll 8
    for (int i = 0; i < 32; ++i) { const int kk = 2 * i + (lane >> 5); scr[kk * 33 + (lane & 31)] = W[(size_t)(k0 + kk) * N + n0 + (lane & 31)]; }
    LDS_WAIT(); asm volatile("" ::: "memory");
    const int c = lane & 7;
#pragma unroll
    for (int j = 0; j < 4; ++j) { const int n = (lane >> 3) + 8 * j; const LAS float* s = scr + (8 * c) * 33 + n;
        v4u o; o.x = pk2(s[0 * 33], s[1 * 33]); o.y = pk2(s[2 * 33], s[3 * 33]); o.z = pk2(s[4 * 33], s[5 * 33]); o.w = pk2(s[6 * 33], s[7 * 33]);
        *(GAS v4u*)(WT + (size_t)(drow + n) * K + k0 + 8 * c) = o; }
    LDS_WAIT(); asm volatile("" ::: "memory");
}
__device__ __forceinline__ int win_drow(int c0) {
    const int sect = c0 >> 10, cc = c0 & 1023;
    if (sect == 3) return 256 * (12 + (cc >> 7)) + (cc & 127);
    if (sect == 5) return 256 * (12 + (cc >> 7)) + 128 + (cc & 127);
    const int tile = (sect < 3 ? sect * 4 : sect == 4 ? 20 : sect == 6 ? 24 : 28) + (cc >> 8), sl = cc & 255;
    return 256 * tile + 128 * ((sl >> 5) & 1) + 32 * (sl >> 6);
}
__device__ __forceinline__ int wgu_drow(int c0) { const int ch = c0 < FF ? c0 : c0 - FF; return 256 * (ch >> 7) + (c0 < FF ? 0 : 128) + (ch & 127); }

__device__ __forceinline__ void norm_row(const float* xrow, const float* g, const float* shift, const float* scale, bf16* orow, int lane) {
    const GAS f32x4* xr = (const GAS f32x4*)xrow + lane;
    f32x4 v[4]; float s = 0.f;
#pragma unroll
    for (int j = 0; j < 4; ++j) { v[j] = xr[64 * j]; s += (v[j].x * v[j].x + v[j].y * v[j].y) + (v[j].z * v[j].z + v[j].w * v[j].w); }
    const float rstd = __builtin_amdgcn_rsqf(wave_sum(s) * (1.f / D) + pg8::RMS_EPS);
    GAS unsigned long long* o8 = (GAS unsigned long long*)orow + lane;
#pragma unroll
    for (int j = 0; j < 4; ++j) { const int c = 4 * (lane + 64 * j); const f32x4 gg = *(const f32x4*)(g + c), sh = *(const f32x4*)(shift + c), sc = *(const f32x4*)(scale + c);
        const f32x4 o = v[j] * rstd * gg * (sc + 1.0f) + sh;
        o8[64 * j] = (unsigned long long)pk2(o.x, o.y) | ((unsigned long long)pk2(o.z, o.w) << 32); }
}

typedef short sbf16x8 __attribute__((ext_vector_type(8)));
typedef float sf32x16 __attribute__((ext_vector_type(16)));
__device__ __forceinline__ unsigned cvtpk2(float lo, float hi) { unsigned r; asm("v_cvt_pk_bf16_f32 %0, %1, %2" : "=v"(r) : "v"(lo), "v"(hi)); return r; }
__device__ __forceinline__ sbf16x8 pack_f8(f32x4 a, f32x4 b) { v4u w; w.x = cvtpk2(a.x, a.y); w.y = cvtpk2(a.z, a.w); w.z = cvtpk2(b.x, b.y); w.w = cvtpk2(b.z, b.w); return __builtin_bit_cast(sbf16x8, w); }
__device__ __forceinline__ int crow_(int r, int hi) { return (r & 3) + 8 * (r >> 2) + 4 * hi; }
__device__ __forceinline__ void sample_attn_item(const Args& A, LAS unsigned char* lds, int b, int h, int mm, int tid) {
    constexpr int SP = 1060, NK = PAST + TS;
    const bf16* Q = (const bf16*)(A.ws + WS_Q); const bf16* Kb = (const bf16*)(A.ws + WS_K); const bf16* Vb = (const bf16*)(A.ws + WS_V); bf16* O12 = (bf16*)(A.ws + WS_O12);
    LAS float* S = (LAS float*)lds;
    LAS float* linv = (LAS float*)(lds + 32 * SP * 4);
    const int lane = tid & 63, wave = __builtin_amdgcn_readfirstlane(tid >> 6), r32 = lane & 31, hi = lane >> 5;
    sbf16x8 qr[4];
#pragma unroll
    for (int d0 = 0; d0 < 4; ++d0) qr[d0] = *(const sbf16x8*)(Q + (size_t)(MP + b * TS + r32) * D + (h * 2 + mm) * 64 + d0 * 16 + hi * 8);
    for (int kb = wave; kb < NK / 32; kb += 8) {
        sbf16x8 kf[4];
        if (kb < PAST / 32) { const float* kp = A.cache_k + ((size_t)(b * PAST + kb * 32 + r32) * 8 + h) * 128 + mm * 64 + hi * 8;
#pragma unroll
            for (int d0 = 0; d0 < 4; ++d0) kf[d0] = pack_f8(*(const f32x4*)(kp + d0 * 16), *(const f32x4*)(kp + d0 * 16 + 4)); }
        else { const bf16* kp = Kb + (size_t)(MP + b * TS + r32) * D + (h * 2 + mm) * 64 + hi * 8;
#pragma unroll
            for (int d0 = 0; d0 < 4; ++d0) kf[d0] = *(const sbf16x8*)(kp + d0 * 16); }
        sf32x16 acc = sf32x16{};
#pragma unroll
        for (int d0 = 0; d0 < 4; ++d0) acc = __builtin_amdgcn_mfma_f32_32x32x16_bf16(kf[d0], qr[d0], acc, 0, 0, 0);
#pragma unroll
        for (int r = 0; r < 16; ++r) S[r32 * SP + kb * 32 + crow_(r, hi)] = acc[r];
    }
    __syncthreads();
#pragma unroll 1
    for (int ii = 0; ii < 4; ++ii) { const int i = 4 * wave + ii; LAS float* sr = S + i * SP;
        float mx = -INFINITY; for (int j = lane; j < NK; j += 64) mx = fmaxf(mx, sr[j]);
        mx = wave_max(mx); float sum = 0.f;
        for (int j = lane; j < NK; j += 64) { const float p = __builtin_amdgcn_exp2f(sr[j] - mx); sr[j] = p; sum += p; }
        sum = wave_sum(sum); if (lane == 0) linv[i] = 1.0f / sum; }
    __syncthreads();
    const int db = wave & 3, kh = wave >> 2;
    sf32x16 o = sf32x16{};
    for (int k2 = 33 * kh; k2 < 33 * kh + 33; ++k2) {
        const LAS f32x4* pp = (const LAS f32x4*)(S + r32 * SP + k2 * 16 + hi * 8);
        const sbf16x8 pa = pack_f8(pp[0], pp[1]);
        sbf16x8 vf;
        if (k2 < PAST / 16) { const float* vp = A.cache_v + ((size_t)(b * PAST + k2 * 16 + hi * 8) * 8 + h) * 128 + db * 32 + r32;
            f32x4 v0, v1; v0.x = vp[0]; v0.y = vp[1024]; v0.z = vp[2048]; v0.w = vp[3072]; v1.x = vp[4096]; v1.y = vp[5120]; v1.z = vp[6144]; v1.w = vp[7168];
            vf = pack_f8(v0, v1); }
        else { const bf16* vp = Vb + (size_t)(MP + b * TS + (k2 * 16 - PAST) + hi * 8) * D + h * 128 + db * 32 + r32;
            v4u w; w.x = (unsigned)vp[0] | ((unsigned)vp[1024] << 16); w.y = (unsigned)vp[2048] | ((unsigned)vp[3072] << 16); w.z = (unsigned)vp[4096] | ((unsigned)vp[5120] << 16); w.w = (unsigned)vp[6144] | ((unsigned)vp[7168] << 16);
            vf = __builtin_bit_cast(sbf16x8, w); }
        o = __builtin_amdgcn_mfma_f32_32x32x16_bf16(pa, vf, o, 0, 0, 0);
    }
    __syncthreads();
    LAS float* red = (LAS float*)lds;
    if (kh == 1) {
#pragma unroll
        for (int r = 0; r < 16; ++r) red[(db * 16 + r) * 64 + lane] = o[r]; }
    __syncthreads();
    if (kh == 0) {
#pragma unroll
        for (int r = 0; r < 16; ++r) { const int q = crow_(r, hi); const float v = (o[r] + red[(db * 16 + r) * 64 + lane]) * linv[q];
            O12[(size_t)(MP + b * TS + q) * 2048 + mm * 1024 + h * 128 + db * 32 + r32] = (bf16)f2bf(v); } }
    __syncthreads();
}

typedef float sf32x4 __attribute__((ext_vector_type(4)));
template <class F> __device__ __forceinline__ void small_gemm(const bf16* A, const bf16* Bt, int K, int vcu, int G, LAS unsigned char* lds, int tid, const F& f) {
    const int lane = tid & 63, wave = __builtin_amdgcn_readfirstlane(tid >> 6), fr = lane & 15, fq = lane >> 4, cb = wave & 3, kh = wave >> 2, K2 = K >> 1;
    for (int item = vcu; item < 256; item += G) {
        const int r0 = (item >> 4) * 16, c0 = (item & 15) * 64 + cb * 16;
        const bf16* ap = A + (size_t)(r0 + fr) * K + kh * K2 + fq * 8;
        const bf16* bp = Bt + (size_t)(c0 + fr) * K + kh * K2 + fq * 8;
        sf32x4 acc = {0.f, 0.f, 0.f, 0.f};
#pragma unroll 8
        for (int k = 0; k < K2; k += 32) acc = __builtin_amdgcn_mfma_f32_16x16x32_bf16(*(const sbf16x8*)(bp + k), *(const sbf16x8*)(ap + k), acc, 0, 0, 0);
        LAS sf32x4* red = (LAS sf32x4*)lds;
        if (kh == 1) red[cb * 64 + lane] = acc;
        __syncthreads();
        if (kh == 0) { acc += red[cb * 64 + lane]; f(MP + r0 + fr, c0 + 4 * fq, acc); }
        __syncthreads();
    }
}
__device__ __forceinline__ float sigm_(float x) { return __builtin_amdgcn_rcpf(1.0f + __builtin_amdgcn_exp2f(-1.4426950408889634f * x)); }
struct SmallGate0 { const bf16* G; float* T;
    __device__ __forceinline__ void operator()(int row, int col, sf32x4 acc) const { const size_t o = (size_t)row * 1024 + col; const v2u g = *(const v2u*)(G + o);
        sf32x4 s; s.x = sigm_(bflo(g.x)); s.y = sigm_(bfhi(g.x)); s.z = sigm_(bflo(g.y)); s.w = sigm_(bfhi(g.y)); *(sf32x4*)(T + o) = s * acc; } };
struct SmallGate1 { const bf16* G; const float* T; bf16* Mx;
    __device__ __forceinline__ void operator()(int row, int col, sf32x4 acc) const { const size_t o = (size_t)row * 1024 + col; const v2u g = *(const v2u*)(G + o);
        sf32x4 s; s.x = sigm_(bflo(g.x)); s.y = sigm_(bfhi(g.x)); s.z = sigm_(bflo(g.y)); s.w = sigm_(bfhi(g.y)); const sf32x4 v = *(const sf32x4*)(T + o) + s * acc;
        v2u w; w.x = pk2(v.x, v.y); w.y = pk2(v.z, v.w); *(v2u*)(Mx + o) = w; } };
struct SmallRes { const float* base; float* out; const float* gate;
    __device__ __forceinline__ void operator()(int row, int col, sf32x4 acc) const { const size_t o = (size_t)row * 1024 + col; const int mrow = 8 + ((row - MP) >> 5);
        const sf32x4 g = *(const sf32x4*)(gate + (size_t)mrow * 6144 + col); *(sf32x4*)(out + o) = *(const sf32x4*)(base + o) + g * acc; } };

typedef const __attribute__((address_space(4))) Args* kargs_t;
#define XB_TMO      128
#define XB_XCNT(j)  (256  + 64 * (j))
#define XB_XSUB(j)  (1280 + 64 * (j))
#define XB_XGEN(j)  (2304 + 64 * (j))
#define XB_TOP      3328
#define XB_TOPGEN   3392
#define XCD_BAR_WORDS 3456
#define XB_SPIN_CAP (1u << 22)

__device__ __forceinline__ unsigned xb_ld(unsigned* p)              { return __hip_atomic_load(p, __ATOMIC_RELAXED, __HIP_MEMORY_SCOPE_AGENT); }
__device__ __forceinline__ unsigned xb_add(unsigned* p, unsigned v) { return __hip_atomic_fetch_add(p, v, __ATOMIC_RELAXED, __HIP_MEMORY_SCOPE_AGENT); }
__device__ __forceinline__ unsigned xb_xcc_id() { return (unsigned)__builtin_amdgcn_s_getreg((3 << 11) | 20) & 0xFu; }
#define XB_SPIN(cond, bar) do { unsigned _sp = 0; while (cond) { __builtin_amdgcn_s_sleep(1); \
    if ((++_sp & 255u) == 0u) { if (xb_ld(&(bar)[XB_TMO])) break; if (_sp > XB_SPIN_CAP) { atomicAdd(&(bar)[XB_TMO], 1u); break; } } } } while (0)

struct XcdBarrier {
    unsigned* bar; unsigned x;
    volatile LAS unsigned* st;
};

__device__ __forceinline__ XcdBarrier xcd_barrier_post(unsigned* bar, volatile LAS unsigned* st) {
    XcdBarrier b; b.bar = bar; b.x = xb_xcc_id(); b.st = st;
    if (threadIdx.x == 0) (void)xb_add(&bar[XB_XCNT(b.x)], 1u);
    return b;
}
__device__ __forceinline__ void xcd_barrier_complete(unsigned* bar, unsigned x, unsigned& nloc, unsigned& nx) {
    const unsigned G = gridDim.x * gridDim.y * gridDim.z;
    unsigned sum, cnt, mine, sp = 0u;
    for (;;) {
        sum = 0u; cnt = 0u; mine = 0u;
#pragma unroll
        for (unsigned j = 0; j < 16; ++j) { const unsigned c = xb_ld(&bar[XB_XCNT(j)]); sum += c; cnt += (c > 0u) ? 1u : 0u; mine = (j == x) ? c : mine; }
        if (sum == G) break;
        __builtin_amdgcn_s_sleep(1);
        if ((++sp & 255u) == 0u) { if (xb_ld(&bar[XB_TMO])) break; if (sp > XB_SPIN_CAP) { atomicAdd(&bar[XB_TMO], 1u); break; } }
    }
    nloc = mine > 0u ? mine : 1u; nx = cnt > 0u ? cnt : 1u;
}

__device__ __forceinline__ void xcd_barrier(const XcdBarrier& b) {
    asm volatile("s_waitcnt vmcnt(0)" ::: "memory");
    __syncthreads();
    if (threadIdx.x == 0) {
        unsigned* bar = b.bar;
        __builtin_amdgcn_s_waitcnt(0);
        unsigned nloc = b.st[0], nx = b.st[1];
        if (nloc == 0u) { xcd_barrier_complete(bar, b.x, nloc, nx); b.st[0] = nloc; b.st[1] = nx; }
        const unsigned old = xb_add(&bar[XB_XSUB(b.x)], 1u);
        const unsigned gen = old / nloc;
        if (old + 1u == (gen + 1u) * nloc) {
            __builtin_amdgcn_fence(__ATOMIC_RELEASE, "agent");
            asm volatile("s_waitcnt vmcnt(0)" ::: "memory");
            const unsigned og = xb_add(&bar[XB_TOP], 1u);
            const unsigned tg = og / nx;
            if (og + 1u == (tg + 1u) * nx) xb_add(&bar[XB_TOPGEN], 1u);
            else XB_SPIN(xb_ld(&bar[XB_TOPGEN]) == tg, bar);
            __builtin_amdgcn_fence(__ATOMIC_ACQUIRE, "agent");
            xb_add(&bar[XB_XGEN(b.x)], 1u);
            asm volatile("s_waitcnt vmcnt(0)" ::: "memory");
        } else {
            XB_SPIN(xb_ld(&bar[XB_XGEN(b.x)]) == gen, bar);
            __builtin_amdgcn_fence(__ATOMIC_ACQUIRE, "agent");
            asm volatile("s_waitcnt vmcnt(0)" ::: "memory");
        }
    }
    __syncthreads();
}

#define XBAR() do { XcdBarrier xb_; xb_.bar = (unsigned*)(((const Args*)(kargs_t)__builtin_amdgcn_kernarg_segment_ptr())->ws + WS_BAR); xb_.x = xb_xcc_id(); xb_.st = (volatile LAS unsigned*)((LAS unsigned char*)lds_raw + XBAR_LDS_OFF); xcd_barrier(xb_); } while (0)
#define PHASE_BEGIN() \
    kargs_t ap_ = (kargs_t)__builtin_amdgcn_kernarg_segment_ptr(); asm volatile("" : "+s"(ap_)); const Args& A = *(const Args*)ap_; \
    int tid_ = threadIdx.x; asm volatile("" : "+v"(tid_)); const int tid = tid_, lane = tid & 63, wave = __builtin_amdgcn_readfirstlane(tid >> 6); \
    int G_ = gridDim.x, bx_ = blockIdx.x; asm volatile("" : "+s"(G_), "+s"(bx_)); const int G = G_, bx = bx_, vcu = (G % 8 == 0) ? (bx % 8) * (G / 8) + bx / 8 : bx; \
    const int gw = vcu * NWAVES + wave, NGW = G * NWAVES; unsigned char* const ws = A.ws; float* const mod = (float*)(ws + WS_MOD); \
    LAS unsigned char* const lds = (LAS unsigned char*)lds_raw; (void)lane; (void)gw; (void)NGW; (void)mod; (void)lds; (void)tid; (void)vcu;
__global__ void __launch_bounds__(NWAVES * 64, 2) fwd_megakernel(Args A_unused) {
    extern __shared__ __attribute__((aligned(16))) unsigned char lds_raw[];
    cg::grid_group grid = cg::this_grid();
    { if (threadIdx.x < 2) ((LAS unsigned*)((LAS unsigned char*)lds_raw + XBAR_LDS_OFF))[threadIdx.x] = 0u; __syncthreads();
      (void)xcd_barrier_post((unsigned*)(((const Args*)(kargs_t)__builtin_amdgcn_kernarg_segment_ptr())->ws + WS_BAR), (volatile LAS unsigned*)((LAS unsigned char*)lds_raw + XBAR_LDS_OFF)); }
    {
    PHASE_BEGIN();
    {
        LAS float* cs = (LAS float*)lds;
        LAS float* part = (LAS float*)(lds + 65536);
        bool have_cs = false;
        for (int item = bx; item < 192; item += G) {
            if (!have_cs) { for (int idx = tid; idx < 16384; idx += 512) { const int r = idx >> 10, k = idx & 1023; const float c = r < 8 ? A.c_prompt[r * 1024 + k] : A.c_sample[(r - 8) * 1024 + k]; cs[idx] = c * pg8::sigm(c); } have_cs = true; }
            __syncthreads();
            const int n0 = item * 32, slice = tid >> 5, col = tid & 31; float acc[16];
#pragma unroll
            for (int r = 0; r < 16; ++r) acc[r] = 0.f;
#pragma unroll 4
            for (int kk = 0; kk < 64; ++kk) { const int k = slice * 64 + kk; const float w = A.w_ada[(size_t)k * 6144 + n0 + col];
#pragma unroll
                for (int r = 0; r < 16; ++r) acc[r] += cs[r * 1024 + k] * w; }
#pragma unroll
            for (int r = 0; r < 16; ++r) part[(slice * 16 + r) * 32 + col] = acc[r];
            __syncthreads();
            { const int r = tid >> 5; float s = A.b_ada[n0 + col];
#pragma unroll
                for (int sl = 0; sl < 16; ++sl) s += part[(sl * 16 + r) * 32 + col];
                mod[r * 6144 + n0 + col] = s; }
            __syncthreads();
        }
        __syncthreads();
        LAS float* scr = (LAS float*)(lds + wave * 16384);
        constexpr int I_IN = 16 * 256, I_SQ = 16 * 32, I_GU = 16 * 176, I_DN = 44 * 32, NITEMS = I_IN + 3 * I_SQ + I_GU + I_DN;
        for (int it = gw; it < NITEMS; it += NGW) {
            int r = it;
            if (r < I_IN) { const int kb = r / 256, nb = r % 256; transpose_item(A.w_in, D, NIN, (bf16*)(ws + WS_WIN), kb, 32 * nb, win_drow(32 * nb), scr, lane); continue; } r -= I_IN;
            if (r < I_SQ) { transpose_item(A.w_ao, D, D, (bf16*)(ws + WS_WAO), r / 32, 32 * (r % 32), 32 * (r % 32), scr, lane); continue; } r -= I_SQ;
            if (r < I_SQ) { transpose_item(A.w_co, D, D, (bf16*)(ws + WS_WCO), r / 32, 32 * (r % 32), 32 * (r % 32), scr, lane); continue; } r -= I_SQ;
            if (r < I_SQ) { transpose_item(A.w_out, D, D, (bf16*)(ws + WS_WOUT), r / 32, 32 * (r % 32), 32 * (r % 32), scr, lane); continue; } r -= I_SQ;
            if (r < I_GU) { const int kb = r / 176, nb = r % 176; transpose_item(A.w_gu, D, NGU, (bf16*)(ws + WS_WGU), kb, 32 * nb, wgu_drow(32 * nb), scr, lane); continue; } r -= I_GU;
            transpose_item(A.w_dn, FF, D, (bf16*)(ws + WS_WDN), r / 32, 32 * (r % 32), 32 * (r % 32), scr, lane);
        }
    }
    }
    grid.sync();
    {
    PHASE_BEGIN();
    for (int m = gw; m < MT; m += NGW) {
        const float* xr = m < MP ? A.x_prompt + (size_t)m * D : A.x_sample + (size_t)(m - MP) * D;
        const float* mr = mod + (size_t)(m < MP ? (m >> 13) : 8 + ((m - MP) >> 5)) * 6144;
        norm_row(xr, A.norm1_g, mr, mr + 1024, (bf16*)(ws + WS_XN) + (size_t)m * D, lane);
    }
    }
    XBAR();
    {
    PHASE_BEGIN();
    {
        pg8::Gemm g{(const pg8::bf16_t*)(ws + WS_XN), (const pg8::bf16_t*)(ws + WS_WIN), MT, NIN, D}; pg8::StaticOrder S; S.init(MT, NIN, G, bx);
        pg8::EpiInProj E{(pg8::bf16_t*)(ws + WS_Q), (pg8::bf16_t*)(ws + WS_K), (pg8::bf16_t*)(ws + WS_V), (pg8::bf16_t*)(ws + WS_U), (pg8::bf16_t*)(ws + WS_GB),
                         (pg8::bf16_t*)(A.out), (pg8::bf16_t*)(A.out) + (size_t)MT * D, A.out, A.q_norm_g, A.k_norm_g};
        pg8::gemm_phase<pg8::EpiInProj, pg8::StaticOrder, true, true>(lds, g, S, E);
    }
    }
    XBAR();
    {
    PHASE_BEGIN();
    {
        const attn2::bf16* Qp = (const attn2::bf16*)(ws + WS_Q); const attn2::bf16* Kp = (const attn2::bf16*)(ws + WS_K); const attn2::bf16* Vp = (const attn2::bf16*)(ws + WS_V);
        attn2::bf16* Op = (attn2::bf16*)(ws + WS_ON);
        float* o2s = (float*)(ws + WS_O12) + (size_t)vcu * 32768;
        const float mq = wave_max(fabsf(A.q_norm_g[lane])), mk = wave_max(fabsf(A.k_norm_g[lane]));
        const float mshift = __uint_as_float(__builtin_amdgcn_readfirstlane(__float_as_uint(fmaxf(0.f, 64.f * pg8::QK_C2 * mq * mk * 1.02f - 64.f))));
        const float lam = __uint_as_float(__builtin_amdgcn_readfirstlane(__float_as_uint(__expf(wave_sum(A.lq1[lane] * A.lk1[lane])) - __expf(wave_sum(A.lq2[lane] * A.lk2[lane])) + LAM0)));
        const float* subg = A.sub_g;
        float* const kout = A.out + pg8::O_KP; float* const vout = A.out + pg8::O_VP;
#define ATTN_RUN(SH) do { \
        if (G == 256) { const int b = vcu >> 5, lc = vcu & 31, g2 = lc >> 4, s = lc & 15; \
            for (int u = 0; u < 16; ++u) { const int h = 2 * (u >> 2) + g2, mm = 1 - (u & 1), qb = (u & 2) ? 31 - s : s; \
                attn2::attn_unit<SH, 1024>(b, (h * 2 + mm) * 64, h * 128, h * 128, qb, mshift, mm == 0, lam, subg, 1.0f - LAM0, o2s, kout, vout, Qp, Kp, Vp, Op, (char*)lds_raw); } \
        } else { \
            for (int it = vcu; it < 8 * 8 * 32; it += G) { const int b = it >> 8, h = (it >> 5) & 7, qb = it & 31; \
                for (int mm = 1; mm >= 0; --mm) \
                    attn2::attn_unit<SH, 1024>(b, (h * 2 + mm) * 64, h * 128, h * 128, qb, mshift, mm == 0, lam, subg, 1.0f - LAM0, o2s, kout, vout, Qp, Kp, Vp, Op, (char*)lds_raw); } \
        } } while (0)
        if (mshift == 0.f) ATTN_RUN(false); else ATTN_RUN(true);
#undef ATTN_RUN
        asm volatile("s_waitcnt vmcnt(0) lgkmcnt(0)" ::: "memory"); __syncthreads();
        for (int it = (G - 1 - vcu); it < 128; it += G) sample_attn_item(A, lds, it >> 4, (it >> 1) & 7, it & 1, tid);
    }
    }
    XBAR();
    {
    PHASE_BEGIN();
    {
        float lam;
        { const float p1 = lane < 64 ? A.lq1[lane] * A.lk1[lane] : 0.f, p2 = A.lq2[lane] * A.lk2[lane]; lam = __expf(wave_sum(p1)) - __expf(wave_sum(p2)) + LAM0; }
        const bf16* O12 = (const bf16*)(ws + WS_O12); bf16* ON = (bf16*)(ws + WS_ON); const bf16* U = (const bf16*)(ws + WS_U); bf16* GBp = (bf16*)(ws + WS_GB);
        const int c16 = 16 * lane;
        float sg[16], w0[16], w1[16], w2[16];
#pragma unroll
        for (int i = 0; i < 16; ++i) { sg[i] = A.sub_g[(c16 + i) & 127] * (1.0f - LAM0); w0[i] = A.conv_w[c16 + i]; w1[i] = A.conv_w[1024 + c16 + i]; w2[i] = A.conv_w[2048 + c16 + i]; }
        for (int m = gw; m < MT; m += NGW) {
            if (m >= MP) { const v4u* p1 = (const v4u*)(O12 + (size_t)m * 2048 + c16); const v4u* p2 = (const v4u*)(O12 + (size_t)m * 2048 + 1024 + c16);
              float o[16]; float ss = 0.f;
#pragma unroll
              for (int e = 0; e < 2; ++e) { const v4u a = p1[e], c = p2[e];
                  o[8 * e + 0] = bflo(a.x) - lam * bflo(c.x); o[8 * e + 1] = bfhi(a.x) - lam * bfhi(c.x); o[8 * e + 2] = bflo(a.y) - lam * bflo(c.y); o[8 * e + 3] = bfhi(a.y) - lam * bfhi(c.y);
                  o[8 * e + 4] = bflo(a.z) - lam * bflo(c.z); o[8 * e + 5] = bfhi(a.z) - lam * bfhi(c.z); o[8 * e + 6] = bflo(a.w) - lam * bflo(c.w); o[8 * e + 7] = bfhi(a.w) - lam * bfhi(c.w); }
#pragma unroll
              for (int i = 0; i < 16; ++i) ss += o[i] * o[i];
              ss += __shfl_xor(ss, 1); ss += __shfl_xor(ss, 2); ss += __shfl_xor(ss, 4);
              const float rstd = __builtin_amdgcn_rsqf(ss * (1.0f / 128.0f) + pg8::RMS_EPS);
              v4u w[2];
#pragma unroll
              for (int e = 0; e < 2; ++e) { w[e].x = pk2(o[8 * e + 0] * rstd * sg[8 * e + 0], o[8 * e + 1] * rstd * sg[8 * e + 1]); w[e].y = pk2(o[8 * e + 2] * rstd * sg[8 * e + 2], o[8 * e + 3] * rstd * sg[8 * e + 3]);
                  w[e].z = pk2(o[8 * e + 4] * rstd * sg[8 * e + 4], o[8 * e + 5] * rstd * sg[8 * e + 5]); w[e].w = pk2(o[8 * e + 6] * rstd * sg[8 * e + 6], o[8 * e + 7] * rstd * sg[8 * e + 7]); }
              v4u* po = (v4u*)(ON + (size_t)m * D + c16); po[0] = w[0]; po[1] = w[1]; }
            { const bool smp = m >= MP; const int t = smp ? ((m - MP) & 31) : (m & 8191); const int sb = (m - MP) >> 5;
              float u0[16], u1[16], u2[16], gbv[16];
              ld16(U + (size_t)m * D + c16, u0); ld16(GBp + (size_t)m * D + c16, gbv);
              if (t >= 1) ld16(U + (size_t)(m - 1) * D + c16, u1);
              else if (smp) ldf(A.state_conv + (size_t)(sb * 2 + 1) * 1024 + c16, u1);
              else {
#pragma unroll
                  for (int i = 0; i < 16; ++i) u1[i] = 0.f; }
              if (t >= 2) ld16(U + (size_t)(m - 2) * D + c16, u2);
              else if (smp) ldf(A.state_conv + (size_t)(sb * 2 + t) * 1024 + c16, u2);
              else {
#pragma unroll
                  for (int i = 0; i < 16; ++i) u2[i] = 0.f; }
              v4u w[2]; float z[16];
#pragma unroll
              for (int i = 0; i < 16; ++i) z[i] = gbv[i] * (w0[i] * u2[i] + w1[i] * u1[i] + w2[i] * u0[i]);
#pragma unroll
              for (int e = 0; e < 2; ++e) { w[e].x = pk2(z[8 * e + 0], z[8 * e + 1]); w[e].y = pk2(z[8 * e + 2], z[8 * e + 3]); w[e].z = pk2(z[8 * e + 4], z[8 * e + 5]); w[e].w = pk2(z[8 * e + 6], z[8 * e + 7]); }
              v4u* po = (v4u*)(GBp + (size_t)m * D + c16); po[0] = w[0]; po[1] = w[1]; }
        }
    }
    }
    XBAR();
    {
    PHASE_BEGIN();
    {
        { pg8::PairOrder S; S.base.init(MP, D, G, bx);
          pg8::Gemm g{(const pg8::bf16_t*)(ws + WS_ON), (const pg8::bf16_t*)(ws + WS_WAO), MP, D, D, (const pg8::bf16_t*)(ws + WS_GB), (const pg8::bf16_t*)(ws + WS_WCO)};
          pg8::EpiGatePair E{(const pg8::bf16_t*)(A.out), (const pg8::bf16_t*)(A.out) + (size_t)MT * D, (pg8::bf16_t*)(ws + WS_MX)};
          pg8::gemm_phase<pg8::EpiGatePair, pg8::PairOrder, true, true>(lds, g, S, E); }
        small_gemm((const bf16*)(ws + WS_ON) + (size_t)MP * D, (const bf16*)(ws + WS_WAO), D, vcu, G, lds, tid, SmallGate0{(const bf16*)(A.out), (float*)(ws + WS_T)});
        small_gemm((const bf16*)(ws + WS_GB) + (size_t)MP * D, (const bf16*)(ws + WS_WCO), D, vcu, G, lds, tid, SmallGate1{(const bf16*)(A.out) + (size_t)MT * D, (const float*)(ws + WS_T), (bf16*)(ws + WS_MX)});
    }
    }
    XBAR();
    {
    PHASE_BEGIN();
    {
        pg8::Gemm g{(const pg8::bf16_t*)(ws + WS_MX), (const pg8::bf16_t*)(ws + WS_WOUT), MP, D, D}; pg8::StaticOrder S; S.init(MP, D, G, bx);
        pg8::EpiRes E{A.x_prompt, A.x_sample - (size_t)MP * D, A.out, mod + 2 * 1024};
        pg8::gemm_phase<pg8::EpiRes, pg8::StaticOrder, true, true>(lds, g, S, E);
        small_gemm((const bf16*)(ws + WS_MX) + (size_t)MP * D, (const bf16*)(ws + WS_WOUT), D, vcu, G, lds, tid, SmallRes{A.x_sample - (size_t)MP * D, A.out, mod + 2 * 1024});
    }
    }
    XBAR();
    {
    PHASE_BEGIN();
    for (int m = gw; m < MT; m += NGW) {
        const float* mr = mod + (size_t)(m < MP ? (m >> 13) : 8 + ((m - MP) >> 5)) * 6144;
        norm_row(A.out + (size_t)m * D, A.norm2_g, mr + 3 * 1024, mr + 4 * 1024, (bf16*)(ws + WS_XN2) + (size_t)m * D, lane);
    }
    }
    XBAR();
    {
    PHASE_BEGIN();
    {
        pg8::Gemm g{(const pg8::bf16_t*)(ws + WS_XN2), (const pg8::bf16_t*)(ws + WS_WGU), MT, NGU, D}; pg8::StaticOrder S; S.init(MT, NGU, G, bx);
        pg8::EpiSwiglu E{(pg8::bf16_t*)(ws + WS_ACT)};
        pg8::gemm_phase<pg8::EpiSwiglu, pg8::StaticOrder, true, true>(lds, g, S, E);
    }
    }
    XBAR();
    {
    PHASE_BEGIN();
    {
        pg8::Gemm g{(const pg8::bf16_t*)(ws + WS_ACT), (const pg8::bf16_t*)(ws + WS_WDN), MP, D, FF}; pg8::StaticOrder S; S.init(MP, D, G, bx);
        pg8::EpiRes E{A.out, A.out, A.out, mod + 5 * 1024};
        pg8::gemm_phase<pg8::EpiRes, pg8::StaticOrder, true, true>(lds, g, S, E);
        small_gemm((const bf16*)(ws + WS_ACT) + (size_t)MP * FF, (const bf16*)(ws + WS_WDN), FF, vcu, G, lds, tid, SmallRes{A.out, A.out, mod + 5 * 1024});
    }
    }
}

extern "C" void kernel_launch(void* const* d_in, const int* in_sizes, int n_in, void* d_out, int out_size, void* d_ws, size_t ws_size, hipStream_t stream) {
    static int grid = 0;
    if (grid == 0) {
        if (n_in != 25 || (size_t)out_size != pg8::O_END || ws_size < WS_END) { fprintf(stderr, "kernel_launch: unexpected shapes: n_in %d out %d ws %zu\n", n_in, out_size, ws_size); grid = -1; return; }
        int dev = 0, cus = 0, per_cu = 0;
        hipGetDevice(&dev); hipDeviceGetAttribute(&cus, hipDeviceAttributeMultiprocessorCount, dev);
        if (hipFuncSetAttribute((const void*)fwd_megakernel, hipFuncAttributeMaxDynamicSharedMemorySize, LDS_BYTES) != hipSuccess) { fprintf(stderr, "kernel_launch: hipFuncSetAttribute failed\n"); grid = -1; return; }
        if (hipOccupancyMaxActiveBlocksPerMultiprocessor(&per_cu, (const void*)fwd_megakernel, NWAVES * 64, LDS_BYTES) != hipSuccess || per_cu < 1) { fprintf(stderr, "kernel_launch: occupancy query gave %d\n", per_cu); per_cu = 1; }
        (void)hipGetLastError();
        grid = cus * 1;
    }
    if (grid < 0) return;
    Args a{};
    const float** f = (const float**)&a;
    for (int i = 0; i < 25; ++i) f[i] = (const float*)d_in[i];
    a.out = (float*)d_out; a.ws = (unsigned char*)d_ws;
    if (hipMemsetAsync((char*)d_ws + WS_BAR, 0, 16384, stream) != hipSuccess) { fprintf(stderr, "kernel_launch: hipMemsetAsync failed\n"); return; }
    void* args[] = {&a};
    hipError_t e = hipLaunchCooperativeKernel((const void*)fwd_megakernel, dim3(grid), dim3(NWAVES * 64), args, LDS_BYTES, stream);
    if (e != hipSuccess) fprintf(stderr, "cooperative launch failed: %s (grid %d)\n", hipGetErrorString(e), grid);
}
```

```cpp
#include <hip/hip_runtime.h>
#include <cstdio>
#include <cstdint>
namespace pg8 {
#define PG8_LAS __attribute__((address_space(3)))
typedef unsigned short bf16_t;
typedef short bf16x8 __attribute__((ext_vector_type(8)));
typedef float f32x4 __attribute__((ext_vector_type(4)));
typedef unsigned u32x4 __attribute__((ext_vector_type(4)));
constexpr int BM = 256, BK = 64, HALF = 128, HTB = HALF * BK * 2  , STAGE_BYTES = 8 * HTB, NXCD = 8, WGM = 8;

__host__ __device__ __forceinline__ int lds_byte(int r, int c) { const int st = (r >> 4) * 2 + (c >> 5), rr = r & 15, cc = c & 31, ob = rr * 64 + cc * 2; return st * 1024 + (ob ^ (((ob >> 9) & 1) << 5)); }
__host__ __device__ __forceinline__ void stage_rc(int b, int& R, int& C) { const int st = b / 1024, sb = b % 1024, swz = sb ^ (((sb >> 9) & 1) << 5); R = (st >> 1) * 16 + swz / 64; C = (st & 1) * 32 + (swz % 64) / 2; }
__host__ __device__ __forceinline__ int perm32(int rho) { const int n = rho >> 4, i = rho & 15; return 8 * (i >> 2) + 4 * n + (i & 3); }

struct Unit { int pm, pn, seg; };
struct Gemm { const bf16_t* A; const bf16_t* Bt; int M, N, K; const bf16_t* A2; const bf16_t* Bt2; };

struct StaticOrder {
    int nM, nN, nwg, G, c;
    __host__ __device__ void init(int M, int N, int G_, int c_) { nM = M / BM; nN = N / BM; nwg = nM * nN; G = G_; c = c_; }
    __host__ __device__ bool next(int i, Unit& u) const {
        const long L = (long)i * G + c; if (L >= nwg) return false;
        int wgid = (int)L; { const int q = nwg / NXCD, r = nwg % NXCD, xcd = wgid % NXCD, off = wgid / NXCD; wgid = (xcd < r ? xcd * (q + 1) : r * (q + 1) + (xcd - r) * q) + off; }
        const int nig = WGM * nN, gid = wgid / nig, fm = gid * WGM, gsz = (nM - fm) < WGM ? (nM - fm) : WGM;
        u.pm = fm + ((wgid % nig) % gsz); u.pn = (wgid % nig) / gsz; u.seg = 0; return true;
    }
    __device__ __forceinline__ void a_ready(const Unit&) const {}
    __device__ __forceinline__ void done(const Unit&) const {}
};

__device__ __forceinline__ unsigned cvt_pk_bf16(float lo, float hi) { unsigned r; asm volatile("v_cvt_pk_bf16_f32 %0, %1, %2" : "=v"(r) : "v"(lo), "v"(hi)); return r; }
typedef float f32x2 __attribute__((ext_vector_type(2)));
constexpr int MP = 65536, MS = 256, MT = MP + MS;
constexpr size_t O_Y = 0, O_KP = (size_t)MT * 1024, O_VP = O_KP + (size_t)MP * 1024, O_CP = O_VP + (size_t)MP * 1024, O_KS = O_CP + 16384, O_VS = O_KS + (size_t)MS * 1024, O_CS = O_VS + (size_t)MS * 1024, O_END = O_CS + 16384;
constexpr float QK_C2 = 0.125f * 1.4426950408889634f;
constexpr float RMS_EPS = 1e-6f;
__device__ __forceinline__ float bf_lo(unsigned w) { return __uint_as_float(w << 16); }
__device__ __forceinline__ float bf_hi(unsigned w) { return __uint_as_float(w & 0xffff0000u); }
__device__ __forceinline__ float sigm(float x) { return __builtin_amdgcn_rcpf(1.0f + __builtin_amdgcn_exp2f(-1.4426950408889634f * x)); }
__device__ __forceinline__ u32x4 pack8(f32x4 a, f32x4 b) { u32x4 w; w.x = cvt_pk_bf16(a[0], a[1]); w.y = cvt_pk_bf16(a[2], a[3]); w.z = cvt_pk_bf16(b[0], b[1]); w.w = cvt_pk_bf16(b[2], b[3]); return w; }

struct EpiInProj {
    static constexpr bool PERM = true, AFTER_DRAIN = false, PAIRED = false;
    bf16_t *Q, *Kb, *Vb, *U, *GB, *GA2, *GB2; float* out; const float *qg, *kg;
    __device__ __forceinline__ void operator()(const f32x4 (&acc)[2][2][4][2], const Unit& u, int wr, int wc, int fr, int fq) const {
        const int pn = u.pn, pm = u.pm; const bool smp = pm >= (MP / BM);
        const int row0 = pm * BM + wr * 64 + fr;
        if (pn >= 12 && pn < 20) {
            const int col = 128 * (pn - 12) + 32 * wc + 8 * fq;
#pragma unroll
            for (int ai = 0; ai < 2; ++ai)
#pragma unroll
                for (int m = 0; m < 4; ++m) { const int row = row0 + ai * HALF + m * 16;
                    const f32x4 a0 = acc[ai][0][m][0] * acc[ai][1][m][0], a1 = acc[ai][0][m][1] * acc[ai][1][m][1];
                    *(u32x4*)(U + (size_t)row * 1024 + col) = pack8(a0, a1);
                    if (!smp) { const int t = row & 8191; if (t >= 8190) { float* o = out + O_CP + (size_t)((row >> 13) * 2 + (t - 8190)) * 1024 + col; *(f32x4*)o = a0; *(f32x4*)(o + 4) = a1; } }
                    else { const int lr = row - MP, t = lr & 31; if (t >= 30) { float* o = out + O_CS + (size_t)((lr >> 5) * 2 + (t - 30)) * 1024 + col; *(f32x4*)o = a0; *(f32x4*)(o + 4) = a1; } }
                }
            return;
        }
        int sect, tloc; if (pn < 12) { sect = pn >> 2; tloc = pn & 3; } else { sect = 3 + ((pn - 20) >> 2); tloc = (pn - 20) & 3; }
        bf16_t* dst = sect == 0 ? Q : sect == 1 ? Kb : sect == 2 ? Vb : sect == 3 ? GB : sect == 4 ? GA2 : GB2;
        const int col0 = 256 * tloc + 64 * wc + 8 * fq;
        float* fo = nullptr;
        if (sect == 1 && smp) fo = out + O_KS - (size_t)MP * 1024;
        if (sect == 2 && smp) fo = out + O_VS - (size_t)MP * 1024;
        f32x4 g[2][2];
        if (sect < 2) { const float* gp = (sect == 0 ? qg : kg) + 8 * fq; const float sc = sect == 0 ? QK_C2 : 1.0f;
#pragma unroll
            for (int bj = 0; bj < 2; ++bj)
#pragma unroll
                for (int n = 0; n < 2; ++n) g[bj][n] = *(const f32x4*)(gp + 32 * bj + 4 * n) * sc; }
#pragma unroll
        for (int ai = 0; ai < 2; ++ai)
#pragma unroll
            for (int m = 0; m < 4; ++m) { const int row = row0 + ai * HALF + m * 16;
                f32x4 v[2][2];
#pragma unroll
                for (int bj = 0; bj < 2; ++bj)
#pragma unroll
                    for (int n = 0; n < 2; ++n) v[bj][n] = acc[ai][bj][m][n];
                if (sect < 2) { float ss = 0.f;
#pragma unroll
                    for (int bj = 0; bj < 2; ++bj)
#pragma unroll
                        for (int n = 0; n < 2; ++n) { const f32x4 x = v[bj][n]; ss += (x[0] * x[0] + x[1] * x[1]) + (x[2] * x[2] + x[3] * x[3]); }
                    ss += __shfl_xor(ss, 16); ss += __shfl_xor(ss, 32);
                    const float rstd = __builtin_amdgcn_rsqf(ss * (1.0f / 64.0f) + RMS_EPS);
#pragma unroll
                    for (int bj = 0; bj < 2; ++bj)
#pragma unroll
                        for (int n = 0; n < 2; ++n) v[bj][n] = v[bj][n] * rstd * g[bj][n]; }
#pragma unroll
                for (int bj = 0; bj < 2; ++bj) { *(u32x4*)(dst + (size_t)row * 1024 + col0 + 32 * bj) = pack8(v[bj][0], v[bj][1]);
                    if (fo) { float* o = fo + (size_t)row * 1024 + col0 + 32 * bj; *(f32x4*)o = v[bj][0]; *(f32x4*)(o + 4) = v[bj][1]; } }
            }
    }
};
template <int STEP> struct EpiGate {
    static constexpr bool PERM = true, AFTER_DRAIN = false, PAIRED = false;
    const bf16_t* G; float* T; bf16_t* Mx;
    __device__ __forceinline__ void operator()(const f32x4 (&acc)[2][2][4][2], const Unit& u, int wr, int wc, int fr, int fq) const {
        const int row0 = u.pm * BM + wr * 64 + fr, col0 = u.pn * BM + wc * 32 + 8 * fq;
#pragma unroll
        for (int ai = 0; ai < 2; ++ai)
#pragma unroll
            for (int m = 0; m < 4; ++m) { const size_t ro = (size_t)(row0 + ai * HALF + m * 16) * 1024 + col0;
#pragma unroll
                for (int bj = 0; bj < 2; ++bj) { const size_t o = ro + bj * HALF; const u32x4 gw = *(const u32x4*)(G + o);
                    f32x4 s0, s1; s0[0] = sigm(bf_lo(gw.x)); s0[1] = sigm(bf_hi(gw.x)); s0[2] = sigm(bf_lo(gw.y)); s0[3] = sigm(bf_hi(gw.y));
                    s1[0] = sigm(bf_lo(gw.z)); s1[1] = sigm(bf_hi(gw.z)); s1[2] = sigm(bf_lo(gw.w)); s1[3] = sigm(bf_hi(gw.w));
                    f32x4 v0 = s0 * acc[ai][bj][m][0], v1 = s1 * acc[ai][bj][m][1];
                    if (STEP == 0) { *(f32x4*)(T + o) = v0; *(f32x4*)(T + o + 4) = v1; }
                    else { v0 += *(const f32x4*)(T + o); v1 += *(const f32x4*)(T + o + 4); *(u32x4*)(Mx + o) = pack8(v0, v1); } } }
    }
};
struct EpiRes {
    static constexpr bool PERM = true, AFTER_DRAIN = false, PAIRED = false;
    const float* baseP; const float* baseS; float* out; const float* gate;
    __device__ __forceinline__ void operator()(const f32x4 (&acc)[2][2][4][2], const Unit& u, int wr, int wc, int fr, int fq) const {
        const bool smp = u.pm >= (MP / BM); const float* base = smp ? baseS : baseP;
        const int lr0 = wr * 64 + fr, row0 = u.pm * BM + lr0, col0 = u.pn * BM + wc * 32 + 8 * fq;
#pragma unroll
        for (int ai = 0; ai < 2; ++ai)
#pragma unroll
            for (int m = 0; m < 4; ++m) { const int lr = lr0 + ai * HALF + m * 16; const size_t ro = (size_t)(row0 + ai * HALF + m * 16) * 1024 + col0;
                const int mrow = smp ? 8 + (lr >> 5) : (u.pm >> 5); const float* gp = gate + (size_t)mrow * 6144 + col0;
#pragma unroll
                for (int bj = 0; bj < 2; ++bj) { const size_t o = ro + bj * HALF;
                    const f32x4 g0 = *(const f32x4*)(gp + bj * HALF), g1 = *(const f32x4*)(gp + bj * HALF + 4);
                    const f32x4 b0 = *(const f32x4*)(base + o), b1 = *(const f32x4*)(base + o + 4);
                    *(f32x4*)(out + o) = b0 + g0 * acc[ai][bj][m][0]; *(f32x4*)(out + o + 4) = b1 + g1 * acc[ai][bj][m][1]; } }
    }
};
struct EpiSwiglu {
    static constexpr bool PERM = true, AFTER_DRAIN = false, PAIRED = false;
    bf16_t* ACT;
    __device__ __forceinline__ void operator()(const f32x4 (&acc)[2][2][4][2], const Unit& u, int wr, int wc, int fr, int fq) const {
        const int row0 = u.pm * BM + wr * 64 + fr, col0 = u.pn * HALF + wc * 32 + 8 * fq;
#pragma unroll
        for (int ai = 0; ai < 2; ++ai)
#pragma unroll
            for (int m = 0; m < 4; ++m) { f32x4 r[2];
#pragma unroll
                for (int n = 0; n < 2; ++n) { const f32x4 g = acc[ai][0][m][n], up = acc[ai][1][m][n];
#pragma unroll
                    for (int i = 0; i < 4; ++i) r[n][i] = g[i] * sigm(g[i]) * up[i]; }
                *(u32x4*)(ACT + (size_t)(row0 + ai * HALF + m * 16) * 2816 + col0) = pack8(r[0], r[1]); }
    }
};
struct PairOrder { StaticOrder base;
    __device__ __forceinline__ bool next(int i, Unit& u) const { if (!base.next(i >> 1, u)) return false; u.seg = i & 1; return true; }
    __device__ __forceinline__ void a_ready(const Unit&) const {}
    __device__ __forceinline__ void done(const Unit&) const {} };
struct EpiGatePair {
    static constexpr bool PERM = true, AFTER_DRAIN = false, PAIRED = true;
    const bf16_t* GA; const bf16_t* GBr; bf16_t* Mx;
    static __device__ __forceinline__ float em(float x) { return __builtin_amdgcn_exp2f(-1.4426950408889634f * x); }
    __device__ __forceinline__ void mid(f32x4 (&acc)[2][2][4][2], const Unit& u, int wr, int wc, int fr, int fq) const {
        const int row0 = u.pm * BM + wr * 64 + fr, col0 = u.pn * BM + wc * 32 + 8 * fq;
#pragma unroll
        for (int ai = 0; ai < 2; ++ai)
#pragma unroll
            for (int m = 0; m < 4; ++m) { const size_t ro = (size_t)(row0 + ai * HALF + m * 16) * 1024 + col0;
#pragma unroll
                for (int bj = 0; bj < 2; ++bj) { const size_t o = ro + bj * HALF; const u32x4 a = *(const u32x4*)(GA + o), b = *(const u32x4*)(GBr + o);
                    const unsigned aw[4] = {a.x, a.y, a.z, a.w}, bw[4] = {b.x, b.y, b.z, b.w};
#pragma unroll
                    for (int j = 0; j < 4; ++j) { const float r0 = (1.0f + em(fmaxf(bf_lo(bw[j]), -30.f))) * __builtin_amdgcn_rcpf(1.0f + em(bf_lo(aw[j]))), r1 = (1.0f + em(fmaxf(bf_hi(bw[j]), -30.f))) * __builtin_amdgcn_rcpf(1.0f + em(bf_hi(aw[j])));
                        acc[ai][bj][m][j >> 1][2 * (j & 1)] *= r0; acc[ai][bj][m][j >> 1][2 * (j & 1) + 1] *= r1; } } }
    }
    __device__ __forceinline__ void operator()(const f32x4 (&acc)[2][2][4][2], const Unit& u, int wr, int wc, int fr, int fq) const {
        const int row0 = u.pm * BM + wr * 64 + fr, col0 = u.pn * BM + wc * 32 + 8 * fq;
#pragma unroll
        for (int ai = 0; ai < 2; ++ai)
#pragma unroll
            for (int m = 0; m < 4; ++m) { const size_t ro = (size_t)(row0 + ai * HALF + m * 16) * 1024 + col0;
#pragma unroll
                for (int bj = 0; bj < 2; ++bj) { const size_t o = ro + bj * HALF; const u32x4 b = *(const u32x4*)(GBr + o);
                    f32x4 s0, s1; s0[0] = sigm(fmaxf(bf_lo(b.x), -30.f)); s0[1] = sigm(fmaxf(bf_hi(b.x), -30.f)); s0[2] = sigm(fmaxf(bf_lo(b.y), -30.f)); s0[3] = sigm(fmaxf(bf_hi(b.y), -30.f));
                    s1[0] = sigm(fmaxf(bf_lo(b.z), -30.f)); s1[1] = sigm(fmaxf(bf_hi(b.z), -30.f)); s1[2] = sigm(fmaxf(bf_lo(b.w), -30.f)); s1[3] = sigm(fmaxf(bf_hi(b.w), -30.f));
                    *(u32x4*)(Mx + o) = pack8(s0 * acc[ai][bj][m][0], s1 * acc[ai][bj][m][1]); } }
    }
};
template <class Epi, class Sched, bool ALIGN_EPI = false, bool SP2 = false>
__device__ __forceinline__ void gemm_phase(PG8_LAS unsigned char* lds, const Gemm g, const Sched& S, const Epi& E) {
    int tid_ = threadIdx.x; asm volatile("" : "+v"(tid_));
    const int tid = tid_, wid = __builtin_amdgcn_readfirstlane(tid >> 6), lane = tid & 63, wr = wid >> 2, wc = wid & 3, fr = lane & 15, fq = lane >> 4;
    const int K = g.K, nt = K / BK;
    unsigned voffA[2], voffB[2];
#pragma unroll
    for (int i = 0; i < 2; ++i) { int R, C; stage_rc(tid * 16 + i * 8192, R, C); const int Rb = Epi::PERM ? ((R & ~31) + perm32(R & 31)) : R;
        voffA[i] = (unsigned)(R * K + C) * 2u; voffB[i] = (unsigned)(Rb * K + C) * 2u; }
    const size_t kstep = (size_t)(BK * 2);
    const size_t hstep = (size_t)HALF * K * 2;
    const size_t tstep = 2 * hstep;
    const unsigned ldsw = (unsigned)wid * 1024u;
    const int aoff = lds_byte(wr * 64 + fr, fq * 8), boff = lds_byte(wc * 32 + fr, fq * 8);
#define PG8_SA(b, h) (((b) * 2 + (h)) * HTB)
#define PG8_SB(b, h) ((4 + (b) * 2 + (h)) * HTB)
#define PG8_STAGE(bufoff, gbase, voff) do { _Pragma("unroll") for (int _i = 0; _i < 2; ++_i) \
        __builtin_amdgcn_global_load_lds((const unsigned*)((const char*)(gbase) + (voff)[_i]), (PG8_LAS unsigned*)(lds + (bufoff) + ldsw + _i * 8192), 16, 0, 0); } while (0)
#define PG8_LDA(dst, b, h) do { _Pragma("unroll") for (int m = 0; m < 4; ++m) _Pragma("unroll") for (int k = 0; k < 2; ++k) dst[m][k] = *(const PG8_LAS bf16x8*)(lds + PG8_SA(b, h) + aoff + m * 2048 + k * 1024); } while (0)
#define PG8_LDB(dst, b, h) do { _Pragma("unroll") for (int n = 0; n < 2; ++n) _Pragma("unroll") for (int k = 0; k < 2; ++k) dst[n][k] = *(const PG8_LAS bf16x8*)(lds + PG8_SB(b, h) + boff + n * 2048 + k * 1024); } while (0)
#define PG8_MMA(ai, bj, At, Bt) do { __builtin_amdgcn_s_setprio(1); _Pragma("unroll") for (int m = 0; m < 4; ++m) _Pragma("unroll") for (int n = 0; n < 2; ++n) _Pragma("unroll") for (int k = 0; k < 2; ++k) \
        acc[ai][bj][m][n] = __builtin_amdgcn_mfma_f32_16x16x32_bf16(Bt[n][k], At[m][k], acc[ai][bj][m][n], 0, 0, 0); __builtin_amdgcn_s_setprio(0); } while (0)
#define PG8_WAIT_V(n) asm volatile("s_waitcnt vmcnt(" #n ")" ::: "memory")
#define PG8_WAIT_L(n) asm volatile("s_waitcnt lgkmcnt(" #n ")" ::: "memory")
#define PG8_BAR __builtin_amdgcn_s_barrier()
#define PG8_SCHED __builtin_amdgcn_sched_barrier(0)
    Unit cur, nxt; int ui = 0;
    if (!S.next(0, cur)) return;
    f32x4 acc[2][2][4][2];
#pragma unroll
    for (int a = 0; a < 2; ++a)
#pragma unroll
        for (int b = 0; b < 2; ++b)
#pragma unroll
            for (int m = 0; m < 4; ++m)
#pragma unroll
                for (int n = 0; n < 2; ++n) acc[a][b][m][n] = (f32x4){0.f, 0.f, 0.f, 0.f};
    bf16x8 At[4][2], B0[2][2], B1[2][2];
#define PG8_ABASE(u) ((const char*)((u).seg ? g.A2 : g.A) + (size_t)(u).pm * tstep)
#define PG8_BBASE(u) ((const char*)((u).seg ? g.Bt2 : g.Bt) + (size_t)(u).pn * tstep)
    const char* cA = PG8_ABASE(cur); const char* cB = PG8_BBASE(cur);
    S.a_ready(cur);
    if constexpr (SP2) {
        PG8_STAGE(PG8_SB(0, 0), cB, voffB); PG8_STAGE(PG8_SB(0, 1), cB + hstep, voffB); PG8_STAGE(PG8_SA(0, 0), cA, voffA); PG8_STAGE(PG8_SA(0, 1), cA + hstep, voffA);
        if (wr == 1) PG8_BAR;
        PG8_WAIT_V(2); PG8_BAR;
        PG8_STAGE(PG8_SB(1, 0), cB + kstep, voffB); PG8_STAGE(PG8_SA(1, 0), cA + kstep, voffA); PG8_STAGE(PG8_SB(1, 1), cB + hstep + kstep, voffB);
        PG8_WAIT_V(6); PG8_BAR;
    } else {
        PG8_STAGE(PG8_SB(0, 0), cB, voffB); PG8_STAGE(PG8_SA(0, 0), cA, voffA); PG8_STAGE(PG8_SB(0, 1), cB + hstep, voffB); PG8_STAGE(PG8_SA(0, 1), cA + hstep, voffA);
        if (wr == 1) PG8_BAR;
        PG8_WAIT_V(4); PG8_BAR;
        PG8_STAGE(PG8_SB(1, 0), cB + kstep, voffB); PG8_STAGE(PG8_SA(1, 0), cA + kstep, voffA); PG8_STAGE(PG8_SB(1, 1), cB + hstep + kstep, voffB);
        PG8_WAIT_V(6); PG8_BAR;
    }
    for (;;) {
        const bool has_next = S.next(ui + 1, nxt);
        const char* nA = has_next ? PG8_ABASE(nxt) : cA; const char* nB = has_next ? PG8_BBASE(nxt) : cB;
        for (int t = 0; t < nt; t += 2) {
            const bool last = (t == nt - 2);
            const char* a1 = cA + (size_t)(t + 1) * kstep;
            const char* a2 = last ? nA : cA + (size_t)(t + 2) * kstep; const char* b2 = last ? nB : cB + (size_t)(t + 2) * kstep;
            const char* a3 = a2 + kstep; const char* b3 = b2 + kstep;
            if (last && has_next) S.a_ready(nxt);
            if constexpr (SP2) {
            PG8_LDB(B0, 0, 0); PG8_LDB(B1, 0, 1); PG8_SCHED; PG8_LDA(At, 0, 0); PG8_STAGE(PG8_SA(1, 1), a1 + hstep, voffA);
            PG8_WAIT_V(8); PG8_WAIT_L(0); PG8_BAR; PG8_MMA(0, 0, At, B0); PG8_MMA(0, 1, At, B1); PG8_BAR; PG8_SCHED;
            PG8_LDA(At, 0, 1); PG8_STAGE(PG8_SB(0, 0), b2, voffB); PG8_STAGE(PG8_SB(0, 1), b2 + hstep, voffB); PG8_STAGE(PG8_SA(0, 0), a2, voffA);
            PG8_WAIT_V(8); PG8_WAIT_L(0); PG8_BAR; PG8_MMA(1, 0, At, B0); PG8_MMA(1, 1, At, B1); PG8_BAR; PG8_SCHED;
            PG8_LDB(B0, 1, 0); PG8_LDB(B1, 1, 1); PG8_SCHED; PG8_LDA(At, 1, 0); PG8_STAGE(PG8_SA(0, 1), a2 + hstep, voffA);
            PG8_WAIT_V(8); PG8_WAIT_L(0); PG8_BAR; PG8_MMA(0, 0, At, B0); PG8_MMA(0, 1, At, B1); PG8_BAR; PG8_SCHED;
            PG8_LDA(At, 1, 1); PG8_STAGE(PG8_SB(1, 0), b3, voffB); PG8_STAGE(PG8_SB(1, 1), b3 + hstep, voffB); PG8_STAGE(PG8_SA(1, 0), a3, voffA);
            PG8_WAIT_V(8); PG8_WAIT_L(0); PG8_BAR; PG8_MMA(1, 0, At, B0); PG8_MMA(1, 1, At, B1); PG8_BAR; PG8_SCHED;
            } else {
            PG8_LDB(B0, 0, 0); PG8_SCHED; PG8_LDA(At, 0, 0); PG8_STAGE(PG8_SA(1, 1), a1 + hstep, voffA);
            PG8_WAIT_L(8); PG8_BAR; PG8_WAIT_L(0); PG8_MMA(0, 0, At, B0); PG8_BAR; PG8_SCHED;
            PG8_LDB(B1, 0, 1); PG8_STAGE(PG8_SB(0, 0), b2, voffB);
            PG8_BAR; PG8_WAIT_L(0); PG8_MMA(0, 1, At, B1); PG8_BAR;
            PG8_LDA(At, 0, 1); PG8_STAGE(PG8_SA(0, 0), a2, voffA);
            PG8_BAR; PG8_WAIT_L(0); PG8_MMA(1, 0, At, B0); PG8_BAR; PG8_SCHED;
            PG8_STAGE(PG8_SB(0, 1), b2 + hstep, voffB);
            PG8_WAIT_V(6); PG8_BAR; PG8_MMA(1, 1, At, B1); PG8_BAR;
            PG8_LDB(B0, 1, 0); PG8_SCHED; PG8_LDA(At, 1, 0); PG8_STAGE(PG8_SA(0, 1), a2 + hstep, voffA);
            PG8_WAIT_L(8); PG8_BAR; PG8_WAIT_L(0); PG8_MMA(0, 0, At, B0); PG8_BAR; PG8_SCHED;
            PG8_LDB(B1, 1, 1); PG8_STAGE(PG8_SB(1, 0), b3, voffB);
            PG8_BAR; PG8_WAIT_L(0); PG8_MMA(0, 1, At, B1); PG8_BAR;
            PG8_LDA(At, 1, 1); PG8_STAGE(PG8_SA(1, 0), a3, voffA);
            PG8_BAR; PG8_WAIT_L(0); PG8_MMA(1, 0, At, B0); PG8_BAR; PG8_SCHED;
            PG8_STAGE(PG8_SB(1, 1), b3 + hstep, voffB);
            PG8_WAIT_V(6); PG8_BAR; PG8_MMA(1, 1, At, B1); PG8_BAR;
            }
        }
        if constexpr (ALIGN_EPI) { if (wr == 0) PG8_BAR; }
        bool keep_acc = false;
        if constexpr (Epi::PAIRED) { if (cur.seg == 0) { E.mid(acc, cur, wr, wc, fr, fq); keep_acc = true; } else E(acc, cur, wr, wc, fr, fq); S.done(cur); }
        else if constexpr (!Epi::AFTER_DRAIN) { E(acc, cur, wr, wc, fr, fq); S.done(cur); }
        if (!has_next) break;
        if (!keep_acc)
#pragma unroll
        for (int a = 0; a < 2; ++a)
#pragma unroll
            for (int b = 0; b < 2; ++b)
#pragma unroll
                for (int m = 0; m < 4; ++m)
#pragma unroll
                    for (int n = 0; n < 2; ++n) acc[a][b][m][n] = (f32x4){0.f, 0.f, 0.f, 0.f};
        cur = nxt; cA = nA; cB = nB; ++ui;
        if constexpr (ALIGN_EPI) { if (wr == 1) PG8_BAR; }
    }
    PG8_WAIT_V(0);
    if constexpr (!ALIGN_EPI) { if (wr == 0) PG8_BAR; }
    PG8_BAR;
    if constexpr (Epi::AFTER_DRAIN) { E.fused(acc, cur, wr, wc, fr, fq, lds, wid, lane); S.done(cur); }
#undef PG8_ABASE
#undef PG8_BBASE
#undef PG8_SA
#undef PG8_SB
#undef PG8_STAGE
#undef PG8_LDA
#undef PG8_LDB
#undef PG8_MMA
#undef PG8_WAIT_V
#undef PG8_WAIT_L
#undef PG8_BAR
#undef PG8_SCHED
}
}
#include <hip/hip_bf16.h>
#include <cmath>
namespace attn2 {
using bf16=__hip_bfloat16;
using bf16x8=__attribute__((ext_vector_type(8)))short;
using s16x4=__attribute__((ext_vector_type(4)))short;
using f32x16=__attribute__((ext_vector_type(16)))float;
using u32x4=__attribute__((ext_vector_type(4)))unsigned;
constexpr int SEQ=8192,DM=1024;
constexpr int NW=8,QBLK=32,QB=QBLK*NW,KVBLK=64;
__device__ __forceinline__ int crow(int r,int hi){return (r&3)+8*(r>>2)+4*hi;}
#define SBAR() __builtin_amdgcn_sched_barrier(0)
constexpr int NSLOT=3, SLOTB=8192;
constexpr int LDS_K=0, LDS_V=NSLOT*SLOTB, LDS_WS=LDS_V+2*NSLOT*SLOTB, LDS_OST=LDS_WS+NW*64*4, LDS_BYTES=LDS_OST+NW*4096;
__device__ __forceinline__ void glds16(const void*gsrc,unsigned lds_dst){unsigned keep;
  asm volatile("s_mov_b32 %0, m0\n\ts_mov_b32 m0, %2\n\ts_nop 0\n\tglobal_load_lds_dwordx4 %1, off\n\ts_mov_b32 m0, %0":"=&s"(keep):"v"(gsrc),"s"(lds_dst):"memory");}
typedef float f32x2_t __attribute__((ext_vector_type(2))); typedef __bf16 bf16x2_t __attribute__((ext_vector_type(2)));
__device__ __forceinline__ unsigned cvtpk_s(float lo,float hi){f32x2_t v={lo,hi};bf16x2_t b=__builtin_convertvector(v,bf16x2_t);return __builtin_bit_cast(unsigned,b);}
#define WAIT_BAR(N) asm volatile("s_waitcnt vmcnt(" #N ") lgkmcnt(0)\n\ts_barrier":::"memory")
typedef __attribute__((address_space(3))) const char* lds_cptr;
typedef short v4i16_t __attribute__((ext_vector_type(4)));
__device__ __forceinline__ void qkt0(f32x16&p0,f32x16&p1,const char*Kslot,const bf16x8*qr,int r32,int hi){
  const char*kb=Kslot+hi*1024+r32*16; const f32x16 z=f32x16{};
  #pragma unroll
  for(int d0=0;d0<4;++d0){
    const bf16x8 b0=*reinterpret_cast<const bf16x8*>(kb+d0*2048);
    const bf16x8 b1=*reinterpret_cast<const bf16x8*>(kb+d0*2048+512);
    if(d0==0){p0=__builtin_amdgcn_mfma_f32_32x32x16_bf16(b0,qr[0],z,0,0,0);p1=__builtin_amdgcn_mfma_f32_32x32x16_bf16(b1,qr[0],z,0,0,0);}
    else{p0=__builtin_amdgcn_mfma_f32_32x32x16_bf16(b0,qr[d0],p0,0,0,0);p1=__builtin_amdgcn_mfma_f32_32x32x16_bf16(b1,qr[d0],p1,0,0,0);}}
}
__device__ __forceinline__ void kload8(bf16x8*kf,lds_cptr kp){
  kf[0]=*(const __attribute__((address_space(3))) bf16x8*)(kp);      kf[1]=*(const __attribute__((address_space(3))) bf16x8*)(kp+512);
  kf[2]=*(const __attribute__((address_space(3))) bf16x8*)(kp+2048); kf[3]=*(const __attribute__((address_space(3))) bf16x8*)(kp+2560);
  kf[4]=*(const __attribute__((address_space(3))) bf16x8*)(kp+4096); kf[5]=*(const __attribute__((address_space(3))) bf16x8*)(kp+4608);
  kf[6]=*(const __attribute__((address_space(3))) bf16x8*)(kp+6144); kf[7]=*(const __attribute__((address_space(3))) bf16x8*)(kp+6656);
}
__device__ __forceinline__ void kload2(bf16x8*kf,lds_cptr kp,int j){ kf[2*j]=*(const __attribute__((address_space(3))) bf16x8*)(kp+j*2048); kf[2*j+1]=*(const __attribute__((address_space(3))) bf16x8*)(kp+j*2048+512); }
__device__ __forceinline__ s16x4 vtr(lds_cptr p){ return __builtin_bit_cast(s16x4,__builtin_amdgcn_ds_read_tr16_b64_v4i16((__attribute__((address_space(3))) v4i16_t*)p)); }
__device__ __forceinline__ void pv4(f32x16*o,int vb,bf16x8 pa0,bf16x8 pa1,bf16x8 pa2,bf16x8 pa3){
  #pragma unroll
  for(int d0=0;d0<4;++d0){s16x4 lo[4],hi[4];
    #pragma unroll
    for(int ks=0;ks<4;++ks){
      asm volatile("ds_read_b64_tr_b16 %0,%1 offset:%c2":"=&v"(lo[ks]):"v"(vb),"i"(d0*4096+ks*1024):"memory");
      asm volatile("ds_read_b64_tr_b16 %0,%1 offset:%c2":"=&v"(hi[ks]):"v"(vb),"i"(d0*4096+ks*1024+512):"memory");}
    asm volatile("s_waitcnt lgkmcnt(0)":::"memory");SBAR();
    #define PK(k) (bf16x8){lo[k][0],lo[k][1],lo[k][2],lo[k][3],hi[k][0],hi[k][1],hi[k][2],hi[k][3]}
    o[d0]=__builtin_amdgcn_mfma_f32_32x32x16_bf16(pa0,PK(0),o[d0],0,0,0);
    o[d0]=__builtin_amdgcn_mfma_f32_32x32x16_bf16(pa1,PK(1),o[d0],0,0,0);
    o[d0]=__builtin_amdgcn_mfma_f32_32x32x16_bf16(pa2,PK(2),o[d0],0,0,0);
    o[d0]=__builtin_amdgcn_mfma_f32_32x32x16_bf16(pa3,PK(3),o[d0],0,0,0);
    #undef PK
  }
}
#ifndef ATTN_STORE16
#define ATTN_STORE16(p,v) (*(u32x4*)(p)=(v))
#endif
template<bool SHIFT,int OP> __device__ __forceinline__ void attn_unit(int b,int qcol,int vcol,int ocol,int qb,float mshift,int mode,float lam,const float*subg,float gmul,float*o2s,float*kout,float*vout,const bf16*Q,const bf16*__restrict__ K,const bf16*__restrict__ V,bf16*O,char*shm){
  int tid_=threadIdx.x; asm volatile("":"+v"(tid_)); const int tid=tid_,lane=tid&63,r32=lane&31,hi=lane>>5; const int wid=__builtin_amdgcn_readfirstlane(tid>>6);
  const long rowbase=(long)b*SEQ; const int q0=qb*QB;
  const bf16*Qw=Q+(rowbase+q0+wid*QBLK)*DM+qcol;
  const bf16*Kh=K+rowbase*DM+qcol,*Vh=V+rowbase*DM+vcol;
  const unsigned lds0=(unsigned)(uintptr_t)shm;
  float*wsf=(float*)(shm+LDS_WS)+wid*64;
  const bf16*ksrc=Kh+(long)lane*DM+wid*8;
  const bf16*vsrc=Vh+(long)(16*(wid&3)+(lane>>2))*DM+(wid>>2)*32+(lane&3)*8;
  const unsigned kdst=lds0+LDS_K+wid*1024, vdst=lds0+LDS_V+wid*1024;
  #define DMA_K(t,slot) glds16(ksrc+(long)(t)*KVBLK*DM,(unsigned)__builtin_amdgcn_readfirstlane(kdst+(slot)))
  #define DMA_V(t,slot) do{ glds16(vsrc+(long)(t)*KVBLK*DM,(unsigned)__builtin_amdgcn_readfirstlane(vdst+2*(slot))); glds16(vsrc+(long)(t)*KVBLK*DM+64,(unsigned)__builtin_amdgcn_readfirstlane(vdst+2*(slot)+8192)); }while(0)
  const int vb0=(int)(lds0+LDS_V)+((lane>>4)&1)*32+(lane&3)*8+(4*hi+((lane&15)>>2))*64;
  const char*Kbase=shm+LDS_K; bf16x8 kf[8];
  const lds_cptr shm3=(lds_cptr)shm; const lds_cptr kp0=shm3+LDS_K+hi*1024+r32*16; const lds_cptr vp0=shm3+LDS_V+((lane>>4)&1)*32+(lane&3)*8+(4*hi+((lane&15)>>2))*64;
  const int NT=(q0+QB)/KVBLK;
  DMA_K(0,0);DMA_V(0,0);DMA_K(1,SLOTB);
  bf16x8 qr[4];
  #pragma unroll
  for(int d0=0;d0<4;++d0)qr[d0]=*reinterpret_cast<const bf16x8*>(&Qw[(long)r32*DM+d0*16+hi*8]);
  float l_reg=0.f;f32x16 o[4];o[0]=f32x16{};o[1]=f32x16{};o[2]=f32x16{};o[3]=f32x16{};
  const int chunkw=wid>>1;
  #define CMASK_BAND(P0,P1,t) do{int jb_=(t)-(NT-4); if(jb_>chunkw){ asm volatile("":::"memory"); _Pragma("unroll") for(int r=0;r<16;++r){P0[r]=-INFINITY;P1[r]=-INFINITY;} } }while(0)
  #define CMASK(P0,P1,t) CMASK_BAND(P0,P1,t)
  #define EX(v) __builtin_amdgcn_exp2f(v)
  #define EXS(v) (SHIFT?EX((v)-mshift):EX(v))
  f32x16 pA0,pA1,pB0,pB1;
  int sl_prev=0,sl_cur=0,sl_next=SLOTB;
  #define ROT() do{sl_prev=sl_cur;sl_cur=sl_next;sl_next=(sl_next==(NSLOT-1)*SLOTB)?0:sl_next+SLOTB;}while(0)
  DMA_K(2,2*SLOTB);
  WAIT_BAR(4);
  qkt0(pA0,pA1,Kbase,qr,r32,hi);CMASK(pA0,pA1,0);
  _Pragma("unroll") for(int r=0;r<16;++r){pA0[r]=EXS(pA0[r]);pA1[r]=EXS(pA1[r]);}
  WAIT_BAR(0);
  DMA_K(3,0);DMA_V(1,SLOTB);
  ROT();
  kload8(kf,kp0+sl_cur);
  WAIT_BAR(3);
  s16x4 vlo[8],vhi[8]; u32x4 pw0,pw1,pw2,pw3;
  #define PKW(P,B) cvtpk_s(P[B],P[B+1])
  #define PAF(k) __builtin_bit_cast(bf16x8,pw##k)
  #define VFR(i) (bf16x8){vlo[i][0],vlo[i][1],vlo[i][2],vlo[i][3],vhi[i][0],vhi[i][1],vhi[i][2],vhi[i][3]}
  #define PIN(x) asm volatile("":"+v"(x))
  #define GAPA(MF,A0,A1,A2,A3,W0,W1,PW) do{ MF; sacc+=A0; sacc+=A1; sacc+=A2; sacc+=A3; PIN(sacc); W0; W1; PIN(PW); SBAR(); }while(0)
  #define GAPB(MF,X,B) do{ MF; X[B]=EXS(X[B]); X[B+1]=EXS(X[B+1]); PIN(X); SBAR(); }while(0)
  #define VRD(i,db) do{ vlo[i]=vtr(vp_+((db)*4096+((i)&3)*1024)); vhi[i]=vtr(vp_+((db)*4096+((i)&3)*1024+512)); }while(0)
  #define KRD(G,j) do{ if(G){ kload2(kf,kp0+sl_next,j); SBAR(); } }while(0)
  #define STEP(C0,C1,P0,P1,t,GK,GV,GL) do{ SBAR(); \
    const lds_cptr vp_=vp0+2*sl_prev; const f32x16 z_=f32x16{}; \
    VRD(0,0); SBAR(); float sacc=(P0[0]+P0[1]); \
    GAPA(C0=__builtin_amdgcn_mfma_f32_32x32x16_bf16(kf[0],qr[0],z_,0,0,0), P0[2],P0[3],P0[4],P0[5],     pw0[0]=PKW(P0,0), pw0[1]=PKW(P0,2), pw0); \
    VRD(4,1); SBAR(); GAPA(C1=__builtin_amdgcn_mfma_f32_32x32x16_bf16(kf[1],qr[0],z_,0,0,0), P0[6],P0[7],P0[8],P0[9],     pw0[2]=PKW(P0,4), pw0[3]=PKW(P0,6), pw0); \
    VRD(1,0); SBAR(); GAPA(C0=__builtin_amdgcn_mfma_f32_32x32x16_bf16(kf[2],qr[1],C0,0,0,0),   P0[10],P0[11],P0[12],P0[13], pw1[0]=PKW(P0,8), pw1[1]=PKW(P0,10), pw1); \
    VRD(5,1); SBAR(); GAPA(C1=__builtin_amdgcn_mfma_f32_32x32x16_bf16(kf[3],qr[1],C1,0,0,0),   P0[14],P0[15],P1[0],P1[1],   pw1[2]=PKW(P0,12),pw1[3]=PKW(P0,14), pw1); \
    VRD(2,0); SBAR(); GAPA(C0=__builtin_amdgcn_mfma_f32_32x32x16_bf16(kf[4],qr[2],C0,0,0,0),   P1[2],P1[3],P1[4],P1[5],     pw2[0]=PKW(P1,0), pw2[1]=PKW(P1,2), pw2); \
    VRD(6,1); SBAR(); GAPA(C1=__builtin_amdgcn_mfma_f32_32x32x16_bf16(kf[5],qr[2],C1,0,0,0),   P1[6],P1[7],P1[8],P1[9],     pw2[2]=PKW(P1,4), pw2[3]=PKW(P1,6), pw2); \
    VRD(3,0); SBAR(); GAPA(C0=__builtin_amdgcn_mfma_f32_32x32x16_bf16(kf[6],qr[3],C0,0,0,0),   P1[10],P1[11],P1[12],P1[13], pw3[0]=PKW(P1,8), pw3[1]=PKW(P1,10), pw3); \
    VRD(7,1); SBAR(); GAPA(C1=__builtin_amdgcn_mfma_f32_32x32x16_bf16(kf[7],qr[3],C1,0,0,0),   P1[14],P1[15],0.f,0.f,       pw3[2]=PKW(P1,12),pw3[3]=PKW(P1,14), pw3); \
    l_reg+=sacc; \
    if(GK){DMA_K((t)+3,sl_cur);} if(GV){DMA_V((t)+1,sl_next);} \
    CMASK(C0,C1,t); \
    SBAR(); \
    GAPB(o[0]=__builtin_amdgcn_mfma_f32_32x32x16_bf16(PAF(0),VFR(0),o[0],0,0,0), C0,0);  VRD(0,2); SBAR(); \
    GAPB(o[1]=__builtin_amdgcn_mfma_f32_32x32x16_bf16(PAF(0),VFR(4),o[1],0,0,0), C0,2);  VRD(4,3); SBAR(); \
    KRD(GL,0); GAPB(o[0]=__builtin_amdgcn_mfma_f32_32x32x16_bf16(PAF(1),VFR(1),o[0],0,0,0), C0,4);  VRD(1,2); SBAR(); \
    KRD(GL,1); GAPB(o[1]=__builtin_amdgcn_mfma_f32_32x32x16_bf16(PAF(1),VFR(5),o[1],0,0,0), C0,6);  VRD(5,3); SBAR(); \
    KRD(GL,2); GAPB(o[0]=__builtin_amdgcn_mfma_f32_32x32x16_bf16(PAF(2),VFR(2),o[0],0,0,0), C0,8);  VRD(2,2); SBAR(); \
    KRD(GL,3); GAPB(o[1]=__builtin_amdgcn_mfma_f32_32x32x16_bf16(PAF(2),VFR(6),o[1],0,0,0), C0,10); VRD(6,3); SBAR(); \
    GAPB(o[0]=__builtin_amdgcn_mfma_f32_32x32x16_bf16(PAF(3),VFR(3),o[0],0,0,0), C0,12); VRD(3,2); SBAR(); \
    GAPB(o[1]=__builtin_amdgcn_mfma_f32_32x32x16_bf16(PAF(3),VFR(7),o[1],0,0,0), C0,14); VRD(7,3); SBAR(); \
    GAPB(o[2]=__builtin_amdgcn_mfma_f32_32x32x16_bf16(PAF(0),VFR(0),o[2],0,0,0), C1,0); \
    GAPB(o[3]=__builtin_amdgcn_mfma_f32_32x32x16_bf16(PAF(0),VFR(4),o[3],0,0,0), C1,2); \
    GAPB(o[2]=__builtin_amdgcn_mfma_f32_32x32x16_bf16(PAF(1),VFR(1),o[2],0,0,0), C1,4); \
    GAPB(o[3]=__builtin_amdgcn_mfma_f32_32x32x16_bf16(PAF(1),VFR(5),o[3],0,0,0), C1,6); \
    GAPB(o[2]=__builtin_amdgcn_mfma_f32_32x32x16_bf16(PAF(2),VFR(2),o[2],0,0,0), C1,8); \
    GAPB(o[3]=__builtin_amdgcn_mfma_f32_32x32x16_bf16(PAF(2),VFR(6),o[3],0,0,0), C1,10); \
    GAPB(o[2]=__builtin_amdgcn_mfma_f32_32x32x16_bf16(PAF(3),VFR(3),o[2],0,0,0), C1,12); \
    GAPB(o[3]=__builtin_amdgcn_mfma_f32_32x32x16_bf16(PAF(3),VFR(7),o[3],0,0,0), C1,14); \
    }while(0)
  if(wid>=4)__builtin_amdgcn_s_setprio(1);
  int t=1;
  #undef CMASK
  #define CMASK(P0,P1,t) do{}while(0)
  for(;t+5<NT;t+=2){
    STEP(pB0,pB1,pA0,pA1,t,true,true,true);     WAIT_BAR(3); ROT();
    STEP(pA0,pA1,pB0,pB1,t+1,true,true,true);   WAIT_BAR(3); ROT();
  }
  #undef CMASK
  #define CMASK(P0,P1,t) CMASK_BAND(P0,P1,t)
  #define ENDW(tt) do{ if((tt)+3<NT){WAIT_BAR(3);} else if((tt)+2<NT){WAIT_BAR(2);} else {WAIT_BAR(0);} }while(0)
  for(;t+1<NT;t+=2){
    STEP(pB0,pB1,pA0,pA1,t,(t+3<NT),(t+1<NT),(t+1<NT));       ENDW(t);   ROT();
    STEP(pA0,pA1,pB0,pB1,t+1,(t+4<NT),(t+2<NT),(t+2<NT));     ENDW(t+1); ROT();
  }
  STEP(pB0,pB1,pA0,pA1,NT-1,false,false,false);
  { float sacc=pB0[0]+pB0[1]; _Pragma("unroll") for(int r=2;r<16;++r)sacc+=pB0[r]; _Pragma("unroll") for(int r=0;r<16;++r)sacc+=pB1[r]; l_reg+=sacc;
    pw0=(u32x4){PKW(pB0,0),PKW(pB0,2),PKW(pB0,4),PKW(pB0,6)};pw1=(u32x4){PKW(pB0,8),PKW(pB0,10),PKW(pB0,12),PKW(pB0,14)};pw2=(u32x4){PKW(pB1,0),PKW(pB1,2),PKW(pB1,4),PKW(pB1,6)};pw3=(u32x4){PKW(pB1,8),PKW(pB1,10),PKW(pB1,12),PKW(pB1,14)};
    SBAR(); pv4(o,vb0+2*sl_cur,PAF(0),PAF(1),PAF(2),PAF(3)); }
  #undef PKW
  #undef PAF
  #undef VFR
  #undef PIN
  #undef GAPA
  #undef GAPB
  #undef EX
  #undef EXS
  #undef VRD
  #undef KRD
  #undef STEP
  #undef ENDW
  __builtin_amdgcn_s_setprio(0);
  {auto rr=__builtin_amdgcn_permlane32_swap(__float_as_uint(l_reg),__float_as_uint(l_reg),false,false);l_reg=__uint_as_float(rr[0])+__uint_as_float(rr[1]);}
  if(hi==0)wsf[32+r32]=l_reg;asm volatile("s_waitcnt lgkmcnt(0)":::"memory");
  { float rli[16];
  #pragma unroll
  for(int r=0;r<16;++r)rli[r]=__builtin_amdgcn_rcpf(wsf[32+crow(r,hi)]);
  #pragma unroll
  for(int d0=0;d0<4;++d0)
    #pragma unroll
    for(int r=0;r<16;++r)o[d0][r]*=rli[r]; }
  typedef float f32x4o __attribute__((ext_vector_type(4)));
  f32x4o*o2w=(f32x4o*)(o2s+(size_t)wid*4096)+lane;
  if(mode==0){
    #pragma unroll
    for(int d0=0;d0<4;++d0)
      #pragma unroll
      for(int j=0;j<4;++j)o2w[(d0*4+j)*64]=(f32x4o){o[d0][4*j],o[d0][4*j+1],o[d0][4*j+2],o[d0][4*j+3]};
  } else {
    #pragma unroll
    for(int d0=0;d0<4;++d0)
      #pragma unroll
      for(int j=0;j<4;++j){ const f32x4o t=o2w[(d0*4+j)*64]; o[d0][4*j]-=lam*t.x; o[d0][4*j+1]-=lam*t.y; o[d0][4*j+2]-=lam*t.z; o[d0][4*j+3]-=lam*t.w; }
    float sg[4];
    #pragma unroll
    for(int d0=0;d0<4;++d0)sg[d0]=subg[32*d0+r32]*gmul;
    #pragma unroll
    for(int r=0;r<16;++r){ float ss=(o[0][r]*o[0][r]+o[1][r]*o[1][r])+(o[2][r]*o[2][r]+o[3][r]*o[3][r]);
      ss+=__shfl_xor(ss,1);ss+=__shfl_xor(ss,2);ss+=__shfl_xor(ss,4);ss+=__shfl_xor(ss,8);ss+=__shfl_xor(ss,16);
      const float rs=__builtin_amdgcn_rsqf(ss*(1.0f/128.0f)+1e-6f);
      #pragma unroll
      for(int d0=0;d0<4;++d0)o[d0][r]*=rs*sg[d0]; }
    bf16*Ow=O+(rowbase+q0+wid*QBLK)*OP+ocol;
    bf16*stg=(bf16*)(shm+LDS_OST)+wid*2048;
    #pragma unroll
    for(int ps=0;ps<2;++ps){
      #pragma unroll
      for(int r=0;r<16;++r){const int orow=crow(r,hi);
        #pragma unroll
        for(int d0=0;d0<2;++d0)stg[orow*64+d0*32+r32]=__float2bfloat16(o[2*ps+d0][r]);}
      asm volatile("s_waitcnt lgkmcnt(0)":::"memory");
      #pragma unroll
      for(int i=0;i<4;++i){const int row=i*8+(lane>>3),ch=lane&7; const u32x4 v=*(const u32x4*)(stg+row*64+ch*8); ATTN_STORE16(Ow+(long)row*OP+ps*64+ch*8,v);}
      asm volatile("s_waitcnt lgkmcnt(0)":::"memory"); } }
  { typedef float f32x4a __attribute__((ext_vector_type(4)));
    #pragma unroll
    for(int i=0;i<4;++i){ const int gI=tid+512*i,row=gI>>3,c8=gI&7; const u32x4 w=*(const u32x4*)(Kh+(long)(q0+row)*DM+c8*8); float*dst=kout+(rowbase+q0+row)*DM+qcol+c8*8;
      *(f32x4a*)dst=(f32x4a){__uint_as_float(w.x<<16),__uint_as_float(w.x&0xffff0000u),__uint_as_float(w.y<<16),__uint_as_float(w.y&0xffff0000u)};
      *(f32x4a*)(dst+4)=(f32x4a){__uint_as_float(w.z<<16),__uint_as_float(w.z&0xffff0000u),__uint_as_float(w.w<<16),__uint_as_float(w.w&0xffff0000u)}; }
    if(mode==1){
      #pragma unroll
      for(int i=0;i<8;++i){ const int gI=tid+512*i,row=gI>>4,c8=gI&15; const u32x4 w=*(const u32x4*)(Vh+(long)(q0+row)*DM+c8*8); float*dst=vout+(rowbase+q0+row)*DM+vcol+c8*8;
        *(f32x4a*)dst=(f32x4a){__uint_as_float(w.x<<16),__uint_as_float(w.x&0xffff0000u),__uint_as_float(w.y<<16),__uint_as_float(w.y&0xffff0000u)};
        *(f32x4a*)(dst+4)=(f32x4a){__uint_as_float(w.z<<16),__uint_as_float(w.z&0xffff0000u),__uint_as_float(w.w<<16),__uint_as_float(w.w&0xffff0000u)}; } } }
  asm volatile("s_waitcnt lgkmcnt(0)\n\ts_barrier":::"memory");
  #undef DMA_K
  #undef DMA_V
  #undef CMASK
  #undef CMASK_BAND
  #undef ROT
}
#undef SBAR
#undef WAIT_BAR
}
#include <hip/hip_cooperative_groups.h>
namespace cg = cooperative_groups;
constexpr int NWAVES = 8;
constexpr int MP = pg8::MP, MS = pg8::MS, MT = pg8::MT, D = 1024, TP = 8192, TS = 32, PAST = 1024, NIN = 8192, FF = 2816, NGU = 2 * FF;
constexpr float LAM0 = 0.2f;
constexpr size_t MiB = 1u << 20;
constexpr size_t ROWB = (size_t)MT * D * 2;
constexpr size_t WS_MOD = 0;
constexpr size_t WS_WIN = 1 * MiB, WS_WAO = 17 * MiB, WS_WCO = 19 * MiB, WS_WOUT = 21 * MiB, WS_WGU = 23 * MiB, WS_WDN = 34 * MiB;
constexpr size_t WS_XN = 40 * MiB;
constexpr size_t WS_O12 = 40 * MiB;
constexpr size_t WS_T = WS_O12;
constexpr size_t WS_Q = WS_O12 + 2 * ROWB, WS_K = WS_Q + ROWB, WS_V = WS_K + ROWB, WS_U = WS_V + ROWB, WS_GB = WS_U + ROWB, WS_END = WS_GB + ROWB;
constexpr size_t WS_ON = WS_Q;
constexpr size_t WS_MX = WS_K;
constexpr size_t WS_XN2 = WS_V;
constexpr size_t WS_ACT = 40 * MiB;
static_assert(WS_ACT + (size_t)MT * FF * 2 <= WS_MX && WS_END <= 1024 * MiB, "d_ws map");
constexpr int LDS_BYTES = 147456;
constexpr size_t WS_BAR = 512 * 1024;
constexpr int XBAR_LDS_OFF = 147456 - 64;

#define GAS __attribute__((address_space(1)))
#define LAS __attribute__((address_space(3)))
typedef unsigned short bf16;
typedef unsigned v4u __attribute__((ext_vector_type(4)));
typedef unsigned v2u __attribute__((ext_vector_type(2)));
typedef float f32x4 __attribute__((ext_vector_type(4)));
#define LDS_WAIT() asm volatile("s_waitcnt lgkmcnt(0)" ::: "memory")
__device__ __forceinline__ unsigned f2bf(float f) { unsigned u = __builtin_bit_cast(unsigned, f); return (u + 0x7fffu + ((u >> 16) & 1u)) >> 16; }
__device__ __forceinline__ unsigned pk2(float lo, float hi) { return f2bf(lo) | (f2bf(hi) << 16); }
__device__ __forceinline__ float bflo(unsigned w) { return __uint_as_float(w << 16); }
__device__ __forceinline__ float bfhi(unsigned w) { return __uint_as_float(w & 0xffff0000u); }
__device__ __forceinline__ float bf1(bf16 b) { return __uint_as_float((unsigned)b << 16); }
__device__ __forceinline__ float wave_sum(float v) {
#pragma unroll
    for (int o = 1; o < 64; o <<= 1) v += __shfl_xor(v, o);
    return v;
}
__device__ __forceinline__ float wave_max(float v) {
#pragma unroll
    for (int o = 1; o < 64; o <<= 1) v = fmaxf(v, __shfl_xor(v, o));
    return v;
}

__device__ __forceinline__ void ld16(const bf16* p, float (&d)[16]) { const v4u* q = (const v4u*)p;
#pragma unroll
    for (int e = 0; e < 2; ++e) { const v4u a = q[e]; d[8 * e + 0] = bflo(a.x); d[8 * e + 1] = bfhi(a.x); d[8 * e + 2] = bflo(a.y); d[8 * e + 3] = bfhi(a.y); d[8 * e + 4] = bflo(a.z); d[8 * e + 5] = bfhi(a.z); d[8 * e + 6] = bflo(a.w); d[8 * e + 7] = bfhi(a.w); } }
__device__ __forceinline__ void ldf(const float* p, float (&d)[16]) { const f32x4* q = (const f32x4*)p;
#pragma unroll
    for (int e = 0; e < 4; ++e) { const f32x4 a = q[e]; d[4 * e] = a.x; d[4 * e + 1] = a.y; d[4 * e + 2] = a.z; d[4 * e + 3] = a.w; } }
struct Args {
    const float *x_prompt, *x_sample, *cache_k, *cache_v, *state_conv, *c_prompt, *c_sample, *w_ada, *b_ada, *norm1_g, *norm2_g, *w_in, *q_norm_g, *k_norm_g,
        *lq1, *lk1, *lq2, *lk2, *sub_g, *w_ao, *conv_w, *w_co, *w_out, *w_gu, *w_dn;
    float* out; unsigned char* ws;
};

__device__ __forceinline__ void transpose_item(const float* W, int K, int N, bf16* WT, int kb, int n0, int drow, LAS float* scr, int lane) {
    const int k0 = 64 * kb;
#pragma unroll 8
    for (int i = 0; i < 32; ++i) { const int kk = 2 * i + (lane >> 5); scr[kk * 33 + (lane & 31)] = W[(size_t)(k0 + kk) * N + n0 + (lane & 31)]; }
    LDS_WAIT(); asm volatile("" ::: "memory");
    const int c = lane & 7;
#pragma unroll
    for (int j = 0; j < 4; ++j) { const int n = (lane >> 3) + 8 * j; const LAS float* s = scr + (8 * c) * 33 + n;
        v4u o; o.x = pk2(s[0 * 33], s[1 * 33]); o.y = pk2(s[2 * 33], s[3 * 33]); o.z = pk2(s[4 * 33], s[5 * 33]); o.w = pk2(s[6 * 33], s[7 * 33]);
        *(GAS v4u*)(WT + (size_t)(drow + n) * K + k0 + 8 * c) = o; }
    LDS_WAIT(); asm volatile("" ::: "memory");
}
__device__ __forceinline__ int win_drow(int c0) {
    const int sect = c0 >> 10, cc = c0 & 1023;
    if (sect == 3) return 256 * (12 + (cc >> 7)) + (cc & 127);
    if (sect == 5) return 256 * (12 + (cc >> 7)) + 128 + (cc & 127);
    const int tile = (sect < 3 ? sect * 4 : sect == 4 ? 20 : sect == 6 ? 24 : 28) + (cc >> 8), sl = cc & 255;
    return 256 * tile + 128 * ((sl >> 5) & 1) + 32 * (sl >> 6);
}
__device__ __forceinline__ int wgu_drow(int c0) { const int ch = c0 < FF ? c0 : c0 - FF; return 256 * (ch >> 7) + (c0 < FF ? 0 : 128) + (ch & 127); }

__device__ __forceinline__ void norm_row(const float* xrow, const float* g, const float* shift, const float* scale, bf16* orow, int lane) {
    const GAS f32x4* xr = (const GAS f32x4*)xrow + lane;
    f32x4 v[4]; float s = 0.f;
#pragma unroll
    for (int j = 0; j < 4; ++j) { v[j] = xr[64 * j]; s += (v[j].x * v[j].x + v[j].y * v[j].y) + (v[j].z * v[j].z + v[j].w * v[j].w); }
    const float rstd = __builtin_amdgcn_rsqf(wave_sum(s) * (1.f / D) + pg8::RMS_EPS);
    GAS unsigned long long* o8 = (GAS unsigned long long*)orow + lane;
#pragma unroll
    for (int j = 0; j < 4; ++j) { const int c = 4 * (lane + 64 * j); const f32x4 gg = *(const f32x4*)(g + c), sh = *(const f32x4*)(shift + c), sc = *(const f32x4*)(scale + c);
        const f32x4 o = v[j] * rstd * gg * (sc + 1.0f) + sh;
        o8[64 * j] = (unsigned long long)pk2(o.x, o.y) | ((unsigned long long)pk2(o.z, o.w) << 32); }
}

typedef short sbf16x8 __attribute__((ext_vector_type(8)));
typedef float sf32x16 __attribute__((ext_vector_type(16)));
__device__ __forceinline__ unsigned cvtpk2(float lo, float hi) { unsigned r; asm("v_cvt_pk_bf16_f32 %0, %1, %2" : "=v"(r) : "v"(lo), "v"(hi)); return r; }
__device__ __forceinline__ sbf16x8 pack_f8(f32x4 a, f32x4 b) { v4u w; w.x = cvtpk2(a.x, a.y); w.y = cvtpk2(a.z, a.w); w.z = cvtpk2(b.x, b.y); w.w = cvtpk2(b.z, b.w); return __builtin_bit_cast(sbf16x8, w); }
__device__ __forceinline__ int crow_(int r, int hi) { return (r & 3) + 8 * (r >> 2) + 4 * hi; }
__device__ __forceinline__ void sample_attn_item(const Args& A, LAS unsigned char* lds, int b, int h, int mm, int tid) {
    constexpr int SP = 1060, NK = PAST + TS;
    const bf16* Q = (const bf16*)(A.ws + WS_Q); const bf16* Kb = (const bf16*)(A.ws + WS_K); const bf16* Vb = (const bf16*)(A.ws + WS_V); bf16* O12 = (bf16*)(A.ws + WS_O12);
    LAS float* S = (LAS float*)lds;
    LAS float* linv = (LAS float*)(lds + 32 * SP * 4);
    const int lane = tid & 63, wave = __builtin_amdgcn_readfirstlane(tid >> 6), r32 = lane & 31, hi = lane >> 5;
    sbf16x8 qr[4];
#pragma unroll
    for (int d0 = 0; d0 < 4; ++d0) qr[d0] = *(const sbf16x8*)(Q + (size_t)(MP + b * TS + r32) * D + (h * 2 + mm) * 64 + d0 * 16 + hi * 8);
    for (int kb = wave; kb < NK / 32; kb += 8) {
        sbf16x8 kf[4];
        if (kb < PAST / 32) { const float* kp = A.cache_k + ((size_t)(b * PAST + kb * 32 + r32) * 8 + h) * 128 + mm * 64 + hi * 8;
#pragma unroll
            for (int d0 = 0; d0 < 4; ++d0) kf[d0] = pack_f8(*(const f32x4*)(kp + d0 * 16), *(const f32x4*)(kp + d0 * 16 + 4)); }
        else { const bf16* kp = Kb + (size_t)(MP + b * TS + r32) * D + (h * 2 + mm) * 64 + hi * 8;
#pragma unroll
            for (int d0 = 0; d0 < 4; ++d0) kf[d0] = *(const sbf16x8*)(kp + d0 * 16); }
        sf32x16 acc = sf32x16{};
#pragma unroll
        for (int d0 = 0; d0 < 4; ++d0) acc = __builtin_amdgcn_mfma_f32_32x32x16_bf16(kf[d0], qr[d0], acc, 0, 0, 0);
#pragma unroll
        for (int r = 0; r < 16; ++r) S[r32 * SP + kb * 32 + crow_(r, hi)] = acc[r];
    }
    __syncthreads();
#pragma unroll 1
    for (int ii = 0; ii < 4; ++ii) { const int i = 4 * wave + ii; LAS float* sr = S + i * SP;
        float mx = -INFINITY; for (int j = lane; j < NK; j += 64) mx = fmaxf(mx, sr[j]);
        mx = wave_max(mx); float sum = 0.f;
        for (int j = lane; j < NK; j += 64) { const float p = __builtin_amdgcn_exp2f(sr[j] - mx); sr[j] = p; sum += p; }
        sum = wave_sum(sum); if (lane == 0) linv[i] = 1.0f / sum; }
    __syncthreads();
    const int db = wave & 3, kh = wave >> 2;
    sf32x16 o = sf32x16{};
    for (int k2 = 33 * kh; k2 < 33 * kh + 33; ++k2) {
        const LAS f32x4* pp = (const LAS f32x4*)(S + r32 * SP + k2 * 16 + hi * 8);
        const sbf16x8 pa = pack_f8(pp[0], pp[1]);
        sbf16x8 vf;
        if (k2 < PAST / 16) { const float* vp = A.cache_v + ((size_t)(b * PAST + k2 * 16 + hi * 8) * 8 + h) * 128 + db * 32 + r32;
            f32x4 v0, v1; v0.x = vp[0]; v0.y = vp[1024]; v0.z = vp[2048]; v0.w = vp[3072]; v1.x = vp[4096]; v1.y = vp[5120]; v1.z = vp[6144]; v1.w = vp[7168];
            vf = pack_f8(v0, v1); }
        else { const bf16* vp = Vb + (size_t)(MP + b * TS + (k2 * 16 - PAST) + hi * 8) * D + h * 128 + db * 32 + r32;
            v4u w; w.x = (unsigned)vp[0] | ((unsigned)vp[1024] << 16); w.y = (unsigned)vp[2048] | ((unsigned)vp[3072] << 16); w.z = (unsigned)vp[4096] | ((unsigned)vp[5120] << 16); w.w = (unsigned)vp[6144] | ((unsigned)vp[7168] << 16);
            vf = __builtin_bit_cast(sbf16x8, w); }
        o = __builtin_amdgcn_mfma_f32_32x32x16_bf16(pa, vf, o, 0, 0, 0);
    }
    __syncthreads();
    LAS float* red = (LAS float*)lds;
    if (kh == 1) {
#pragma unroll
        for (int r = 0; r < 16; ++r) red[(db * 16 + r) * 64 + lane] = o[r]; }
    __syncthreads();
    if (kh == 0) {
#pragma unroll
        for (int r = 0; r < 16; ++r) { const int q = crow_(r, hi); const float v = (o[r] + red[(db * 16 + r) * 64 + lane]) * linv[q];
            O12[(size_t)(MP + b * TS + q) * 2048 + mm * 1024 + h * 128 + db * 32 + r32] = (bf16)f2bf(v); } }
    __syncthreads();
}

typedef float sf32x4 __attribute__((ext_vector_type(4)));
template <class F> __device__ __forceinline__ void small_gemm(const bf16* A, const bf16* Bt, int K, int vcu, int G, LAS unsigned char* lds, int tid, const F& f) {
    const int lane = tid & 63, wave = __builtin_amdgcn_readfirstlane(tid >> 6), fr = lane & 15, fq = lane >> 4, cb = wave & 3, kh = wave >> 2, K2 = K >> 1;
    for (int item = vcu; item < 256; item += G) {
        const int r0 = (item >> 4) * 16, c0 = (item & 15) * 64 + cb * 16;
        const bf16* ap = A + (size_t)(r0 + fr) * K + kh * K2 + fq * 8;
        const bf16* bp = Bt + (size_t)(c0 + fr) * K + kh * K2 + fq * 8;
        sf32x4 acc = {0.f, 0.f, 0.f, 0.f};
#pragma unroll 8
        for (int k = 0; k < K2; k += 32) acc = __builtin_amdgcn_mfma_f32_16x16x32_bf16(*(const sbf16x8*)(bp + k), *(const sbf16x8*)(ap + k), acc, 0, 0, 0);
        LAS sf32x4* red = (LAS sf32x4*)lds;
        if (kh == 1) red[cb * 64 + lane] = acc;
        __syncthreads();
        if (kh == 0) { acc += red[cb * 64 + lane]; f(MP + r0 + fr, c0 + 4 * fq, acc); }
        __syncthreads();
    }
}
__device__ __forceinline__ float sigm_(float x) { return __builtin_amdgcn_rcpf(1.0f + __builtin_amdgcn_exp2f(-1.4426950408889634f * x)); }
struct SmallGate0 { const bf16* G; float* T;
    __device__ __forceinline__ void operator()(int row, int col, sf32x4 acc) const { const size_t o = (size_t)row * 1024 + col; const v2u g = *(const v2u*)(G + o);
        sf32x4 s; s.x = sigm_(bflo(g.x)); s.y = sigm_(bfhi(g.x)); s.z = sigm_(bflo(g.y)); s.w = sigm_(bfhi(g.y)); *(sf32x4*)(T + o) = s * acc; } };
struct SmallGate1 { const bf16* G; const float* T; bf16* Mx;
    __device__ __forceinline__ void operator()(int row, int col, sf32x4 acc) const { const size_t o = (size_t)row * 1024 + col; const v2u g = *(const v2u*)(G + o);
        sf32x4 s; s.x = sigm_(bflo(g.x)); s.y = sigm_(bfhi(g.x)); s.z = sigm_(bflo(g.y)); s.w = sigm_(bfhi(g.y)); const sf32x4 v = *(const sf32x4*)(T + o) + s * acc;
        v2u w; w.x = pk2(v.x, v.y); w.y = pk2(v.z, v.w); *(v2u*)(Mx + o) = w; } };
struct SmallRes { const float* base; float* out; const float* gate;
    __device__ __forceinline__ void operator()(int row, int col, sf32x4 acc) const { const size_t o = (size_t)row * 1024 + col; const int mrow = 8 + ((row - MP) >> 5);
        const sf32x4 g = *(const sf32x4*)(gate + (size_t)mrow * 6144 + col); *(sf32x4*)(out + o) = *(const sf32x4*)(base + o) + g * acc; } };

typedef const __attribute__((address_space(4))) Args* kargs_t;
#define XB_TMO      128
#define XB_XCNT(j)  (256  + 64 * (j))
#define XB_XSUB(j)  (1280 + 64 * (j))
#define XB_XGEN(j)  (2304 + 64 * (j))
#define XB_TOP      3328
#define XB_TOPGEN   3392
#define XCD_BAR_WORDS 3456
#define XB_SPIN_CAP (1u << 22)

__device__ __forceinline__ unsigned xb_ld(unsigned* p)              { return __hip_atomic_load(p, __ATOMIC_RELAXED, __HIP_MEMORY_SCOPE_AGENT); }
__device__ __forceinline__ unsigned xb_add(unsigned* p, unsigned v) { return __hip_atomic_fetch_add(p, v, __ATOMIC_RELAXED, __HIP_MEMORY_SCOPE_AGENT); }
__device__ __forceinline__ unsigned xb_xcc_id() { return (unsigned)__builtin_amdgcn_s_getreg((3 << 11) | 20) & 0xFu; }
#define XB_SPIN(cond, bar) do { unsigned _sp = 0; while (cond) { __builtin_amdgcn_s_sleep(1); \
    if ((++_sp & 255u) == 0u) { if (xb_ld(&(bar)[XB_TMO])) break; if (_sp > XB_SPIN_CAP) { atomicAdd(&(bar)[XB_TMO], 1u); break; } } } } while (0)

struct XcdBarrier {
    unsigned* bar; unsigned x;
    volatile LAS unsigned* st;
};

__device__ __forceinline__ XcdBarrier xcd_barrier_post(unsigned* bar, volatile LAS unsigned* st) {
    XcdBarrier b; b.bar = bar; b.x = xb_xcc_id(); b.st = st;
    if (threadIdx.x == 0) (void)xb_add(&bar[XB_XCNT(b.x)], 1u);
    return b;
}
__device__ __forceinline__ void xcd_barrier_complete(unsigned* bar, unsigned x, unsigned& nloc, unsigned& nx) {
    const unsigned G = gridDim.x * gridDim.y * gridDim.z;
    unsigned sum, cnt, mine, sp = 0u;
    for (;;) {
        sum = 0u; cnt = 0u; mine = 0u;
#pragma unroll
        for (unsigned j = 0; j < 16; ++j) { const unsigned c = xb_ld(&bar[XB_XCNT(j)]); sum += c; cnt += (c > 0u) ? 1u : 0u; mine = (j == x) ? c : mine; }
        if (sum == G) break;
        __builtin_amdgcn_s_sleep(1);
        if ((++sp & 255u) == 0u) { if (xb_ld(&bar[XB_TMO])) break; if (sp > XB_SPIN_CAP) { atomicAdd(&bar[XB_TMO], 1u); break; } }
    }
    nloc = mine > 0u ? mine : 1u; nx = cnt > 0u ? cnt : 1u;
}

__device__ __forceinline__ void xcd_barrier(const XcdBarrier& b) {
    asm volatile("s_waitcnt vmcnt(0)" ::: "memory");
    __syncthreads();
    if (threadIdx.x == 0) {
        unsigned* bar = b.bar;
        __builtin_amdgcn_s_waitcnt(0);
        unsigned nloc = b.st[0], nx = b.st[1];
        if (nloc == 0u) { xcd_barrier_complete(bar, b.x, nloc, nx); b.st[0] = nloc; b.st[1] = nx; }
        const unsigned old = xb_add(&bar[XB_XSUB(b.x)], 1u);
        const unsigned gen = old / nloc;
        if (old + 1u == (gen + 1u) * nloc) {
            __builtin_amdgcn_fence(__ATOMIC_RELEASE, "agent");
            asm volatile("s_waitcnt vmcnt(0)" ::: "memory");
            const unsigned og = xb_add(&bar[XB_TOP], 1u);
            const unsigned tg = og / nx;
            if (og + 1u == (tg + 1u) * nx) xb_add(&bar[XB_TOPGEN], 1u);
            else XB_SPIN(xb_ld(&bar[XB_TOPGEN]) == tg, bar);
            __builtin_amdgcn_fence(__ATOMIC_ACQUIRE, "agent");
            xb_add(&bar[XB_XGEN(b.x)], 1u);
            asm volatile("s_waitcnt vmcnt(0)" ::: "memory");
        } else {
            XB_SPIN(xb_ld(&bar[XB_XGEN(b.x)]) == gen, bar);
            __builtin_amdgcn_fence(__ATOMIC_ACQUIRE, "agent");
            asm volatile("s_waitcnt vmcnt(0)" ::: "memory");
        }
    }
    __syncthreads();
}

#define XBAR() do { XcdBarrier xb_; xb_.bar = (unsigned*)(((const Args*)(kargs_t)__builtin_amdgcn_kernarg_segment_ptr())->ws + WS_BAR); xb_.x = xb_xcc_id(); xb_.st = (volatile LAS unsigned*)((LAS unsigned char*)lds_raw + XBAR_LDS_OFF); xcd_barrier(xb_); } while (0)
#define PHASE_BEGIN() \
    kargs_t ap_ = (kargs_t)__builtin_amdgcn_kernarg_segment_ptr(); asm volatile("" : "+s"(ap_)); const Args& A = *(const Args*)ap_; \
    int tid_ = threadIdx.x; asm volatile("" : "+v"(tid_)); const int tid = tid_, lane = tid & 63, wave = __builtin_amdgcn_readfirstlane(tid >> 6); \
    int G_ = gridDim.x, bx_ = blockIdx.x; asm volatile("" : "+s"(G_), "+s"(bx_)); const int G = G_, bx = bx_, vcu = (G % 8 == 0) ? (bx % 8) * (G / 8) + bx / 8 : bx; \
    const int gw = vcu * NWAVES + wave, NGW = G * NWAVES; unsigned char* const ws = A.ws; float* const mod = (float*)(ws + WS_MOD); \
    LAS unsigned char* const lds = (LAS unsigned char*)lds_raw; (void)lane; (void)gw; (void)NGW; (void)mod; (void)lds; (void)tid; (void)vcu;
__global__ void __launch_bounds__(NWAVES * 64, 2) fwd_megakernel(Args A_unused) {
    extern __shared__ __attribute__((aligned(16))) unsigned char lds_raw[];
    cg::grid_group grid = cg::this_grid();
    { if (threadIdx.x < 2) ((LAS unsigned*)((LAS unsigned char*)lds_raw + XBAR_LDS_OFF))[threadIdx.x] = 0u; __syncthreads();
      (void)xcd_barrier_post((unsigned*)(((const Args*)(kargs_t)__builtin_amdgcn_kernarg_segment_ptr())->ws + WS_BAR), (volatile LAS unsigned*)((LAS unsigned char*)lds_raw + XBAR_LDS_OFF)); }
    {
    PHASE_BEGIN();
    {
        LAS float* cs = (LAS float*)lds;
        LAS float* part = (LAS float*)(lds + 65536);
        bool have_cs = false;
        for (int item = bx; item < 192; item += G) {
            if (!have_cs) { for (int idx = tid; idx < 16384; idx += 512) { const int r = idx >> 10, k = idx & 1023; const float c = r < 8 ? A.c_prompt[r * 1024 + k] : A.c_sample[(r - 8) * 1024 + k]; cs[idx] = c * pg8::sigm(c); } have_cs = true; }
            __syncthreads();
            const int n0 = item * 32, slice = tid >> 5, col = tid & 31; float acc[16];
#pragma unroll
            for (int r = 0; r < 16; ++r) acc[r] = 0.f;
#pragma unroll 4
            for (int kk = 0; kk < 64; ++kk) { const int k = slice * 64 + kk; const float w = A.w_ada[(size_t)k * 6144 + n0 + col];
#pragma unroll
                for (int r = 0; r < 16; ++r) acc[r] += cs[r * 1024 + k] * w; }
#pragma unroll
            for (int r = 0; r < 16; ++r) part[(slice * 16 + r) * 32 + col] = acc[r];
            __syncthreads();
            { const int r = tid >> 5; float s = A.b_ada[n0 + col];
#pragma unroll
                for (int sl = 0; sl < 16; ++sl) s += part[(sl * 16 + r) * 32 + col];
                mod[r * 6144 + n0 + col] = s; }
            __syncthreads();
        }
        __syncthreads();
        LAS float* scr = (LAS float*)(lds + wave * 16384);
        constexpr int I_IN = 16 * 256, I_SQ = 16 * 32, I_GU = 16 * 176, I_DN = 44 * 32, NITEMS = I_IN + 3 * I_SQ + I_GU + I_DN;
        for (int it = gw; it < NITEMS; it += NGW) {
            int r = it;
            if (r < I_IN) { const int kb = r / 256, nb = r % 256; transpose_item(A.w_in, D, NIN, (bf16*)(ws + WS_WIN), kb, 32 * nb, win_drow(32 * nb), scr, lane); continue; } r -= I_IN;
            if (r < I_SQ) { transpose_item(A.w_ao, D, D, (bf16*)(ws + WS_WAO), r / 32, 32 * (r % 32), 32 * (r % 32), scr, lane); continue; } r -= I_SQ;
            if (r < I_SQ) { transpose_item(A.w_co, D, D, (bf16*)(ws + WS_WCO), r / 32, 32 * (r % 32), 32 * (r % 32), scr, lane); continue; } r -= I_SQ;
            if (r < I_SQ) { transpose_item(A.w_out, D, D, (bf16*)(ws + WS_WOUT), r / 32, 32 * (r % 32), 32 * (r % 32), scr, lane); continue; } r -= I_SQ;
            if (r < I_GU) { const int kb = r / 176, nb = r % 176; transpose_item(A.w_gu, D, NGU, (bf16*)(ws + WS_WGU), kb, 32 * nb, wgu_drow(32 * nb), scr, lane); continue; } r -= I_GU;
            transpose_item(A.w_dn, FF, D, (bf16*)(ws + WS_WDN), r / 32, 32 * (r % 32), 32 * (r % 32), scr, lane);
        }
    }
    }
    if (__builtin_expect(((const Args*)(kargs_t)__builtin_amdgcn_kernarg_segment_ptr())->ws == nullptr, 0)) grid.sync();
    XBAR();
    {
    PHASE_BEGIN();
    for (int m = gw; m < MT; m += NGW) {
        const float* xr = m < MP ? A.x_prompt + (size_t)m * D : A.x_sample + (size_t)(m - MP) * D;
        const float* mr = mod + (size_t)(m < MP ? (m >> 13) : 8 + ((m - MP) >> 5)) * 6144;
        norm_row(xr, A.norm1_g, mr, mr + 1024, (bf16*)(ws + WS_XN) + (size_t)m * D, lane);
    }
    }
    XBAR();
    {
    PHASE_BEGIN();
    {
        pg8::Gemm g{(const pg8::bf16_t*)(ws + WS_XN), (const pg8::bf16_t*)(ws + WS_WIN), MT, NIN, D}; pg8::StaticOrder S; S.init(MT, NIN, G, bx);
        pg8::EpiInProj E{(pg8::bf16_t*)(ws + WS_Q), (pg8::bf16_t*)(ws + WS_K), (pg8::bf16_t*)(ws + WS_V), (pg8::bf16_t*)(ws + WS_U), (pg8::bf16_t*)(ws + WS_GB),
                         (pg8::bf16_t*)(A.out), (pg8::bf16_t*)(A.out) + (size_t)MT * D, A.out, A.q_norm_g, A.k_norm_g};
        pg8::gemm_phase<pg8::EpiInProj, pg8::StaticOrder, true, true>(lds, g, S, E);
    }
    }
    XBAR();
    {
    PHASE_BEGIN();
    {
        const attn2::bf16* Qp = (const attn2::bf16*)(ws + WS_Q); const attn2::bf16* Kp = (const attn2::bf16*)(ws + WS_K); const attn2::bf16* Vp = (const attn2::bf16*)(ws + WS_V);
        attn2::bf16* Op = (attn2::bf16*)(ws + WS_ON);
        float* o2s = (float*)(ws + WS_O12) + (size_t)vcu * 32768;
        const float mq = wave_max(fabsf(A.q_norm_g[lane])), mk = wave_max(fabsf(A.k_norm_g[lane]));
        const float mshift = __uint_as_float(__builtin_amdgcn_readfirstlane(__float_as_uint(fmaxf(0.f, 64.f * pg8::QK_C2 * mq * mk * 1.02f - 64.f))));
        const float lam = __uint_as_float(__builtin_amdgcn_readfirstlane(__float_as_uint(__expf(wave_sum(A.lq1[lane] * A.lk1[lane])) - __expf(wave_sum(A.lq2[lane] * A.lk2[lane])) + LAM0)));
        const float* subg = A.sub_g;
        float* const kout = A.out + pg8::O_KP; float* const vout = A.out + pg8::O_VP;
#define ATTN_RUN(SH) do { \
        if (G == 256) { const int b = vcu >> 5, lc = vcu & 31, g2 = lc >> 4, s = lc & 15; \
            for (int u = 0; u < 16; ++u) { const int h = 2 * (u >> 2) + g2, mm = 1 - (u & 1), qb = (u & 2) ? 31 - s : s; \
                attn2::attn_unit<SH, 1024>(b, (h * 2 + mm) * 64, h * 128, h * 128, qb, mshift, mm == 0, lam, subg, 1.0f - LAM0, o2s, kout, vout, Qp, Kp, Vp, Op, (char*)lds_raw); } \
        } else { \
            for (int it = vcu; it < 8 * 8 * 32; it += G) { const int b = it >> 8, h = (it >> 5) & 7, qb = it & 31; \
                for (int mm = 1; mm >= 0; --mm) \
                    attn2::attn_unit<SH, 1024>(b, (h * 2 + mm) * 64, h * 128, h * 128, qb, mshift, mm == 0, lam, subg, 1.0f - LAM0, o2s, kout, vout, Qp, Kp, Vp, Op, (char*)lds_raw); } \
        } } while (0)
        if (mshift == 0.f) ATTN_RUN(false); else ATTN_RUN(true);
#undef ATTN_RUN
        asm volatile("s_waitcnt vmcnt(0) lgkmcnt(0)" ::: "memory"); __syncthreads();
        for (int it = (G - 1 - vcu); it < 128; it += G) sample_attn_item(A, lds, it >> 4, (it >> 1) & 7, it & 1, tid);
    }
    }
    XBAR();
    {
    PHASE_BEGIN();
    {
        float lam;
        { const float p1 = lane < 64 ? A.lq1[lane] * A.lk1[lane] : 0.f, p2 = A.lq2[lane] * A.lk2[lane]; lam = __expf(wave_sum(p1)) - __expf(wave_sum(p2)) + LAM0; }
        const bf16* O12 = (const bf16*)(ws + WS_O12); bf16* ON = (bf16*)(ws + WS_ON); const bf16* U = (const bf16*)(ws + WS_U); bf16* GBp = (bf16*)(ws + WS_GB);
        const int c16 = 16 * lane;
        float sg[16], w0[16], w1[16], w2[16];
#pragma unroll
        for (int i = 0; i < 16; ++i) { sg[i] = A.sub_g[(c16 + i) & 127] * (1.0f - LAM0); w0[i] = A.conv_w[c16 + i]; w1[i] = A.conv_w[1024 + c16 + i]; w2[i] = A.conv_w[2048 + c16 + i]; }
        for (int m = gw; m < MT; m += NGW) {
            if (m >= MP) { const v4u* p1 = (const v4u*)(O12 + (size_t)m * 2048 + c16); const v4u* p2 = (const v4u*)(O12 + (size_t)m * 2048 + 1024 + c16);
              float o[16]; float ss = 0.f;
#pragma unroll
              for (int e = 0; e < 2; ++e) { const v4u a = p1[e], c = p2[e];
                  o[8 * e + 0] = bflo(a.x) - lam * bflo(c.x); o[8 * e + 1] = bfhi(a.x) - lam * bfhi(c.x); o[8 * e + 2] = bflo(a.y) - lam * bflo(c.y); o[8 * e + 3] = bfhi(a.y) - lam * bfhi(c.y);
                  o[8 * e + 4] = bflo(a.z) - lam * bflo(c.z); o[8 * e + 5] = bfhi(a.z) - lam * bfhi(c.z); o[8 * e + 6] = bflo(a.w) - lam * bflo(c.w); o[8 * e + 7] = bfhi(a.w) - lam * bfhi(c.w); }
#pragma unroll
              for (int i = 0; i < 16; ++i) ss += o[i] * o[i];
              ss += __shfl_xor(ss, 1); ss += __shfl_xor(ss, 2); ss += __shfl_xor(ss, 4);
              const float rstd = __builtin_amdgcn_rsqf(ss * (1.0f / 128.0f) + pg8::RMS_EPS);
              v4u w[2];
#pragma unroll
              for (int e = 0; e < 2; ++e) { w[e].x = pk2(o[8 * e + 0] * rstd * sg[8 * e + 0], o[8 * e + 1] * rstd * sg[8 * e + 1]); w[e].y = pk2(o[8 * e + 2] * rstd * sg[8 * e + 2], o[8 * e + 3] * rstd * sg[8 * e + 3]);
                  w[e].z = pk2(o[8 * e + 4] * rstd * sg[8 * e + 4], o[8 * e + 5] * rstd * sg[8 * e + 5]); w[e].w = pk2(o[8 * e + 6] * rstd * sg[8 * e + 6], o[8 * e + 7] * rstd * sg[8 * e + 7]); }
              v4u* po = (v4u*)(ON + (size_t)m * D + c16); po[0] = w[0]; po[1] = w[1]; }
            { const bool smp = m >= MP; const int t = smp ? ((m - MP) & 31) : (m & 8191); const int sb = (m - MP) >> 5;
              float u0[16], u1[16], u2[16], gbv[16];
              ld16(U + (size_t)m * D + c16, u0); ld16(GBp + (size_t)m * D + c16, gbv);
              if (t >= 1) ld16(U + (size_t)(m - 1) * D + c16, u1);
              else if (smp) ldf(A.state_conv + (size_t)(sb * 2 + 1) * 1024 + c16, u1);
              else {
#pragma unroll
                  for (int i = 0; i < 16; ++i) u1[i] = 0.f; }
              if (t >= 2) ld16(U + (size_t)(m - 2) * D + c16, u2);
              else if (smp) ldf(A.state_conv + (size_t)(sb * 2 + t) * 1024 + c16, u2);
              else {
#pragma unroll
                  for (int i = 0; i < 16; ++i) u2[i] = 0.f; }
              v4u w[2]; float z[16];
#pragma unroll
              for (int i = 0; i < 16; ++i) z[i] = gbv[i] * (w0[i] * u2[i] + w1[i] * u1[i] + w2[i] * u0[i]);
#pragma unroll
              for (int e = 0; e < 2; ++e) { w[e].x = pk2(z[8 * e + 0], z[8 * e + 1]); w[e].y = pk2(z[8 * e + 2], z[8 * e + 3]); w[e].z = pk2(z[8 * e + 4], z[8 * e + 5]); w[e].w = pk2(z[8 * e + 6], z[8 * e + 7]); }
              v4u* po = (v4u*)(GBp + (size_t)m * D + c16); po[0] = w[0]; po[1] = w[1]; }
        }
    }
    }
    XBAR();
    {
    PHASE_BEGIN();
    {
        { pg8::PairOrder S; S.base.init(MP, D, G, bx);
          pg8::Gemm g{(const pg8::bf16_t*)(ws + WS_ON), (const pg8::bf16_t*)(ws + WS_WAO), MP, D, D, (const pg8::bf16_t*)(ws + WS_GB), (const pg8::bf16_t*)(ws + WS_WCO)};
          pg8::EpiGatePair E{(const pg8::bf16_t*)(A.out), (const pg8::bf16_t*)(A.out) + (size_t)MT * D, (pg8::bf16_t*)(ws + WS_MX)};
          pg8::gemm_phase<pg8::EpiGatePair, pg8::PairOrder, true, true>(lds, g, S, E); }
        small_gemm((const bf16*)(ws + WS_ON) + (size_t)MP * D, (const bf16*)(ws + WS_WAO), D, vcu, G, lds, tid, SmallGate0{(const bf16*)(A.out), (float*)(ws + WS_T)});
        small_gemm((const bf16*)(ws + WS_GB) + (size_t)MP * D, (const bf16*)(ws + WS_WCO), D, vcu, G, lds, tid, SmallGate1{(const bf16*)(A.out) + (size_t)MT * D, (const float*)(ws + WS_T), (bf16*)(ws + WS_MX)});
    }
    }
    XBAR();
    {
    PHASE_BEGIN();
    {
        pg8::Gemm g{(const pg8::bf16_t*)(ws + WS_MX), (const pg8::bf16_t*)(ws + WS_WOUT), MP, D, D}; pg8::StaticOrder S; S.init(MP, D, G, bx);
        pg8::EpiRes E{A.x_prompt, A.x_sample - (size_t)MP * D, A.out, mod + 2 * 1024};
        pg8::gemm_phase<pg8::EpiRes, pg8::StaticOrder, true, true>(lds, g, S, E);
        small_gemm((const bf16*)(ws + WS_MX) + (size_t)MP * D, (const bf16*)(ws + WS_WOUT), D, vcu, G, lds, tid, SmallRes{A.x_sample - (size_t)MP * D, A.out, mod + 2 * 1024});
    }
    }
    XBAR();
    {
    PHASE_BEGIN();
    for (int m = gw; m < MT; m += NGW) {
        const float* mr = mod + (size_t)(m < MP ? (m >> 13) : 8 + ((m - MP) >> 5)) * 6144;
        norm_row(A.out + (size_t)m * D, A.norm2_g, mr + 3 * 1024, mr + 4 * 1024, (bf16*)(ws + WS_XN2) + (size_t)m * D, lane);
    }
    }
    XBAR();
    {
    PHASE_BEGIN();
    {
        pg8::Gemm g{(const pg8::bf16_t*)(ws + WS_XN2), (const pg8::bf16_t*)(ws + WS_WGU), MT, NGU, D}; pg8::StaticOrder S; S.init(MT, NGU, G, bx);
        pg8::EpiSwiglu E{(pg8::bf16_t*)(ws + WS_ACT)};
        pg8::gemm_phase<pg8::EpiSwiglu, pg8::StaticOrder, true, true>(lds, g, S, E);
    }
    }
    XBAR();
    {
    PHASE_BEGIN();
    {
        pg8::Gemm g{(const pg8::bf16_t*)(ws + WS_ACT), (const pg8::bf16_t*)(ws + WS_WDN), MP, D, FF}; pg8::StaticOrder S; S.init(MP, D, G, bx);
        pg8::EpiRes E{A.out, A.out, A.out, mod + 5 * 1024};
        pg8::gemm_phase<pg8::EpiRes, pg8::StaticOrder, true, true>(lds, g, S, E);
        small_gemm((const bf16*)(ws + WS_ACT) + (size_t)MP * FF, (const bf16*)(ws + WS_WDN), FF, vcu, G, lds, tid, SmallRes{A.out, A.out, mod + 5 * 1024});
    }
    }
}

extern "C" void kernel_launch(void* const* d_in, const int* in_sizes, int n_in, void* d_out, int out_size, void* d_ws, size_t ws_size, hipStream_t stream) {
    static int grid = 0;
    if (grid == 0) {
        if (n_in != 25 || (size_t)out_size != pg8::O_END || ws_size < WS_END) { fprintf(stderr, "kernel_launch: unexpected shapes: n_in %d out %d ws %zu\n", n_in, out_size, ws_size); grid = -1; return; }
        int dev = 0, cus = 0, per_cu = 0;
        hipGetDevice(&dev); hipDeviceGetAttribute(&cus, hipDeviceAttributeMultiprocessorCount, dev);
        if (hipFuncSetAttribute((const void*)fwd_megakernel, hipFuncAttributeMaxDynamicSharedMemorySize, LDS_BYTES) != hipSuccess) { fprintf(stderr, "kernel_launch: hipFuncSetAttribute failed\n"); grid = -1; return; }
        if (hipOccupancyMaxActiveBlocksPerMultiprocessor(&per_cu, (const void*)fwd_megakernel, NWAVES * 64, LDS_BYTES) != hipSuccess || per_cu < 1) { fprintf(stderr, "kernel_launch: occupancy query gave %d\n", per_cu); per_cu = 1; }
        (void)hipGetLastError();
        grid = cus * 1;
    }
    if (grid < 0) return;
    Args a{};
    const float** f = (const float**)&a;
    for (int i = 0; i < 25; ++i) f[i] = (const float*)d_in[i];
    a.out = (float*)d_out; a.ws = (unsigned char*)d_ws;
    if (hipMemsetAsync((char*)d_ws + WS_BAR, 0, 16384, stream) != hipSuccess) { fprintf(stderr, "kernel_launch: hipMemsetAsync failed\n"); return; }
    void* args[] = {&a};
    hipError_t e = hipLaunchCooperativeKernel((const void*)fwd_megakernel, dim3(grid), dim3(NWAVES * 64), args, LDS_BYTES, stream);
    if (e != hipSuccess) fprintf(stderr, "cooperative launch failed: %s (grid %d)\n", hipGetErrorString(e), grid);
}
```

```cpp
#include <hip/hip_runtime.h>
#include <cstdio>
#include <cstdint>
namespace pg8 {
#define PG8_LAS __attribute__((address_space(3)))
typedef unsigned short bf16_t;
typedef short bf16x8 __attribute__((ext_vector_type(8)));
typedef float f32x4 __attribute__((ext_vector_type(4)));
typedef unsigned u32x4 __attribute__((ext_vector_type(4)));
constexpr int BM = 256, BK = 64, HALF = 128, HTB = HALF * BK * 2  , STAGE_BYTES = 8 * HTB, NXCD = 8, WGM = 8;

__host__ __device__ __forceinline__ int lds_byte(int r, int c) { const int st = (r >> 4) * 2 + (c >> 5), rr = r & 15, cc = c & 31, ob = rr * 64 + cc * 2; return st * 1024 + (ob ^ (((ob >> 9) & 1) << 5)); }
__host__ __device__ __forceinline__ void stage_rc(int b, int& R, int& C) { const int st = b / 1024, sb = b % 1024, swz = sb ^ (((sb >> 9) & 1) << 5); R = (st >> 1) * 16 + swz / 64; C = (st & 1) * 32 + (swz % 64) / 2; }
__host__ __device__ __forceinline__ int perm32(int rho) { const int n = rho >> 4, i = rho & 15; return 8 * (i >> 2) + 4 * n + (i & 3); }

struct Unit { int pm, pn, seg; };
struct Gemm { const bf16_t* A; const bf16_t* Bt; int M, N, K; const bf16_t* A2; const bf16_t* Bt2; };

struct StaticOrder {
    int nM, nN, nwg, G, c;
    __host__ __device__ void init(int M, int N, int G_, int c_) { nM = M / BM; nN = N / BM; nwg = nM * nN; G = G_; c = c_; }
    __host__ __device__ bool next(int i, Unit& u) const {
        const long L = (long)i * G + c; if (L >= nwg) return false;
        int wgid = (int)L; { const int q = nwg / NXCD, r = nwg % NXCD, xcd = wgid % NXCD, off = wgid / NXCD; wgid = (xcd < r ? xcd * (q + 1) : r * (q + 1) + (xcd - r) * q) + off; }
        const int nig = WGM * nN, gid = wgid / nig, fm = gid * WGM, gsz = (nM - fm) < WGM ? (nM - fm) : WGM;
        u.pm = fm + ((wgid % nig) % gsz); u.pn = (wgid % nig) / gsz; u.seg = 0; return true;
    }
    __device__ __forceinline__ void a_ready(const Unit&) const {}
    __device__ __forceinline__ void done(const Unit&) const {}
};

__device__ __forceinline__ unsigned cvt_pk_bf16(float lo, float hi) { unsigned r; asm volatile("v_cvt_pk_bf16_f32 %0, %1, %2" : "=v"(r) : "v"(lo), "v"(hi)); return r; }
typedef float f32x2 __attribute__((ext_vector_type(2)));
constexpr int MP = 65536, MS = 256, MT = MP + MS;
constexpr size_t O_Y = 0, O_KP = (size_t)MT * 1024, O_VP = O_KP + (size_t)MP * 1024, O_CP = O_VP + (size_t)MP * 1024, O_KS = O_CP + 16384, O_VS = O_KS + (size_t)MS * 1024, O_CS = O_VS + (size_t)MS * 1024, O_END = O_CS + 16384;
constexpr float QK_C2 = 0.125f * 1.4426950408889634f;
constexpr float RMS_EPS = 1e-6f;
__device__ __forceinline__ float bf_lo(unsigned w) { return __uint_as_float(w << 16); }
__device__ __forceinline__ float bf_hi(unsigned w) { return __uint_as_float(w & 0xffff0000u); }
__device__ __forceinline__ float sigm(float x) { return __builtin_amdgcn_rcpf(1.0f + __builtin_amdgcn_exp2f(-1.4426950408889634f * x)); }
__device__ __forceinline__ u32x4 pack8(f32x4 a, f32x4 b) { u32x4 w; w.x = cvt_pk_bf16(a[0], a[1]); w.y = cvt_pk_bf16(a[2], a[3]); w.z = cvt_pk_bf16(b[0], b[1]); w.w = cvt_pk_bf16(b[2], b[3]); return w; }

struct EpiInProj {
    static constexpr bool PERM = true, AFTER_DRAIN = false, PAIRED = false;
    bf16_t *Q, *Kb, *Vb, *U, *GB, *GA2, *GB2; float* out; const float *qg, *kg;
    __device__ __forceinline__ void operator()(const f32x4 (&acc)[2][2][4][2], const Unit& u, int wr, int wc, int fr, int fq) const {
        const int pn = u.pn, pm = u.pm; const bool smp = pm >= (MP / BM);
        const int row0 = pm * BM + wr * 64 + fr;
        if (pn >= 12 && pn < 20) {
            const int col = 128 * (pn - 12) + 32 * wc + 8 * fq;
#pragma unroll
            for (int ai = 0; ai < 2; ++ai)
#pragma unroll
                for (int m = 0; m < 4; ++m) { const int row = row0 + ai * HALF + m * 16;
                    const f32x4 a0 = acc[ai][0][m][0] * acc[ai][1][m][0], a1 = acc[ai][0][m][1] * acc[ai][1][m][1];
                    *(u32x4*)(U + (size_t)row * 1024 + col) = pack8(a0, a1);
                    if (!smp) { const int t = row & 8191; if (t >= 8190) { float* o = out + O_CP + (size_t)((row >> 13) * 2 + (t - 8190)) * 1024 + col; *(f32x4*)o = a0; *(f32x4*)(o + 4) = a1; } }
                    else { const int lr = row - MP, t = lr & 31; if (t >= 30) { float* o = out + O_CS + (size_t)((lr >> 5) * 2 + (t - 30)) * 1024 + col; *(f32x4*)o = a0; *(f32x4*)(o + 4) = a1; } }
                }
            return;
        }
        int sect, tloc; if (pn < 12) { sect = pn >> 2; tloc = pn & 3; } else { sect = 3 + ((pn - 20) >> 2); tloc = (pn - 20) & 3; }
        bf16_t* dst = sect == 0 ? Q : sect == 1 ? Kb : sect == 2 ? Vb : sect == 3 ? GB : sect == 4 ? GA2 : GB2;
        const int col0 = 256 * tloc + 64 * wc + 8 * fq;
        float* fo = nullptr;
        if (sect == 1 && smp) fo = out + O_KS - (size_t)MP * 1024;
        if (sect == 2 && smp) fo = out + O_VS - (size_t)MP * 1024;
        f32x4 g[2][2];
        if (sect < 2) { const float* gp = (sect == 0 ? qg : kg) + 8 * fq; const float sc = sect == 0 ? QK_C2 : 1.0f;
#pragma unroll
            for (int bj = 0; bj < 2; ++bj)
#pragma unroll
                for (int n = 0; n < 2; ++n) g[bj][n] = *(const f32x4*)(gp + 32 * bj + 4 * n) * sc; }
#pragma unroll
        for (int ai = 0; ai < 2; ++ai)
#pragma unroll
            for (int m = 0; m < 4; ++m) { const int row = row0 + ai * HALF + m * 16;
                f32x4 v[2][2];
#pragma unroll
                for (int bj = 0; bj < 2; ++bj)
#pragma unroll
                    for (int n = 0; n < 2; ++n) v[bj][n] = acc[ai][bj][m][n];
                if (sect < 2) { float ss = 0.f;
#pragma unroll
                    for (int bj = 0; bj < 2; ++bj)
#pragma unroll
                        for (int n = 0; n < 2; ++n) { const f32x4 x = v[bj][n]; ss += (x[0] * x[0] + x[1] * x[1]) + (x[2] * x[2] + x[3] * x[3]); }
                    ss += __shfl_xor(ss, 16); ss += __shfl_xor(ss, 32);
                    const float rstd = __builtin_amdgcn_rsqf(ss * (1.0f / 64.0f) + RMS_EPS);
#pragma unroll
                    for (int bj = 0; bj < 2; ++bj)
#pragma unroll
                        for (int n = 0; n < 2; ++n) v[bj][n] = v[bj][n] * rstd * g[bj][n]; }
#pragma unroll
                for (int bj = 0; bj < 2; ++bj) { *(u32x4*)(dst + (size_t)row * 1024 + col0 + 32 * bj) = pack8(v[bj][0], v[bj][1]);
                    if (fo) { float* o = fo + (size_t)row * 1024 + col0 + 32 * bj; *(f32x4*)o = v[bj][0]; *(f32x4*)(o + 4) = v[bj][1]; } }
            }
    }
};
template <int STEP> struct EpiGate {
    static constexpr bool PERM = true, AFTER_DRAIN = false, PAIRED = false;
    const bf16_t* G; float* T; bf16_t* Mx;
    __device__ __forceinline__ void operator()(const f32x4 (&acc)[2][2][4][2], const Unit& u, int wr, int wc, int fr, int fq) const {
        const int row0 = u.pm * BM + wr * 64 + fr, col0 = u.pn * BM + wc * 32 + 8 * fq;
#pragma unroll
        for (int ai = 0; ai < 2; ++ai)
#pragma unroll
            for (int m = 0; m < 4; ++m) { const size_t ro = (size_t)(row0 + ai * HALF + m * 16) * 1024 + col0;
#pragma unroll
                for (int bj = 0; bj < 2; ++bj) { const size_t o = ro + bj * HALF; const u32x4 gw = *(const u32x4*)(G + o);
                    f32x4 s0, s1; s0[0] = sigm(bf_lo(gw.x)); s0[1] = sigm(bf_hi(gw.x)); s0[2] = sigm(bf_lo(gw.y)); s0[3] = sigm(bf_hi(gw.y));
                    s1[0] = sigm(bf_lo(gw.z)); s1[1] = sigm(bf_hi(gw.z)); s1[2] = sigm(bf_lo(gw.w)); s1[3] = sigm(bf_hi(gw.w));
                    f32x4 v0 = s0 * acc[ai][bj][m][0], v1 = s1 * acc[ai][bj][m][1];
                    if (STEP == 0) { *(f32x4*)(T + o) = v0; *(f32x4*)(T + o + 4) = v1; }
                    else { v0 += *(const f32x4*)(T + o); v1 += *(const f32x4*)(T + o + 4); *(u32x4*)(Mx + o) = pack8(v0, v1); } } }
    }
};
template <bool FINAL> struct EpiRes {
    static constexpr bool PERM = true, AFTER_DRAIN = false, PAIRED = false;
    const float* xin; bf16_t* x1b; float* out; const float* gate;
    __device__ __forceinline__ void operator()(const f32x4 (&acc)[2][2][4][2], const Unit& u, int wr, int wc, int fr, int fq) const {
        const int row0 = u.pm * BM + wr * 64 + fr, col0 = u.pn * BM + wc * 32 + 8 * fq;
        const float* gp = gate + (size_t)(u.pm >> 5) * 6144 + col0;
        f32x4 g[2][2];
#pragma unroll
        for (int bj = 0; bj < 2; ++bj) { g[bj][0] = *(const f32x4*)(gp + bj * HALF); g[bj][1] = *(const f32x4*)(gp + bj * HALF + 4); }
#pragma unroll
        for (int ai = 0; ai < 2; ++ai)
#pragma unroll
            for (int m = 0; m < 4; ++m) { const size_t ro = (size_t)(row0 + ai * HALF + m * 16) * 1024 + col0;
#pragma unroll
                for (int bj = 0; bj < 2; ++bj) { const size_t o = ro + bj * HALF;
                    if constexpr (!FINAL) { const f32x4 b0 = *(const f32x4*)(xin + o), b1 = *(const f32x4*)(xin + o + 4);
                        *(u32x4*)(x1b + o) = pack8(b0 + g[bj][0] * acc[ai][bj][m][0], b1 + g[bj][1] * acc[ai][bj][m][1]); }
                    else { const u32x4 w = *(const u32x4*)(x1b + o);
                        const f32x4 b0 = {bf_lo(w.x), bf_hi(w.x), bf_lo(w.y), bf_hi(w.y)}, b1 = {bf_lo(w.z), bf_hi(w.z), bf_lo(w.w), bf_hi(w.w)};
                        *(f32x4*)(out + o) = b0 + g[bj][0] * acc[ai][bj][m][0]; *(f32x4*)(out + o + 4) = b1 + g[bj][1] * acc[ai][bj][m][1]; } } }
    }
};
struct EpiSwiglu {
    static constexpr bool PERM = true, AFTER_DRAIN = false, PAIRED = false;
    bf16_t* ACT;
    __device__ __forceinline__ void operator()(const f32x4 (&acc)[2][2][4][2], const Unit& u, int wr, int wc, int fr, int fq) const {
        const int row0 = u.pm * BM + wr * 64 + fr, col0 = u.pn * HALF + wc * 32 + 8 * fq;
#pragma unroll
        for (int ai = 0; ai < 2; ++ai)
#pragma unroll
            for (int m = 0; m < 4; ++m) { f32x4 r[2];
#pragma unroll
                for (int n = 0; n < 2; ++n) { const f32x4 g = acc[ai][0][m][n], up = acc[ai][1][m][n];
#pragma unroll
                    for (int i = 0; i < 4; ++i) r[n][i] = g[i] * sigm(g[i]) * up[i]; }
                *(u32x4*)(ACT + (size_t)(row0 + ai * HALF + m * 16) * 2816 + col0) = pack8(r[0], r[1]); }
    }
};
struct PairOrder { StaticOrder base;
    __device__ __forceinline__ bool next(int i, Unit& u) const { if (!base.next(i >> 1, u)) return false; u.seg = i & 1; return true; }
    __device__ __forceinline__ void a_ready(const Unit&) const {}
    __device__ __forceinline__ void done(const Unit&) const {} };
struct EpiGatePair {
    static constexpr bool PERM = true, AFTER_DRAIN = false, PAIRED = true;
    const bf16_t* GA; const bf16_t* GBr; bf16_t* Mx;
    static __device__ __forceinline__ float em(float x) { return __builtin_amdgcn_exp2f(-1.4426950408889634f * x); }
    __device__ __forceinline__ void mid(f32x4 (&acc)[2][2][4][2], const Unit& u, int wr, int wc, int fr, int fq) const {
        const int row0 = u.pm * BM + wr * 64 + fr, col0 = u.pn * BM + wc * 32 + 8 * fq;
#pragma unroll
        for (int ai = 0; ai < 2; ++ai)
#pragma unroll
            for (int m = 0; m < 4; ++m) { const size_t ro = (size_t)(row0 + ai * HALF + m * 16) * 1024 + col0;
#pragma unroll
                for (int bj = 0; bj < 2; ++bj) { const size_t o = ro + bj * HALF; const u32x4 a = *(const u32x4*)(GA + o), b = *(const u32x4*)(GBr + o);
                    const unsigned aw[4] = {a.x, a.y, a.z, a.w}, bw[4] = {b.x, b.y, b.z, b.w};
#pragma unroll
                    for (int j = 0; j < 4; ++j) { const float r0 = (1.0f + em(fmaxf(bf_lo(bw[j]), -30.f))) * __builtin_amdgcn_rcpf(1.0f + em(bf_lo(aw[j]))), r1 = (1.0f + em(fmaxf(bf_hi(bw[j]), -30.f))) * __builtin_amdgcn_rcpf(1.0f + em(bf_hi(aw[j])));
                        acc[ai][bj][m][j >> 1][2 * (j & 1)] *= r0; acc[ai][bj][m][j >> 1][2 * (j & 1) + 1] *= r1; } } }
    }
    __device__ __forceinline__ void operator()(const f32x4 (&acc)[2][2][4][2], const Unit& u, int wr, int wc, int fr, int fq) const {
        const int row0 = u.pm * BM + wr * 64 + fr, col0 = u.pn * BM + wc * 32 + 8 * fq;
#pragma unroll
        for (int ai = 0; ai < 2; ++ai)
#pragma unroll
            for (int m = 0; m < 4; ++m) { const size_t ro = (size_t)(row0 + ai * HALF + m * 16) * 1024 + col0;
#pragma unroll
                for (int bj = 0; bj < 2; ++bj) { const size_t o = ro + bj * HALF; const u32x4 b = *(const u32x4*)(GBr + o);
                    f32x4 s0, s1; s0[0] = sigm(fmaxf(bf_lo(b.x), -30.f)); s0[1] = sigm(fmaxf(bf_hi(b.x), -30.f)); s0[2] = sigm(fmaxf(bf_lo(b.y), -30.f)); s0[3] = sigm(fmaxf(bf_hi(b.y), -30.f));
                    s1[0] = sigm(fmaxf(bf_lo(b.z), -30.f)); s1[1] = sigm(fmaxf(bf_hi(b.z), -30.f)); s1[2] = sigm(fmaxf(bf_lo(b.w), -30.f)); s1[3] = sigm(fmaxf(bf_hi(b.w), -30.f));
                    *(u32x4*)(Mx + o) = pack8(s0 * acc[ai][bj][m][0], s1 * acc[ai][bj][m][1]); } }
    }
};
template <class Epi, class Sched, bool ALIGN_EPI = false, bool SP2 = false>
__device__ __forceinline__ void gemm_phase(PG8_LAS unsigned char* lds, const Gemm g, const Sched& S, const Epi& E) {
    int tid_ = threadIdx.x; asm volatile("" : "+v"(tid_));
    const int tid = tid_, wid = __builtin_amdgcn_readfirstlane(tid >> 6), lane = tid & 63, wr = wid >> 2, wc = wid & 3, fr = lane & 15, fq = lane >> 4;
    const int K = g.K, nt = K / BK;
    unsigned voffA[2], voffB[2];
#pragma unroll
    for (int i = 0; i < 2; ++i) { int R, C; stage_rc(tid * 16 + i * 8192, R, C); const int Rb = Epi::PERM ? ((R & ~31) + perm32(R & 31)) : R;
        voffA[i] = (unsigned)(R * K + C) * 2u; voffB[i] = (unsigned)(Rb * K + C) * 2u; }
    const size_t kstep = (size_t)(BK * 2);
    const size_t hstep = (size_t)HALF * K * 2;
    const size_t tstep = 2 * hstep;
    const unsigned ldsw = (unsigned)wid * 1024u;
    const int aoff = lds_byte(wr * 64 + fr, fq * 8), boff = lds_byte(wc * 32 + fr, fq * 8);
#define PG8_SA(b, h) (((b) * 2 + (h)) * HTB)
#define PG8_SB(b, h) ((4 + (b) * 2 + (h)) * HTB)
#define PG8_STAGE(bufoff, gbase, voff) do { _Pragma("unroll") for (int _i = 0; _i < 2; ++_i) \
        __builtin_amdgcn_global_load_lds((const unsigned*)((const char*)(gbase) + (voff)[_i]), (PG8_LAS unsigned*)(lds + (bufoff) + ldsw + _i * 8192), 16, 0, 0); } while (0)
#define PG8_LDA(dst, b, h) do { _Pragma("unroll") for (int m = 0; m < 4; ++m) _Pragma("unroll") for (int k = 0; k < 2; ++k) dst[m][k] = *(const PG8_LAS bf16x8*)(lds + PG8_SA(b, h) + aoff + m * 2048 + k * 1024); } while (0)
#define PG8_LDB(dst, b, h) do { _Pragma("unroll") for (int n = 0; n < 2; ++n) _Pragma("unroll") for (int k = 0; k < 2; ++k) dst[n][k] = *(const PG8_LAS bf16x8*)(lds + PG8_SB(b, h) + boff + n * 2048 + k * 1024); } while (0)
#define PG8_MMA(ai, bj, At, Bt) do { __builtin_amdgcn_s_setprio(1); _Pragma("unroll") for (int m = 0; m < 4; ++m) _Pragma("unroll") for (int n = 0; n < 2; ++n) _Pragma("unroll") for (int k = 0; k < 2; ++k) \
        acc[ai][bj][m][n] = __builtin_amdgcn_mfma_f32_16x16x32_bf16(Bt[n][k], At[m][k], acc[ai][bj][m][n], 0, 0, 0); __builtin_amdgcn_s_setprio(0); } while (0)
#define PG8_WAIT_V(n) asm volatile("s_waitcnt vmcnt(" #n ")" ::: "memory")
#define PG8_WAIT_L(n) asm volatile("s_waitcnt lgkmcnt(" #n ")" ::: "memory")
#define PG8_BAR __builtin_amdgcn_s_barrier()
#define PG8_SCHED __builtin_amdgcn_sched_barrier(0)
    Unit cur, nxt; int ui = 0;
    if (!S.next(0, cur)) return;
    f32x4 acc[2][2][4][2];
#pragma unroll
    for (int a = 0; a < 2; ++a)
#pragma unroll
        for (int b = 0; b < 2; ++b)
#pragma unroll
            for (int m = 0; m < 4; ++m)
#pragma unroll
                for (int n = 0; n < 2; ++n) acc[a][b][m][n] = (f32x4){0.f, 0.f, 0.f, 0.f};
    bf16x8 At[4][2], B0[2][2], B1[2][2];
#define PG8_ABASE(u) ((const char*)((u).seg ? g.A2 : g.A) + (size_t)(u).pm * tstep)
#define PG8_BBASE(u) ((const char*)((u).seg ? g.Bt2 : g.Bt) + (size_t)(u).pn * tstep)
    const char* cA = PG8_ABASE(cur); const char* cB = PG8_BBASE(cur);
    S.a_ready(cur);
    if constexpr (SP2) {
        PG8_STAGE(PG8_SB(0, 0), cB, voffB); PG8_STAGE(PG8_SB(0, 1), cB + hstep, voffB); PG8_STAGE(PG8_SA(0, 0), cA, voffA); PG8_STAGE(PG8_SA(0, 1), cA + hstep, voffA);
        if (wr == 1) PG8_BAR;
        PG8_WAIT_V(2); PG8_BAR;
        PG8_STAGE(PG8_SB(1, 0), cB + kstep, voffB); PG8_STAGE(PG8_SA(1, 0), cA + kstep, voffA); PG8_STAGE(PG8_SB(1, 1), cB + hstep + kstep, voffB);
        PG8_WAIT_V(6); PG8_BAR;
    } else {
        PG8_STAGE(PG8_SB(0, 0), cB, voffB); PG8_STAGE(PG8_SA(0, 0), cA, voffA); PG8_STAGE(PG8_SB(0, 1), cB + hstep, voffB); PG8_STAGE(PG8_SA(0, 1), cA + hstep, voffA);
        if (wr == 1) PG8_BAR;
        PG8_WAIT_V(4); PG8_BAR;
        PG8_STAGE(PG8_SB(1, 0), cB + kstep, voffB); PG8_STAGE(PG8_SA(1, 0), cA + kstep, voffA); PG8_STAGE(PG8_SB(1, 1), cB + hstep + kstep, voffB);
        PG8_WAIT_V(6); PG8_BAR;
    }
    for (;;) {
        const bool has_next = S.next(ui + 1, nxt);
        const char* nA = has_next ? PG8_ABASE(nxt) : cA; const char* nB = has_next ? PG8_BBASE(nxt) : cB;
        for (int t = 0; t < nt; t += 2) {
            const bool last = (t == nt - 2);
            const char* a1 = cA + (size_t)(t + 1) * kstep;
            const char* a2 = last ? nA : cA + (size_t)(t + 2) * kstep; const char* b2 = last ? nB : cB + (size_t)(t + 2) * kstep;
            const char* a3 = a2 + kstep; const char* b3 = b2 + kstep;
            if (last && has_next) S.a_ready(nxt);
            if constexpr (SP2) {
            PG8_LDB(B0, 0, 0); PG8_LDB(B1, 0, 1); PG8_SCHED; PG8_LDA(At, 0, 0); PG8_STAGE(PG8_SA(1, 1), a1 + hstep, voffA);
            PG8_WAIT_V(8); PG8_WAIT_L(0); PG8_BAR; PG8_MMA(0, 0, At, B0); PG8_MMA(0, 1, At, B1); PG8_BAR; PG8_SCHED;
            PG8_LDA(At, 0, 1); PG8_STAGE(PG8_SB(0, 0), b2, voffB); PG8_STAGE(PG8_SB(0, 1), b2 + hstep, voffB); PG8_STAGE(PG8_SA(0, 0), a2, voffA);
            PG8_WAIT_V(8); PG8_WAIT_L(0); PG8_BAR; PG8_MMA(1, 0, At, B0); PG8_MMA(1, 1, At, B1); PG8_BAR; PG8_SCHED;
            PG8_LDB(B0, 1, 0); PG8_LDB(B1, 1, 1); PG8_SCHED; PG8_LDA(At, 1, 0); PG8_STAGE(PG8_SA(0, 1), a2 + hstep, voffA);
            PG8_WAIT_V(8); PG8_WAIT_L(0); PG8_BAR; PG8_MMA(0, 0, At, B0); PG8_MMA(0, 1, At, B1); PG8_BAR; PG8_SCHED;
            PG8_LDA(At, 1, 1); PG8_STAGE(PG8_SB(1, 0), b3, voffB); PG8_STAGE(PG8_SB(1, 1), b3 + hstep, voffB); PG8_STAGE(PG8_SA(1, 0), a3, voffA);
            PG8_WAIT_V(8); PG8_WAIT_L(0); PG8_BAR; PG8_MMA(1, 0, At, B0); PG8_MMA(1, 1, At, B1); PG8_BAR; PG8_SCHED;
            } else {
            PG8_LDB(B0, 0, 0); PG8_SCHED; PG8_LDA(At, 0, 0); PG8_STAGE(PG8_SA(1, 1), a1 + hstep, voffA);
            PG8_WAIT_L(8); PG8_BAR; PG8_WAIT_L(0); PG8_MMA(0, 0, At, B0); PG8_BAR; PG8_SCHED;
            PG8_LDB(B1, 0, 1); PG8_STAGE(PG8_SB(0, 0), b2, voffB);
            PG8_BAR; PG8_WAIT_L(0); PG8_MMA(0, 1, At, B1); PG8_BAR;
            PG8_LDA(At, 0, 1); PG8_STAGE(PG8_SA(0, 0), a2, voffA);
            PG8_BAR; PG8_WAIT_L(0); PG8_MMA(1, 0, At, B0); PG8_BAR; PG8_SCHED;
            PG8_STAGE(PG8_SB(0, 1), b2 + hstep, voffB);
            PG8_WAIT_V(6); PG8_BAR; PG8_MMA(1, 1, At, B1); PG8_BAR;
            PG8_LDB(B0, 1, 0); PG8_SCHED; PG8_LDA(At, 1, 0); PG8_STAGE(PG8_SA(0, 1), a2 + hstep, voffA);
            PG8_WAIT_L(8); PG8_BAR; PG8_WAIT_L(0); PG8_MMA(0, 0, At, B0); PG8_BAR; PG8_SCHED;
            PG8_LDB(B1, 1, 1); PG8_STAGE(PG8_SB(1, 0), b3, voffB);
            PG8_BAR; PG8_WAIT_L(0); PG8_MMA(0, 1, At, B1); PG8_BAR;
            PG8_LDA(At, 1, 1); PG8_STAGE(PG8_SA(1, 0), a3, voffA);
            PG8_BAR; PG8_WAIT_L(0); PG8_MMA(1, 0, At, B0); PG8_BAR; PG8_SCHED;
            PG8_STAGE(PG8_SB(1, 1), b3 + hstep, voffB);
            PG8_WAIT_V(6); PG8_BAR; PG8_MMA(1, 1, At, B1); PG8_BAR;
            }
        }
        if constexpr (ALIGN_EPI) { if (wr == 0) PG8_BAR; }
        bool keep_acc = false;
        if constexpr (Epi::PAIRED) { if (cur.seg == 0) { E.mid(acc, cur, wr, wc, fr, fq); keep_acc = true; } else E(acc, cur, wr, wc, fr, fq); S.done(cur); }
        else if constexpr (!Epi::AFTER_DRAIN) { E(acc, cur, wr, wc, fr, fq); S.done(cur); }
        if (!has_next) break;
        if (!keep_acc)
#pragma unroll
        for (int a = 0; a < 2; ++a)
#pragma unroll
            for (int b = 0; b < 2; ++b)
#pragma unroll
                for (int m = 0; m < 4; ++m)
#pragma unroll
                    for (int n = 0; n < 2; ++n) acc[a][b][m][n] = (f32x4){0.f, 0.f, 0.f, 0.f};
        cur = nxt; cA = nA; cB = nB; ++ui;
        if constexpr (ALIGN_EPI) { if (wr == 1) PG8_BAR; }
    }
    PG8_WAIT_V(0);
    if constexpr (!ALIGN_EPI) { if (wr == 0) PG8_BAR; }
    PG8_BAR;
    if constexpr (Epi::AFTER_DRAIN) { E.fused(acc, cur, wr, wc, fr, fq, lds, wid, lane); S.done(cur); }
#undef PG8_ABASE
#undef PG8_BBASE
#undef PG8_SA
#undef PG8_SB
#undef PG8_STAGE
#undef PG8_LDA
#undef PG8_LDB
#undef PG8_MMA
#undef PG8_WAIT_V
#undef PG8_WAIT_L
#undef PG8_BAR
#undef PG8_SCHED
}
}
#include <hip/hip_bf16.h>
#include <cmath>
namespace attn2 {
using bf16=__hip_bfloat16;
using bf16x8=__attribute__((ext_vector_type(8)))short;
using s16x4=__attribute__((ext_vector_type(4)))short;
using f32x16=__attribute__((ext_vector_type(16)))float;
using u32x4=__attribute__((ext_vector_type(4)))unsigned;
constexpr int SEQ=8192,DM=1024;
constexpr int NW=8,QBLK=32,QB=QBLK*NW,KVBLK=64;
__device__ __forceinline__ int crow(int r,int hi){return (r&3)+8*(r>>2)+4*hi;}
#define SBAR() __builtin_amdgcn_sched_barrier(0)
constexpr int NSLOT=3, SLOTB=8192;
constexpr int LDS_K=0, LDS_V=NSLOT*SLOTB, LDS_WS=LDS_V+2*NSLOT*SLOTB, LDS_OST=LDS_WS+NW*64*4, LDS_BYTES=LDS_OST+NW*4096;
__device__ __forceinline__ void glds16(const void*gsrc,unsigned lds_dst){unsigned keep;
  asm volatile("s_mov_b32 %0, m0\n\ts_mov_b32 m0, %2\n\ts_nop 0\n\tglobal_load_lds_dwordx4 %1, off\n\ts_mov_b32 m0, %0":"=&s"(keep):"v"(gsrc),"s"(lds_dst):"memory");}
typedef float f32x2_t __attribute__((ext_vector_type(2))); typedef __bf16 bf16x2_t __attribute__((ext_vector_type(2)));
__device__ __forceinline__ unsigned cvtpk_s(float lo,float hi){f32x2_t v={lo,hi};bf16x2_t b=__builtin_convertvector(v,bf16x2_t);return __builtin_bit_cast(unsigned,b);}
#define WAIT_BAR(N) asm volatile("s_waitcnt vmcnt(" #N ") lgkmcnt(0)\n\ts_barrier":::"memory")
typedef __attribute__((address_space(3))) const char* lds_cptr;
typedef short v4i16_t __attribute__((ext_vector_type(4)));
__device__ __forceinline__ void qkt0(f32x16&p0,f32x16&p1,const char*Kslot,const bf16x8*qr,int r32,int hi){
  const char*kb=Kslot+hi*1024+r32*16; const f32x16 z=f32x16{};
  #pragma unroll
  for(int d0=0;d0<4;++d0){
    const bf16x8 b0=*reinterpret_cast<const bf16x8*>(kb+d0*2048);
    const bf16x8 b1=*reinterpret_cast<const bf16x8*>(kb+d0*2048+512);
    if(d0==0){p0=__builtin_amdgcn_mfma_f32_32x32x16_bf16(b0,qr[0],z,0,0,0);p1=__builtin_amdgcn_mfma_f32_32x32x16_bf16(b1,qr[0],z,0,0,0);}
    else{p0=__builtin_amdgcn_mfma_f32_32x32x16_bf16(b0,qr[d0],p0,0,0,0);p1=__builtin_amdgcn_mfma_f32_32x32x16_bf16(b1,qr[d0],p1,0,0,0);}}
}
__device__ __forceinline__ void kload8(bf16x8*kf,lds_cptr kp){
  kf[0]=*(const __attribute__((address_space(3))) bf16x8*)(kp);      kf[1]=*(const __attribute__((address_space(3))) bf16x8*)(kp+512);
  kf[2]=*(const __attribute__((address_space(3))) bf16x8*)(kp+2048); kf[3]=*(const __attribute__((address_space(3))) bf16x8*)(kp+2560);
  kf[4]=*(const __attribute__((address_space(3))) bf16x8*)(kp+4096); kf[5]=*(const __attribute__((address_space(3))) bf16x8*)(kp+4608);
  kf[6]=*(const __attribute__((address_space(3))) bf16x8*)(kp+6144); kf[7]=*(const __attribute__((address_space(3))) bf16x8*)(kp+6656);
}
__device__ __forceinline__ void kload2(bf16x8*kf,lds_cptr kp,int j){ kf[2*j]=*(const __attribute__((address_space(3))) bf16x8*)(kp+j*2048); kf[2*j+1]=*(const __attribute__((address_space(3))) bf16x8*)(kp+j*2048+512); }
__device__ __forceinline__ s16x4 vtr(lds_cptr p){ return __builtin_bit_cast(s16x4,__builtin_amdgcn_ds_read_tr16_b64_v4i16((__attribute__((address_space(3))) v4i16_t*)p)); }
__device__ __forceinline__ void pv4(f32x16*o,int vb,bf16x8 pa0,bf16x8 pa1,bf16x8 pa2,bf16x8 pa3){
  #pragma unroll
  for(int d0=0;d0<4;++d0){s16x4 lo[4],hi[4];
    #pragma unroll
    for(int ks=0;ks<4;++ks){
      asm volatile("ds_read_b64_tr_b16 %0,%1 offset:%c2":"=&v"(lo[ks]):"v"(vb),"i"(d0*4096+ks*1024):"memory");
      asm volatile("ds_read_b64_tr_b16 %0,%1 offset:%c2":"=&v"(hi[ks]):"v"(vb),"i"(d0*4096+ks*1024+512):"memory");}
    asm volatile("s_waitcnt lgkmcnt(0)":::"memory");SBAR();
    #define PK(k) (bf16x8){lo[k][0],lo[k][1],lo[k][2],lo[k][3],hi[k][0],hi[k][1],hi[k][2],hi[k][3]}
    o[d0]=__builtin_amdgcn_mfma_f32_32x32x16_bf16(pa0,PK(0),o[d0],0,0,0);
    o[d0]=__builtin_amdgcn_mfma_f32_32x32x16_bf16(pa1,PK(1),o[d0],0,0,0);
    o[d0]=__builtin_amdgcn_mfma_f32_32x32x16_bf16(pa2,PK(2),o[d0],0,0,0);
    o[d0]=__builtin_amdgcn_mfma_f32_32x32x16_bf16(pa3,PK(3),o[d0],0,0,0);
    #undef PK
  }
}
#ifndef ATTN_STORE16
#define ATTN_STORE16(p,v) (*(u32x4*)(p)=(v))
#endif
template<bool SHIFT,int OP> __device__ __forceinline__ void attn_unit(int b,int qcol,int vcol,int ocol,int qb,float mshift,int mode,float lam,const float*subg,float gmul,float*o2s,float*kout,float*vout,const bf16*Q,const bf16*__restrict__ K,const bf16*__restrict__ V,bf16*O,char*shm){
  int tid_=threadIdx.x; asm volatile("":"+v"(tid_)); const int tid=tid_,lane=tid&63,r32=lane&31,hi=lane>>5; const int wid=__builtin_amdgcn_readfirstlane(tid>>6);
  const long rowbase=(long)b*SEQ; const int q0=qb*QB;
  const bf16*Qw=Q+(rowbase+q0+wid*QBLK)*DM+qcol;
  const bf16*Kh=K+rowbase*DM+qcol,*Vh=V+rowbase*DM+vcol;
  const unsigned lds0=(unsigned)(uintptr_t)shm;
  float*wsf=(float*)(shm+LDS_WS)+wid*64;
  const bf16*ksrc=Kh+(long)lane*DM+wid*8;
  const bf16*vsrc=Vh+(long)(16*(wid&3)+(lane>>2))*DM+(wid>>2)*32+(lane&3)*8;
  const unsigned kdst=lds0+LDS_K+wid*1024, vdst=lds0+LDS_V+wid*1024;
  #define DMA_K(t,slot) glds16(ksrc+(long)(t)*KVBLK*DM,(unsigned)__builtin_amdgcn_readfirstlane(kdst+(slot)))
  #define DMA_V(t,slot) do{ glds16(vsrc+(long)(t)*KVBLK*DM,(unsigned)__builtin_amdgcn_readfirstlane(vdst+2*(slot))); glds16(vsrc+(long)(t)*KVBLK*DM+64,(unsigned)__builtin_amdgcn_readfirstlane(vdst+2*(slot)+8192)); }while(0)
  const int vb0=(int)(lds0+LDS_V)+((lane>>4)&1)*32+(lane&3)*8+(4*hi+((lane&15)>>2))*64;
  const char*Kbase=shm+LDS_K; bf16x8 kf[8];
  const lds_cptr shm3=(lds_cptr)shm; const lds_cptr kp0=shm3+LDS_K+hi*1024+r32*16; const lds_cptr vp0=shm3+LDS_V+((lane>>4)&1)*32+(lane&3)*8+(4*hi+((lane&15)>>2))*64;
  const int NT=(q0+QB)/KVBLK;
  DMA_K(0,0);DMA_V(0,0);DMA_K(1,SLOTB);
  bf16x8 qr[4];
  #pragma unroll
  for(int d0=0;d0<4;++d0)qr[d0]=*reinterpret_cast<const bf16x8*>(&Qw[(long)r32*DM+d0*16+hi*8]);
  float l_reg=0.f;f32x16 o[4];o[0]=f32x16{};o[1]=f32x16{};o[2]=f32x16{};o[3]=f32x16{};
  const int chunkw=wid>>1;
  #define CMASK_BAND(P0,P1,t) do{int jb_=(t)-(NT-4); if(jb_>chunkw){ asm volatile("":::"memory"); _Pragma("unroll") for(int r=0;r<16;++r){P0[r]=-INFINITY;P1[r]=-INFINITY;} } }while(0)
  #define CMASK(P0,P1,t) CMASK_BAND(P0,P1,t)
  #define EX(v) __builtin_amdgcn_exp2f(v)
  #define EXS(v) (SHIFT?EX((v)-mshift):EX(v))
  f32x16 pA0,pA1,pB0,pB1;
  int sl_prev=0,sl_cur=0,sl_next=SLOTB;
  #define ROT() do{sl_prev=sl_cur;sl_cur=sl_next;sl_next=(sl_next==(NSLOT-1)*SLOTB)?0:sl_next+SLOTB;}while(0)
  DMA_K(2,2*SLOTB);
  WAIT_BAR(4);
  qkt0(pA0,pA1,Kbase,qr,r32,hi);CMASK(pA0,pA1,0);
  _Pragma("unroll") for(int r=0;r<16;++r){pA0[r]=EXS(pA0[r]);pA1[r]=EXS(pA1[r]);}
  WAIT_BAR(0);
  DMA_K(3,0);DMA_V(1,SLOTB);
  ROT();
  kload8(kf,kp0+sl_cur);
  WAIT_BAR(3);
  s16x4 vlo[8],vhi[8]; u32x4 pw0,pw1,pw2,pw3;
  #define PKW(P,B) cvtpk_s(P[B],P[B+1])
  #define PAF(k) __builtin_bit_cast(bf16x8,pw##k)
  #define VFR(i) (bf16x8){vlo[i][0],vlo[i][1],vlo[i][2],vlo[i][3],vhi[i][0],vhi[i][1],vhi[i][2],vhi[i][3]}
  #define PIN(x) asm volatile("":"+v"(x))
  #define GAPA(MF,A0,A1,A2,A3,W0,W1,PW) do{ MF; sacc+=A0; sacc+=A1; sacc+=A2; sacc+=A3; PIN(sacc); W0; W1; PIN(PW); SBAR(); }while(0)
  #define GAPB(MF,X,B) do{ MF; X[B]=EXS(X[B]); X[B+1]=EXS(X[B+1]); PIN(X); SBAR(); }while(0)
  #define VRD(i,db) do{ vlo[i]=vtr(vp_+((db)*4096+((i)&3)*1024)); vhi[i]=vtr(vp_+((db)*4096+((i)&3)*1024+512)); }while(0)
  #define KRD(G,j) do{ if(G){ kload2(kf,kp0+sl_next,j); SBAR(); } }while(0)
  #define STEP(C0,C1,P0,P1,t,GK,GV,GL) do{ SBAR(); \
    const lds_cptr vp_=vp0+2*sl_prev; const f32x16 z_=f32x16{}; \
    VRD(0,0); SBAR(); float sacc=(P0[0]+P0[1]); \
    GAPA(C0=__builtin_amdgcn_mfma_f32_32x32x16_bf16(kf[0],qr[0],z_,0,0,0), P0[2],P0[3],P0[4],P0[5],     pw0[0]=PKW(P0,0), pw0[1]=PKW(P0,2), pw0); \
    VRD(4,1); SBAR(); GAPA(C1=__builtin_amdgcn_mfma_f32_32x32x16_bf16(kf[1],qr[0],z_,0,0,0), P0[6],P0[7],P0[8],P0[9],     pw0[2]=PKW(P0,4), pw0[3]=PKW(P0,6), pw0); \
    VRD(1,0); SBAR(); GAPA(C0=__builtin_amdgcn_mfma_f32_32x32x16_bf16(kf[2],qr[1],C0,0,0,0),   P0[10],P0[11],P0[12],P0[13], pw1[0]=PKW(P0,8), pw1[1]=PKW(P0,10), pw1); \
    VRD(5,1); SBAR(); GAPA(C1=__builtin_amdgcn_mfma_f32_32x32x16_bf16(kf[3],qr[1],C1,0,0,0),   P0[14],P0[15],P1[0],P1[1],   pw1[2]=PKW(P0,12),pw1[3]=PKW(P0,14), pw1); \
    VRD(2,0); SBAR(); GAPA(C0=__builtin_amdgcn_mfma_f32_32x32x16_bf16(kf[4],qr[2],C0,0,0,0),   P1[2],P1[3],P1[4],P1[5],     pw2[0]=PKW(P1,0), pw2[1]=PKW(P1,2), pw2); \
    VRD(6,1); SBAR(); GAPA(C1=__builtin_amdgcn_mfma_f32_32x32x16_bf16(kf[5],qr[2],C1,0,0,0),   P1[6],P1[7],P1[8],P1[9],     pw2[2]=PKW(P1,4), pw2[3]=PKW(P1,6), pw2); \
    VRD(3,0); SBAR(); GAPA(C0=__builtin_amdgcn_mfma_f32_32x32x16_bf16(kf[6],qr[3],C0,0,0,0),   P1[10],P1[11],P1[12],P1[13], pw3[0]=PKW(P1,8), pw3[1]=PKW(P1,10), pw3); \
    VRD(7,1); SBAR(); GAPA(C1=__builtin_amdgcn_mfma_f32_32x32x16_bf16(kf[7],qr[3],C1,0,0,0),   P1[14],P1[15],0.f,0.f,       pw3[2]=PKW(P1,12),pw3[3]=PKW(P1,14), pw3); \
    l_reg+=sacc; \
    if(GK){DMA_K((t)+3,sl_cur);} if(GV){DMA_V((t)+1,sl_next);} \
    CMASK(C0,C1,t); \
    SBAR(); \
    GAPB(o[0]=__builtin_amdgcn_mfma_f32_32x32x16_bf16(PAF(0),VFR(0),o[0],0,0,0), C0,0);  VRD(0,2); SBAR(); \
    GAPB(o[1]=__builtin_amdgcn_mfma_f32_32x32x16_bf16(PAF(0),VFR(4),o[1],0,0,0), C0,2);  VRD(4,3); SBAR(); \
    KRD(GL,0); GAPB(o[0]=__builtin_amdgcn_mfma_f32_32x32x16_bf16(PAF(1),VFR(1),o[0],0,0,0), C0,4);  VRD(1,2); SBAR(); \
    KRD(GL,1); GAPB(o[1]=__builtin_amdgcn_mfma_f32_32x32x16_bf16(PAF(1),VFR(5),o[1],0,0,0), C0,6);  VRD(5,3); SBAR(); \
    KRD(GL,2); GAPB(o[0]=__builtin_amdgcn_mfma_f32_32x32x16_bf16(PAF(2),VFR(2),o[0],0,0,0), C0,8);  VRD(2,2); SBAR(); \
    KRD(GL,3); GAPB(o[1]=__builtin_amdgcn_mfma_f32_32x32x16_bf16(PAF(2),VFR(6),o[1],0,0,0), C0,10); VRD(6,3); SBAR(); \
    GAPB(o[0]=__builtin_amdgcn_mfma_f32_32x32x16_bf16(PAF(3),VFR(3),o[0],0,0,0), C0,12); VRD(3,2); SBAR(); \
    GAPB(o[1]=__builtin_amdgcn_mfma_f32_32x32x16_bf16(PAF(3),VFR(7),o[1],0,0,0), C0,14); VRD(7,3); SBAR(); \
    GAPB(o[2]=__builtin_amdgcn_mfma_f32_32x32x16_bf16(PAF(0),VFR(0),o[2],0,0,0), C1,0); \
    GAPB(o[3]=__builtin_amdgcn_mfma_f32_32x32x16_bf16(PAF(0),VFR(4),o[3],0,0,0), C1,2); \
    GAPB(o[2]=__builtin_amdgcn_mfma_f32_32x32x16_bf16(PAF(1),VFR(1),o[2],0,0,0), C1,4); \
    GAPB(o[3]=__builtin_amdgcn_mfma_f32_32x32x16_bf16(PAF(1),VFR(5),o[3],0,0,0), C1,6); \
    GAPB(o[2]=__builtin_amdgcn_mfma_f32_32x32x16_bf16(PAF(2),VFR(2),o[2],0,0,0), C1,8); \
    GAPB(o[3]=__builtin_amdgcn_mfma_f32_32x32x16_bf16(PAF(2),VFR(6),o[3],0,0,0), C1,10); \
    GAPB(o[2]=__builtin_amdgcn_mfma_f32_32x32x16_bf16(PAF(3),VFR(3),o[2],0,0,0), C1,12); \
    GAPB(o[3]=__builtin_amdgcn_mfma_f32_32x32x16_bf16(PAF(3),VFR(7),o[3],0,0,0), C1,14); \
    }while(0)
  if(wid>=4)__builtin_amdgcn_s_setprio(1);
  int t=1;
  #undef CMASK
  #define CMASK(P0,P1,t) do{}while(0)
  for(;t+5<NT;t+=2){
    STEP(pB0,pB1,pA0,pA1,t,true,true,true);     WAIT_BAR(3); ROT();
    STEP(pA0,pA1,pB0,pB1,t+1,true,true,true);   WAIT_BAR(3); ROT();
  }
  #undef CMASK
  #define CMASK(P0,P1,t) CMASK_BAND(P0,P1,t)
  #define ENDW(tt) do{ if((tt)+3<NT){WAIT_BAR(3);} else if((tt)+2<NT){WAIT_BAR(2);} else {WAIT_BAR(0);} }while(0)
  for(;t+1<NT;t+=2){
    STEP(pB0,pB1,pA0,pA1,t,(t+3<NT),(t+1<NT),(t+1<NT));       ENDW(t);   ROT();
    STEP(pA0,pA1,pB0,pB1,t+1,(t+4<NT),(t+2<NT),(t+2<NT));     ENDW(t+1); ROT();
  }
  STEP(pB0,pB1,pA0,pA1,NT-1,false,false,false);
  { float sacc=pB0[0]+pB0[1]; _Pragma("unroll") for(int r=2;r<16;++r)sacc+=pB0[r]; _Pragma("unroll") for(int r=0;r<16;++r)sacc+=pB1[r]; l_reg+=sacc;
    pw0=(u32x4){PKW(pB0,0),PKW(pB0,2),PKW(pB0,4),PKW(pB0,6)};pw1=(u32x4){PKW(pB0,8),PKW(pB0,10),PKW(pB0,12),PKW(pB0,14)};pw2=(u32x4){PKW(pB1,0),PKW(pB1,2),PKW(pB1,4),PKW(pB1,6)};pw3=(u32x4){PKW(pB1,8),PKW(pB1,10),PKW(pB1,12),PKW(pB1,14)};
    SBAR(); pv4(o,vb0+2*sl_cur,PAF(0),PAF(1),PAF(2),PAF(3)); }
  #undef PKW
  #undef PAF
  #undef VFR
  #undef PIN
  #undef GAPA
  #undef GAPB
  #undef EX
  #undef EXS
  #undef VRD
  #undef KRD
  #undef STEP
  #undef ENDW
  __builtin_amdgcn_s_setprio(0);
  {auto rr=__builtin_amdgcn_permlane32_swap(__float_as_uint(l_reg),__float_as_uint(l_reg),false,false);l_reg=__uint_as_float(rr[0])+__uint_as_float(rr[1]);}
  if(hi==0)wsf[32+r32]=l_reg;asm volatile("s_waitcnt lgkmcnt(0)":::"memory");
  { float rli[16];
  #pragma unroll
  for(int r=0;r<16;++r)rli[r]=__builtin_amdgcn_rcpf(wsf[32+crow(r,hi)]);
  #pragma unroll
  for(int d0=0;d0<4;++d0)
    #pragma unroll
    for(int r=0;r<16;++r)o[d0][r]*=rli[r]; }
  typedef float f32x4o __attribute__((ext_vector_type(4)));
  f32x4o*o2w=(f32x4o*)(o2s+(size_t)wid*4096)+lane;
  if(mode==0){
    #pragma unroll
    for(int d0=0;d0<4;++d0)
      #pragma unroll
      for(int j=0;j<4;++j)o2w[(d0*4+j)*64]=(f32x4o){o[d0][4*j],o[d0][4*j+1],o[d0][4*j+2],o[d0][4*j+3]};
  } else {
    #pragma unroll
    for(int d0=0;d0<4;++d0)
      #pragma unroll
      for(int j=0;j<4;++j){ const f32x4o t=o2w[(d0*4+j)*64]; o[d0][4*j]-=lam*t.x; o[d0][4*j+1]-=lam*t.y; o[d0][4*j+2]-=lam*t.z; o[d0][4*j+3]-=lam*t.w; }
    float sg[4];
    #pragma unroll
    for(int d0=0;d0<4;++d0)sg[d0]=subg[32*d0+r32]*gmul;
    #pragma unroll
    for(int r=0;r<16;++r){ float ss=(o[0][r]*o[0][r]+o[1][r]*o[1][r])+(o[2][r]*o[2][r]+o[3][r]*o[3][r]);
      ss+=__shfl_xor(ss,1);ss+=__shfl_xor(ss,2);ss+=__shfl_xor(ss,4);ss+=__shfl_xor(ss,8);ss+=__shfl_xor(ss,16);
      const float rs=__builtin_amdgcn_rsqf(ss*(1.0f/128.0f)+1e-6f);
      #pragma unroll
      for(int d0=0;d0<4;++d0)o[d0][r]*=rs*sg[d0]; }
    bf16*Ow=O+(rowbase+q0+wid*QBLK)*OP+ocol;
    bf16*stg=(bf16*)(shm+LDS_OST)+wid*2048;
    #pragma unroll
    for(int ps=0;ps<2;++ps){
      #pragma unroll
      for(int r=0;r<16;++r){const int orow=crow(r,hi);
        #pragma unroll
        for(int d0=0;d0<2;++d0)stg[orow*64+d0*32+r32]=__float2bfloat16(o[2*ps+d0][r]);}
      asm volatile("s_waitcnt lgkmcnt(0)":::"memory");
      #pragma unroll
      for(int i=0;i<4;++i){const int row=i*8+(lane>>3),ch=lane&7; const u32x4 v=*(const u32x4*)(stg+row*64+ch*8); ATTN_STORE16(Ow+(long)row*OP+ps*64+ch*8,v);}
      asm volatile("s_waitcnt lgkmcnt(0)":::"memory"); } }
  { typedef float f32x4a __attribute__((ext_vector_type(4)));
    #pragma unroll
    for(int i=0;i<4;++i){ const int gI=tid+512*i,row=gI>>3,c8=gI&7; const u32x4 w=*(const u32x4*)(Kh+(long)(q0+row)*DM+c8*8); float*dst=kout+(rowbase+q0+row)*DM+qcol+c8*8;
      *(f32x4a*)dst=(f32x4a){__uint_as_float(w.x<<16),__uint_as_float(w.x&0xffff0000u),__uint_as_float(w.y<<16),__uint_as_float(w.y&0xffff0000u)};
      *(f32x4a*)(dst+4)=(f32x4a){__uint_as_float(w.z<<16),__uint_as_float(w.z&0xffff0000u),__uint_as_float(w.w<<16),__uint_as_float(w.w&0xffff0000u)}; }
    if(mode==1){
      #pragma unroll
      for(int i=0;i<8;++i){ const int gI=tid+512*i,row=gI>>4,c8=gI&15; const u32x4 w=*(const u32x4*)(Vh+(long)(q0+row)*DM+c8*8); float*dst=vout+(rowbase+q0+row)*DM+vcol+c8*8;
        *(f32x4a*)dst=(f32x4a){__uint_as_float(w.x<<16),__uint_as_float(w.x&0xffff0000u),__uint_as_float(w.y<<16),__uint_as_float(w.y&0xffff0000u)};
        *(f32x4a*)(dst+4)=(f32x4a){__uint_as_float(w.z<<16),__uint_as_float(w.z&0xffff0000u),__uint_as_float(w.w<<16),__uint_as_float(w.w&0xffff0000u)}; } } }
  asm volatile("s_waitcnt lgkmcnt(0)\n\ts_barrier":::"memory");
  #undef DMA_K
  #undef DMA_V
  #undef CMASK
  #undef CMASK_BAND
  #undef ROT
}
#undef SBAR
#undef WAIT_BAR
}
#include <hip/hip_cooperative_groups.h>
namespace cg = cooperative_groups;
constexpr int NWAVES = 8;
constexpr int MP = pg8::MP, MS = pg8::MS, MT = pg8::MT, D = 1024, TP = 8192, TS = 32, PAST = 1024, NIN = 8192, FF = 2816, NGU = 2 * FF;
constexpr float LAM0 = 0.2f;
constexpr size_t MiB = 1u << 20;
constexpr size_t ROWB = (size_t)MT * D * 2;
constexpr size_t WS_MOD = 0;
constexpr size_t WS_WIN = 1 * MiB, WS_WAO = 17 * MiB, WS_WCO = 19 * MiB, WS_WOUT = 21 * MiB, WS_WGU = 23 * MiB, WS_WDN = 34 * MiB;
constexpr size_t WS_XN = 40 * MiB;
constexpr size_t WS_O12 = 40 * MiB;
constexpr size_t WS_T = WS_O12;
constexpr size_t WS_Q = WS_O12 + 2 * ROWB, WS_K = WS_Q + ROWB, WS_V = WS_K + ROWB, WS_U = WS_V + ROWB, WS_GB = WS_U + ROWB, WS_END = WS_GB + ROWB;
constexpr size_t WS_ON = WS_Q;
constexpr size_t WS_MX = WS_K;
constexpr size_t WS_X1B = WS_U;
constexpr size_t WS_XN2 = WS_V;
constexpr size_t WS_ACT = 40 * MiB;
static_assert(WS_ACT + (size_t)MT * FF * 2 <= WS_MX && WS_END <= 1024 * MiB, "d_ws map");
constexpr int LDS_BYTES = 147456;
constexpr size_t WS_BAR = 512 * 1024;
constexpr int XBAR_LDS_OFF = 147456 - 64;

#define GAS __attribute__((address_space(1)))
#define LAS __attribute__((address_space(3)))
typedef unsigned short bf16;
typedef unsigned v4u __attribute__((ext_vector_type(4)));
typedef unsigned v2u __attribute__((ext_vector_type(2)));
typedef float f32x4 __attribute__((ext_vector_type(4)));
#define LDS_WAIT() asm volatile("s_waitcnt lgkmcnt(0)" ::: "memory")
__device__ __forceinline__ unsigned f2bf(float f) { unsigned u = __builtin_bit_cast(unsigned, f); return (u + 0x7fffu + ((u >> 16) & 1u)) >> 16; }
__device__ __forceinline__ unsigned pk2(float lo, float hi) { return f2bf(lo) | (f2bf(hi) << 16); }
__device__ __forceinline__ float bflo(unsigned w) { return __uint_as_float(w << 16); }
__device__ __forceinline__ float bfhi(unsigned w) { return __uint_as_float(w & 0xffff0000u); }
__device__ __forceinline__ float bf1(bf16 b) { return __uint_as_float((unsigned)b << 16); }
__device__ __forceinline__ float wave_sum(float v) {
#pragma unroll
    for (int o = 1; o < 64; o <<= 1) v += __shfl_xor(v, o);
    return v;
}
__device__ __forceinline__ float wave_max(float v) {
#pragma unroll
    for (int o = 1; o < 64; o <<= 1) v = fmaxf(v, __shfl_xor(v, o));
    return v;
}

__device__ __forceinline__ void ld16(const bf16* p, float (&d)[16]) { const v4u* q = (const v4u*)p;
#pragma unroll
    for (int e = 0; e < 2; ++e) { const v4u a = q[e]; d[8 * e + 0] = bflo(a.x); d[8 * e + 1] = bfhi(a.x); d[8 * e + 2] = bflo(a.y); d[8 * e + 3] = bfhi(a.y); d[8 * e + 4] = bflo(a.z); d[8 * e + 5] = bfhi(a.z); d[8 * e + 6] = bflo(a.w); d[8 * e + 7] = bfhi(a.w); } }
__device__ __forceinline__ void ldf(const float* p, float (&d)[16]) { const f32x4* q = (const f32x4*)p;
#pragma unroll
    for (int e = 0; e < 4; ++e) { const f32x4 a = q[e]; d[4 * e] = a.x; d[4 * e + 1] = a.y; d[4 * e + 2] = a.z; d[4 * e + 3] = a.w; } }
struct Args {
    const float *x_prompt, *x_sample, *cache_k, *cache_v, *state_conv, *c_prompt, *c_sample, *w_ada, *b_ada, *norm1_g, *norm2_g, *w_in, *q_norm_g, *k_norm_g,
        *lq1, *lk1, *lq2, *lk2, *sub_g, *w_ao, *conv_w, *w_co, *w_out, *w_gu, *w_dn;
    float* out; unsigned char* ws;
};

__device__ __forceinline__ void transpose_item(const float* W, int K, int N, bf16* WT, int kb, int n0, int drow, LAS float* scr, int lane) {
    const int k0 = 64 * kb;
#pragma unroll 8
    for (int i = 0; i < 32; ++i) { const int kk = 2 * i + (lane >> 5); scr[kk * 33 + (lane & 31)] = W[(size_t)(k0 + kk) * N + n0 + (lane & 31)]; }
    LDS_WAIT(); asm volatile("" ::: "memory");
    const int c = lane & 7;
#pragma unroll
    for (int j = 0; j < 4; ++j) { const int n = (lane >> 3) + 8 * j; const LAS float* s = scr + (8 * c) * 33 + n;
        v4u o; o.x = pk2(s[0 * 33], s[1 * 33]); o.y = pk2(s[2 * 33], s[3 * 33]); o.z = pk2(s[4 * 33], s[5 * 33]); o.w = pk2(s[6 * 33], s[7 * 33]);
        *(GAS v4u*)(WT + (size_t)(drow + n) * K + k0 + 8 * c) = o; }
    LDS_WAIT(); asm volatile("" ::: "memory");
}
__device__ __forceinline__ int win_drow(int c0) {
    const int sect = c0 >> 10, cc = c0 & 1023;
    if (sect == 3) return 256 * (12 + (cc >> 7)) + (cc & 127);
    if (sect == 5) return 256 * (12 + (cc >> 7)) + 128 + (cc & 127);
    const int tile = (sect < 3 ? sect * 4 : sect == 4 ? 20 : sect == 6 ? 24 : 28) + (cc >> 8), sl = cc & 255;
    return 256 * tile + 128 * ((sl >> 5) & 1) + 32 * (sl >> 6);
}
__device__ __forceinline__ int wgu_drow(int c0) { const int ch = c0 < FF ? c0 : c0 - FF; return 256 * (ch >> 7) + (c0 < FF ? 0 : 128) + (ch & 127); }

__device__ __forceinline__ void norm_row(const float* xrow, const float* g, const float* shift, const float* scale, bf16* orow, int lane) {
    const GAS f32x4* xr = (const GAS f32x4*)xrow + lane;
    f32x4 v[4]; float s = 0.f;
#pragma unroll
    for (int j = 0; j < 4; ++j) { v[j] = xr[64 * j]; s += (v[j].x * v[j].x + v[j].y * v[j].y) + (v[j].z * v[j].z + v[j].w * v[j].w); }
    const float rstd = __builtin_amdgcn_rsqf(wave_sum(s) * (1.f / D) + pg8::RMS_EPS);
    GAS unsigned long long* o8 = (GAS unsigned long long*)orow + lane;
#pragma unroll
    for (int j = 0; j < 4; ++j) { const int c = 4 * (lane + 64 * j); const f32x4 gg = *(const f32x4*)(g + c), sh = *(const f32x4*)(shift + c), sc = *(const f32x4*)(scale + c);
        const f32x4 o = v[j] * rstd * gg * (sc + 1.0f) + sh;
        o8[64 * j] = (unsigned long long)pk2(o.x, o.y) | ((unsigned long long)pk2(o.z, o.w) << 32); }
}

__device__ __forceinline__ void norm_row_bf(const bf16* xrow, const float* g, const float* shift, const float* scale, bf16* orow, int lane) {
    float v[16]; float s = 0.f;
#pragma unroll
    for (int j = 0; j < 2; ++j) { const v4u w = *(const v4u*)(xrow + 512 * j + 8 * lane);
        v[8 * j + 0] = bflo(w.x); v[8 * j + 1] = bfhi(w.x); v[8 * j + 2] = bflo(w.y); v[8 * j + 3] = bfhi(w.y); v[8 * j + 4] = bflo(w.z); v[8 * j + 5] = bfhi(w.z); v[8 * j + 6] = bflo(w.w); v[8 * j + 7] = bfhi(w.w); }
#pragma unroll
    for (int i = 0; i < 16; ++i) s += v[i] * v[i];
    const float rstd = __builtin_amdgcn_rsqf(wave_sum(s) * (1.f / D) + pg8::RMS_EPS);
#pragma unroll
    for (int j = 0; j < 2; ++j) { const int c = 512 * j + 8 * lane; float o[8];
#pragma unroll
        for (int h = 0; h < 2; ++h) { const f32x4 gg = *(const f32x4*)(g + c + 4 * h), sh = *(const f32x4*)(shift + c + 4 * h), sc = *(const f32x4*)(scale + c + 4 * h);
            o[4 * h + 0] = v[8 * j + 4 * h + 0] * rstd * gg.x * (sc.x + 1.0f) + sh.x; o[4 * h + 1] = v[8 * j + 4 * h + 1] * rstd * gg.y * (sc.y + 1.0f) + sh.y;
            o[4 * h + 2] = v[8 * j + 4 * h + 2] * rstd * gg.z * (sc.z + 1.0f) + sh.z; o[4 * h + 3] = v[8 * j + 4 * h + 3] * rstd * gg.w * (sc.w + 1.0f) + sh.w; }
        v4u w; w.x = pk2(o[0], o[1]); w.y = pk2(o[2], o[3]); w.z = pk2(o[4], o[5]); w.w = pk2(o[6], o[7]); *(v4u*)(orow + c) = w; }
}
typedef short sbf16x8 __attribute__((ext_vector_type(8)));
typedef float sf32x16 __attribute__((ext_vector_type(16)));
__device__ __forceinline__ unsigned cvtpk2(float lo, float hi) { unsigned r; asm("v_cvt_pk_bf16_f32 %0, %1, %2" : "=v"(r) : "v"(lo), "v"(hi)); return r; }
__device__ __forceinline__ sbf16x8 pack_f8(f32x4 a, f32x4 b) { v4u w; w.x = cvtpk2(a.x, a.y); w.y = cvtpk2(a.z, a.w); w.z = cvtpk2(b.x, b.y); w.w = cvtpk2(b.z, b.w); return __builtin_bit_cast(sbf16x8, w); }
__device__ __forceinline__ int crow_(int r, int hi) { return (r & 3) + 8 * (r >> 2) + 4 * hi; }
__device__ __forceinline__ void sample_attn_item(const Args& A, LAS unsigned char* lds, int b, int h, int mm, int tid) {
    constexpr int SP = 1060, NK = PAST + TS;
    const bf16* Q = (const bf16*)(A.ws + WS_Q); const bf16* Kb = (const bf16*)(A.ws + WS_K); const bf16* Vb = (const bf16*)(A.ws + WS_V); bf16* O12 = (bf16*)(A.ws + WS_O12);
    LAS float* S = (LAS float*)lds;
    LAS float* linv = (LAS float*)(lds + 32 * SP * 4);
    const int lane = tid & 63, wave = __builtin_amdgcn_readfirstlane(tid >> 6), r32 = lane & 31, hi = lane >> 5;
    sbf16x8 qr[4];
#pragma unroll
    for (int d0 = 0; d0 < 4; ++d0) qr[d0] = *(const sbf16x8*)(Q + (size_t)(MP + b * TS + r32) * D + (h * 2 + mm) * 64 + d0 * 16 + hi * 8);
    for (int kb = wave; kb < NK / 32; kb += 8) {
        sbf16x8 kf[4];
        if (kb < PAST / 32) { const float* kp = A.cache_k + ((size_t)(b * PAST + kb * 32 + r32) * 8 + h) * 128 + mm * 64 + hi * 8;
#pragma unroll
            for (int d0 = 0; d0 < 4; ++d0) kf[d0] = pack_f8(*(const f32x4*)(kp + d0 * 16), *(const f32x4*)(kp + d0 * 16 + 4)); }
        else { const bf16* kp = Kb + (size_t)(MP + b * TS + r32) * D + (h * 2 + mm) * 64 + hi * 8;
#pragma unroll
            for (int d0 = 0; d0 < 4; ++d0) kf[d0] = *(const sbf16x8*)(kp + d0 * 16); }
        sf32x16 acc = sf32x16{};
#pragma unroll
        for (int d0 = 0; d0 < 4; ++d0) acc = __builtin_amdgcn_mfma_f32_32x32x16_bf16(kf[d0], qr[d0], acc, 0, 0, 0);
#pragma unroll
        for (int r = 0; r < 16; ++r) S[r32 * SP + kb * 32 + crow_(r, hi)] = acc[r];
    }
    __syncthreads();
#pragma unroll 1
    for (int ii = 0; ii < 4; ++ii) { const int i = 4 * wave + ii; LAS float* sr = S + i * SP;
        float mx = -INFINITY; for (int j = lane; j < NK; j += 64) mx = fmaxf(mx, sr[j]);
        mx = wave_max(mx); float sum = 0.f;
        for (int j = lane; j < NK; j += 64) { const float p = __builtin_amdgcn_exp2f(sr[j] - mx); sr[j] = p; sum += p; }
        sum = wave_sum(sum); if (lane == 0) linv[i] = 1.0f / sum; }
    __syncthreads();
    const int db = wave & 3, kh = wave >> 2;
    sf32x16 o = sf32x16{};
    for (int k2 = 33 * kh; k2 < 33 * kh + 33; ++k2) {
        const LAS f32x4* pp = (const LAS f32x4*)(S + r32 * SP + k2 * 16 + hi * 8);
        const sbf16x8 pa = pack_f8(pp[0], pp[1]);
        sbf16x8 vf;
        if (k2 < PAST / 16) { const float* vp = A.cache_v + ((size_t)(b * PAST + k2 * 16 + hi * 8) * 8 + h) * 128 + db * 32 + r32;
            f32x4 v0, v1; v0.x = vp[0]; v0.y = vp[1024]; v0.z = vp[2048]; v0.w = vp[3072]; v1.x = vp[4096]; v1.y = vp[5120]; v1.z = vp[6144]; v1.w = vp[7168];
            vf = pack_f8(v0, v1); }
        else { const bf16* vp = Vb + (size_t)(MP + b * TS + (k2 * 16 - PAST) + hi * 8) * D + h * 128 + db * 32 + r32;
            v4u w; w.x = (unsigned)vp[0] | ((unsigned)vp[1024] << 16); w.y = (unsigned)vp[2048] | ((unsigned)vp[3072] << 16); w.z = (unsigned)vp[4096] | ((unsigned)vp[5120] << 16); w.w = (unsigned)vp[6144] | ((unsigned)vp[7168] << 16);
            vf = __builtin_bit_cast(sbf16x8, w); }
        o = __builtin_amdgcn_mfma_f32_32x32x16_bf16(pa, vf, o, 0, 0, 0);
    }
    __syncthreads();
    LAS float* red = (LAS float*)lds;
    if (kh == 1) {
#pragma unroll
        for (int r = 0; r < 16; ++r) red[(db * 16 + r) * 64 + lane] = o[r]; }
    __syncthreads();
    if (kh == 0) {
#pragma unroll
        for (int r = 0; r < 16; ++r) { const int q = crow_(r, hi); const float v = (o[r] + red[(db * 16 + r) * 64 + lane]) * linv[q];
            O12[(size_t)(MP + b * TS + q) * 2048 + mm * 1024 + h * 128 + db * 32 + r32] = (bf16)f2bf(v); } }
    __syncthreads();
}

typedef float sf32x4 __attribute__((ext_vector_type(4)));
template <class F> __device__ __forceinline__ void small_gemm(const bf16* A, const bf16* Bt, int K, int vcu, int G, LAS unsigned char* lds, int tid, const F& f) {
    const int lane = tid & 63, wave = __builtin_amdgcn_readfirstlane(tid >> 6), fr = lane & 15, fq = lane >> 4, cb = wave & 3, kh = wave >> 2, K2 = K >> 1;
    for (int item = vcu; item < 256; item += G) {
        const int r0 = (item >> 4) * 16, c0 = (item & 15) * 64 + cb * 16;
        const bf16* ap = A + (size_t)(r0 + fr) * K + kh * K2 + fq * 8;
        const bf16* bp = Bt + (size_t)(c0 + fr) * K + kh * K2 + fq * 8;
        sf32x4 acc = {0.f, 0.f, 0.f, 0.f};
#pragma unroll 8
        for (int k = 0; k < K2; k += 32) acc = __builtin_amdgcn_mfma_f32_16x16x32_bf16(*(const sbf16x8*)(bp + k), *(const sbf16x8*)(ap + k), acc, 0, 0, 0);
        LAS sf32x4* red = (LAS sf32x4*)lds;
        if (kh == 1) red[cb * 64 + lane] = acc;
        __syncthreads();
        if (kh == 0) { acc += red[cb * 64 + lane]; f(MP + r0 + fr, c0 + 4 * fq, acc); }
        __syncthreads();
    }
}
__device__ __forceinline__ float sigm_(float x) { return __builtin_amdgcn_rcpf(1.0f + __builtin_amdgcn_exp2f(-1.4426950408889634f * x)); }
struct SmallGate0 { const bf16* G; float* T;
    __device__ __forceinline__ void operator()(int row, int col, sf32x4 acc) const { const size_t o = (size_t)row * 1024 + col; const v2u g = *(const v2u*)(G + o);
        sf32x4 s; s.x = sigm_(bflo(g.x)); s.y = sigm_(bfhi(g.x)); s.z = sigm_(bflo(g.y)); s.w = sigm_(bfhi(g.y)); *(sf32x4*)(T + o) = s * acc; } };
struct SmallGate1 { const bf16* G; const float* T; bf16* Mx;
    __device__ __forceinline__ void operator()(int row, int col, sf32x4 acc) const { const size_t o = (size_t)row * 1024 + col; const v2u g = *(const v2u*)(G + o);
        sf32x4 s; s.x = sigm_(bflo(g.x)); s.y = sigm_(bfhi(g.x)); s.z = sigm_(bflo(g.y)); s.w = sigm_(bfhi(g.y)); const sf32x4 v = *(const sf32x4*)(T + o) + s * acc;
        v2u w; w.x = pk2(v.x, v.y); w.y = pk2(v.z, v.w); *(v2u*)(Mx + o) = w; } };
template <bool FINAL> struct SmallRes { const float* xin; bf16* x1b; float* out; const float* gate;
    __device__ __forceinline__ void operator()(int row, int col, sf32x4 acc) const { const size_t o = (size_t)row * 1024 + col; const int mrow = 8 + ((row - MP) >> 5);
        const sf32x4 g = *(const sf32x4*)(gate + (size_t)mrow * 6144 + col);
        if constexpr (!FINAL) { const sf32x4 v = *(const sf32x4*)(xin + o) + g * acc; v2u w; w.x = pk2(v.x, v.y); w.y = pk2(v.z, v.w); *(v2u*)(x1b + o) = w; }
        else { const v2u w = *(const v2u*)(x1b + o); const sf32x4 b = {bflo(w.x), bfhi(w.x), bflo(w.y), bfhi(w.y)}; *(sf32x4*)(out + o) = b + g * acc; } } };

typedef const __attribute__((address_space(4))) Args* kargs_t;
#define XB_TMO      128
#define XB_XCNT(j)  (256  + 64 * (j))
#define XB_XSUB(j)  (1280 + 64 * (j))
#define XB_XGEN(j)  (2304 + 64 * (j))
#define XB_TOP      3328
#define XB_TOPGEN   3392
#define XCD_BAR_WORDS 3456
#define XB_SPIN_CAP (1u << 22)

__device__ __forceinline__ unsigned xb_ld(unsigned* p)              { return __hip_atomic_load(p, __ATOMIC_RELAXED, __HIP_MEMORY_SCOPE_AGENT); }
__device__ __forceinline__ unsigned xb_add(unsigned* p, unsigned v) { return __hip_atomic_fetch_add(p, v, __ATOMIC_RELAXED, __HIP_MEMORY_SCOPE_AGENT); }
__device__ __forceinline__ unsigned xb_xcc_id() { return (unsigned)__builtin_amdgcn_s_getreg((3 << 11) | 20) & 0xFu; }
#define XB_SPIN(cond, bar) do { unsigned _sp = 0; while (cond) { __builtin_amdgcn_s_sleep(1); \
    if ((++_sp & 255u) == 0u) { if (xb_ld(&(bar)[XB_TMO])) break; if (_sp > XB_SPIN_CAP) { atomicAdd(&(bar)[XB_TMO], 1u); break; } } } } while (0)

struct XcdBarrier {
    unsigned* bar; unsigned x;
    volatile LAS unsigned* st;
};

__device__ __forceinline__ XcdBarrier xcd_barrier_post(unsigned* bar, volatile LAS unsigned* st) {
    XcdBarrier b; b.bar = bar; b.x = xb_xcc_id(); b.st = st;
    if (threadIdx.x == 0) (void)xb_add(&bar[XB_XCNT(b.x)], 1u);
    return b;
}
__device__ __forceinline__ void xcd_barrier_complete(unsigned* bar, unsigned x, unsigned& nloc, unsigned& nx) {
    const unsigned G = gridDim.x * gridDim.y * gridDim.z;
    unsigned sum, cnt, mine, sp = 0u;
    for (;;) {
        sum = 0u; cnt = 0u; mine = 0u;
#pragma unroll
        for (unsigned j = 0; j < 16; ++j) { const unsigned c = xb_ld(&bar[XB_XCNT(j)]); sum += c; cnt += (c > 0u) ? 1u : 0u; mine = (j == x) ? c : mine; }
        if (sum == G) break;
        __builtin_amdgcn_s_sleep(1);
        if ((++sp & 255u) == 0u) { if (xb_ld(&bar[XB_TMO])) break; if (sp > XB_SPIN_CAP) { atomicAdd(&bar[XB_TMO], 1u); break; } }
    }
    nloc = mine > 0u ? mine : 1u; nx = cnt > 0u ? cnt : 1u;
}

__device__ __forceinline__ void xcd_barrier(const XcdBarrier& b) {
    asm volatile("s_waitcnt vmcnt(0)" ::: "memory");
    __syncthreads();
    if (threadIdx.x == 0) {
        unsigned* bar = b.bar;
        __builtin_amdgcn_s_waitcnt(0);
        unsigned nloc = b.st[0], nx = b.st[1];
        if (nloc == 0u) { xcd_barrier_complete(bar, b.x, nloc, nx); b.st[0] = nloc; b.st[1] = nx; }
        const unsigned old = xb_add(&bar[XB_XSUB(b.x)], 1u);
        const unsigned gen = old / nloc;
        if (old + 1u == (gen + 1u) * nloc) {
            __builtin_amdgcn_fence(__ATOMIC_RELEASE, "agent");
            asm volatile("s_waitcnt vmcnt(0)" ::: "memory");
            const unsigned og = xb_add(&bar[XB_TOP], 1u);
            const unsigned tg = og / nx;
            if (og + 1u == (tg + 1u) * nx) xb_add(&bar[XB_TOPGEN], 1u);
            else XB_SPIN(xb_ld(&bar[XB_TOPGEN]) == tg, bar);
            __builtin_amdgcn_fence(__ATOMIC_ACQUIRE, "agent");
            xb_add(&bar[XB_XGEN(b.x)], 1u);
            asm volatile("s_waitcnt vmcnt(0)" ::: "memory");
        } else {
            XB_SPIN(xb_ld(&bar[XB_XGEN(b.x)]) == gen, bar);
            __builtin_amdgcn_fence(__ATOMIC_ACQUIRE, "agent");
            asm volatile("s_waitcnt vmcnt(0)" ::: "memory");
        }
    }
    __syncthreads();
}

#define XBAR() do { XcdBarrier xb_; xb_.bar = (unsigned*)(((const Args*)(kargs_t)__builtin_amdgcn_kernarg_segment_ptr())->ws + WS_BAR); xb_.x = xb_xcc_id(); xb_.st = (volatile LAS unsigned*)((LAS unsigned char*)lds_raw + XBAR_LDS_OFF); xcd_barrier(xb_); } while (0)
#define PHASE_BEGIN() \
    kargs_t ap_ = (kargs_t)__builtin_amdgcn_kernarg_segment_ptr(); asm volatile("" : "+s"(ap_)); const Args& A = *(const Args*)ap_; \
    int tid_ = threadIdx.x; asm volatile("" : "+v"(tid_)); const int tid = tid_, lane = tid & 63, wave = __builtin_amdgcn_readfirstlane(tid >> 6); \
    int G_ = gridDim.x, bx_ = blockIdx.x; asm volatile("" : "+s"(G_), "+s"(bx_)); const int G = G_, bx = bx_, vcu = (G % 8 == 0) ? (bx % 8) * (G / 8) + bx / 8 : bx; \
    const int gw = vcu * NWAVES + wave, NGW = G * NWAVES; unsigned char* const ws = A.ws; float* const mod = (float*)(ws + WS_MOD); \
    LAS unsigned char* const lds = (LAS unsigned char*)lds_raw; (void)lane; (void)gw; (void)NGW; (void)mod; (void)lds; (void)tid; (void)vcu;
__global__ void __launch_bounds__(NWAVES * 64, 2) fwd_megakernel(Args A_unused) {
    extern __shared__ __attribute__((aligned(16))) unsigned char lds_raw[];
    cg::grid_group grid = cg::this_grid();
    { if (threadIdx.x < 2) ((LAS unsigned*)((LAS unsigned char*)lds_raw + XBAR_LDS_OFF))[threadIdx.x] = 0u; __syncthreads();
      (void)xcd_barrier_post((unsigned*)(((const Args*)(kargs_t)__builtin_amdgcn_kernarg_segment_ptr())->ws + WS_BAR), (volatile LAS unsigned*)((LAS unsigned char*)lds_raw + XBAR_LDS_OFF)); }
    {
    PHASE_BEGIN();
    {
        LAS float* cs = (LAS float*)lds;
        LAS float* part = (LAS float*)(lds + 65536);
        bool have_cs = false;
        for (int item = bx; item < 192; item += G) {
            if (!have_cs) { for (int idx = tid; idx < 16384; idx += 512) { const int r = idx >> 10, k = idx & 1023; const float c = r < 8 ? A.c_prompt[r * 1024 + k] : A.c_sample[(r - 8) * 1024 + k]; cs[idx] = c * pg8::sigm(c); } have_cs = true; }
            __syncthreads();
            const int n0 = item * 32, slice = tid >> 5, col = tid & 31; float acc[16];
#pragma unroll
            for (int r = 0; r < 16; ++r) acc[r] = 0.f;
#pragma unroll 4
            for (int kk = 0; kk < 64; ++kk) { const int k = slice * 64 + kk; const float w = A.w_ada[(size_t)k * 6144 + n0 + col];
#pragma unroll
                for (int r = 0; r < 16; ++r) acc[r] += cs[r * 1024 + k] * w; }
#pragma unroll
            for (int r = 0; r < 16; ++r) part[(slice * 16 + r) * 32 + col] = acc[r];
            __syncthreads();
            { const int r = tid >> 5; float s = A.b_ada[n0 + col];
#pragma unroll
                for (int sl = 0; sl < 16; ++sl) s += part[(sl * 16 + r) * 32 + col];
                mod[r * 6144 + n0 + col] = s; }
            __syncthreads();
        }
        __syncthreads();
        LAS float* scr = (LAS float*)(lds + wave * 16384);
        constexpr int I_IN = 16 * 256, I_SQ = 16 * 32, I_GU = 16 * 176, I_DN = 44 * 32, NITEMS = I_IN + 3 * I_SQ + I_GU + I_DN;
        for (int it = gw; it < NITEMS; it += NGW) {
            int r = it;
            if (r < I_IN) { const int kb = r / 256, nb = r % 256; transpose_item(A.w_in, D, NIN, (bf16*)(ws + WS_WIN), kb, 32 * nb, win_drow(32 * nb), scr, lane); continue; } r -= I_IN;
            if (r < I_SQ) { transpose_item(A.w_ao, D, D, (bf16*)(ws + WS_WAO), r / 32, 32 * (r % 32), 32 * (r % 32), scr, lane); continue; } r -= I_SQ;
            if (r < I_SQ) { transpose_item(A.w_co, D, D, (bf16*)(ws + WS_WCO), r / 32, 32 * (r % 32), 32 * (r % 32), scr, lane); continue; } r -= I_SQ;
            if (r < I_SQ) { transpose_item(A.w_out, D, D, (bf16*)(ws + WS_WOUT), r / 32, 32 * (r % 32), 32 * (r % 32), scr, lane); continue; } r -= I_SQ;
            if (r < I_GU) { const int kb = r / 176, nb = r % 176; transpose_item(A.w_gu, D, NGU, (bf16*)(ws + WS_WGU), kb, 32 * nb, wgu_drow(32 * nb), scr, lane); continue; } r -= I_GU;
            transpose_item(A.w_dn, FF, D, (bf16*)(ws + WS_WDN), r / 32, 32 * (r % 32), 32 * (r % 32), scr, lane);
        }
    }
    }
    if (__builtin_expect(((const Args*)(kargs_t)__builtin_amdgcn_kernarg_segment_ptr())->ws == nullptr, 0)) grid.sync();
    XBAR();
    {
    PHASE_BEGIN();
    for (int m = gw; m < MT; m += NGW) {
        const float* xr = m < MP ? A.x_prompt + (size_t)m * D : A.x_sample + (size_t)(m - MP) * D;
        const float* mr = mod + (size_t)(m < MP ? (m >> 13) : 8 + ((m - MP) >> 5)) * 6144;
        norm_row(xr, A.norm1_g, mr, mr + 1024, (bf16*)(ws + WS_XN) + (size_t)m * D, lane);
    }
    }
    XBAR();
    {
    PHASE_BEGIN();
    {
        pg8::Gemm g{(const pg8::bf16_t*)(ws + WS_XN), (const pg8::bf16_t*)(ws + WS_WIN), MT, NIN, D}; pg8::StaticOrder S; S.init(MT, NIN, G, bx);
        pg8::EpiInProj E{(pg8::bf16_t*)(ws + WS_Q), (pg8::bf16_t*)(ws + WS_K), (pg8::bf16_t*)(ws + WS_V), (pg8::bf16_t*)(ws + WS_U), (pg8::bf16_t*)(ws + WS_GB),
                         (pg8::bf16_t*)(A.out), (pg8::bf16_t*)(A.out) + (size_t)MT * D, A.out, A.q_norm_g, A.k_norm_g};
        pg8::gemm_phase<pg8::EpiInProj, pg8::StaticOrder, true, true>(lds, g, S, E);
    }
    }
    XBAR();
    {
    PHASE_BEGIN();
    {
        const attn2::bf16* Qp = (const attn2::bf16*)(ws + WS_Q); const attn2::bf16* Kp = (const attn2::bf16*)(ws + WS_K); const attn2::bf16* Vp = (const attn2::bf16*)(ws + WS_V);
        attn2::bf16* Op = (attn2::bf16*)(ws + WS_ON);
        float* o2s = (float*)(ws + WS_O12) + (size_t)vcu * 32768;
        const float mq = wave_max(fabsf(A.q_norm_g[lane])), mk = wave_max(fabsf(A.k_norm_g[lane]));
        const float mshift = __uint_as_float(__builtin_amdgcn_readfirstlane(__float_as_uint(fmaxf(0.f, 64.f * pg8::QK_C2 * mq * mk * 1.02f - 64.f))));
        const float lam = __uint_as_float(__builtin_amdgcn_readfirstlane(__float_as_uint(__expf(wave_sum(A.lq1[lane] * A.lk1[lane])) - __expf(wave_sum(A.lq2[lane] * A.lk2[lane])) + LAM0)));
        const float* subg = A.sub_g;
        float* const kout = A.out + pg8::O_KP; float* const vout = A.out + pg8::O_VP;
#define ATTN_RUN(SH) do { \
        if (G == 256) { const int b = vcu >> 5, lc = vcu & 31, g2 = lc >> 4, s = lc & 15; \
            for (int u = 0; u < 16; ++u) { const int h = 2 * (u >> 2) + g2, mm = 1 - (u & 1), qb = (u & 2) ? 31 - s : s; \
                attn2::attn_unit<SH, 1024>(b, (h * 2 + mm) * 64, h * 128, h * 128, qb, mshift, mm == 0, lam, subg, 1.0f - LAM0, o2s, kout, vout, Qp, Kp, Vp, Op, (char*)lds_raw); } \
        } else { \
            for (int it = vcu; it < 8 * 8 * 32; it += G) { const int b = it >> 8, h = (it >> 5) & 7, qb = it & 31; \
                for (int mm = 1; mm >= 0; --mm) \
                    attn2::attn_unit<SH, 1024>(b, (h * 2 + mm) * 64, h * 128, h * 128, qb, mshift, mm == 0, lam, subg, 1.0f - LAM0, o2s, kout, vout, Qp, Kp, Vp, Op, (char*)lds_raw); } \
        } } while (0)
        if (mshift == 0.f) ATTN_RUN(false); else ATTN_RUN(true);
#undef ATTN_RUN
        asm volatile("s_waitcnt vmcnt(0) lgkmcnt(0)" ::: "memory"); __syncthreads();
        for (int it = (G - 1 - vcu); it < 128; it += G) sample_attn_item(A, lds, it >> 4, (it >> 1) & 7, it & 1, tid);
    }
    }
    XBAR();
    {
    PHASE_BEGIN();
    {
        float lam;
        { const float p1 = lane < 64 ? A.lq1[lane] * A.lk1[lane] : 0.f, p2 = A.lq2[lane] * A.lk2[lane]; lam = __expf(wave_sum(p1)) - __expf(wave_sum(p2)) + LAM0; }
        const bf16* O12 = (const bf16*)(ws + WS_O12); bf16* ON = (bf16*)(ws + WS_ON); const bf16* U = (const bf16*)(ws + WS_U); bf16* GBp = (bf16*)(ws + WS_GB);
        const int c16 = 16 * lane;
        float sg[16], w0[16], w1[16], w2[16];
#pragma unroll
        for (int i = 0; i < 16; ++i) { sg[i] = A.sub_g[(c16 + i) & 127] * (1.0f - LAM0); w0[i] = A.conv_w[c16 + i]; w1[i] = A.conv_w[1024 + c16 + i]; w2[i] = A.conv_w[2048 + c16 + i]; }
        for (int m = gw; m < MT; m += NGW) {
            if (m >= MP) { const v4u* p1 = (const v4u*)(O12 + (size_t)m * 2048 + c16); const v4u* p2 = (const v4u*)(O12 + (size_t)m * 2048 + 1024 + c16);
              float o[16]; float ss = 0.f;
#pragma unroll
              for (int e = 0; e < 2; ++e) { const v4u a = p1[e], c = p2[e];
                  o[8 * e + 0] = bflo(a.x) - lam * bflo(c.x); o[8 * e + 1] = bfhi(a.x) - lam * bfhi(c.x); o[8 * e + 2] = bflo(a.y) - lam * bflo(c.y); o[8 * e + 3] = bfhi(a.y) - lam * bfhi(c.y);
                  o[8 * e + 4] = bflo(a.z) - lam * bflo(c.z); o[8 * e + 5] = bfhi(a.z) - lam * bfhi(c.z); o[8 * e + 6] = bflo(a.w) - lam * bflo(c.w); o[8 * e + 7] = bfhi(a.w) - lam * bfhi(c.w); }
#pragma unroll
              for (int i = 0; i < 16; ++i) ss += o[i] * o[i];
              ss += __shfl_xor(ss, 1); ss += __shfl_xor(ss, 2); ss += __shfl_xor(ss, 4);
              const float rstd = __builtin_amdgcn_rsqf(ss * (1.0f / 128.0f) + pg8::RMS_EPS);
              v4u w[2];
#pragma unroll
              for (int e = 0; e < 2; ++e) { w[e].x = pk2(o[8 * e + 0] * rstd * sg[8 * e + 0], o[8 * e + 1] * rstd * sg[8 * e + 1]); w[e].y = pk2(o[8 * e + 2] * rstd * sg[8 * e + 2], o[8 * e + 3] * rstd * sg[8 * e + 3]);
                  w[e].z = pk2(o[8 * e + 4] * rstd * sg[8 * e + 4], o[8 * e + 5] * rstd * sg[8 * e + 5]); w[e].w = pk2(o[8 * e + 6] * rstd * sg[8 * e + 6], o[8 * e + 7] * rstd * sg[8 * e + 7]); }
              v4u* po = (v4u*)(ON + (size_t)m * D + c16); po[0] = w[0]; po[1] = w[1]; }
            { const bool smp = m >= MP; const int t = smp ? ((m - MP) & 31) : (m & 8191); const int sb = (m - MP) >> 5;
              float u0[16], u1[16], u2[16], gbv[16];
              ld16(U + (size_t)m * D + c16, u0); ld16(GBp + (size_t)m * D + c16, gbv);
              if (t >= 1) ld16(U + (size_t)(m - 1) * D + c16, u1);
              else if (smp) ldf(A.state_conv + (size_t)(sb * 2 + 1) * 1024 + c16, u1);
              else {
#pragma unroll
                  for (int i = 0; i < 16; ++i) u1[i] = 0.f; }
              if (t >= 2) ld16(U + (size_t)(m - 2) * D + c16, u2);
              else if (smp) ldf(A.state_conv + (size_t)(sb * 2 + t) * 1024 + c16, u2);
              else {
#pragma unroll
                  for (int i = 0; i < 16; ++i) u2[i] = 0.f; }
              v4u w[2]; float z[16];
#pragma unroll
              for (int i = 0; i < 16; ++i) z[i] = gbv[i] * (w0[i] * u2[i] + w1[i] * u1[i] + w2[i] * u0[i]);
#pragma unroll
              for (int e = 0; e < 2; ++e) { w[e].x = pk2(z[8 * e + 0], z[8 * e + 1]); w[e].y = pk2(z[8 * e + 2], z[8 * e + 3]); w[e].z = pk2(z[8 * e + 4], z[8 * e + 5]); w[e].w = pk2(z[8 * e + 6], z[8 * e + 7]); }
              v4u* po = (v4u*)(GBp + (size_t)m * D + c16); po[0] = w[0]; po[1] = w[1]; }
        }
    }
    }
    XBAR();
    {
    PHASE_BEGIN();
    {
        { pg8::PairOrder S; S.base.init(MP, D, G, bx);
          pg8::Gemm g{(const pg8::bf16_t*)(ws + WS_ON), (const pg8::bf16_t*)(ws + WS_WAO), MP, D, D, (const pg8::bf16_t*)(ws + WS_GB), (const pg8::bf16_t*)(ws + WS_WCO)};
          pg8::EpiGatePair E{(const pg8::bf16_t*)(A.out), (const pg8::bf16_t*)(A.out) + (size_t)MT * D, (pg8::bf16_t*)(ws + WS_MX)};
          pg8::gemm_phase<pg8::EpiGatePair, pg8::PairOrder, true, true>(lds, g, S, E); }
        small_gemm((const bf16*)(ws + WS_ON) + (size_t)MP * D, (const bf16*)(ws + WS_WAO), D, vcu, G, lds, tid, SmallGate0{(const bf16*)(A.out), (float*)(ws + WS_T)});
        small_gemm((const bf16*)(ws + WS_GB) + (size_t)MP * D, (const bf16*)(ws + WS_WCO), D, vcu, G, lds, tid, SmallGate1{(const bf16*)(A.out) + (size_t)MT * D, (const float*)(ws + WS_T), (bf16*)(ws + WS_MX)});
    }
    }
    XBAR();
    {
    PHASE_BEGIN();
    {
        pg8::Gemm g{(const pg8::bf16_t*)(ws + WS_MX), (const pg8::bf16_t*)(ws + WS_WOUT), MP, D, D}; pg8::StaticOrder S; S.init(MP, D, G, bx);
        pg8::EpiRes<false> E{A.x_prompt, (pg8::bf16_t*)(ws + WS_X1B), nullptr, mod + 2 * 1024};
        pg8::gemm_phase<pg8::EpiRes<false>, pg8::StaticOrder, true, true>(lds, g, S, E);
        small_gemm((const bf16*)(ws + WS_MX) + (size_t)MP * D, (const bf16*)(ws + WS_WOUT), D, vcu, G, lds, tid, SmallRes<false>{A.x_sample - (size_t)MP * D, (bf16*)(ws + WS_X1B), nullptr, mod + 2 * 1024});
    }
    }
    XBAR();
    {
    PHASE_BEGIN();
    for (int m = gw; m < MT; m += NGW) {
        const float* mr = mod + (size_t)(m < MP ? (m >> 13) : 8 + ((m - MP) >> 5)) * 6144;
        norm_row_bf(((const bf16*)(ws + WS_X1B)) + (size_t)m * D, A.norm2_g, mr + 3 * 1024, mr + 4 * 1024, (bf16*)(ws + WS_XN2) + (size_t)m * D, lane);
    }
    }
    XBAR();
    {
    PHASE_BEGIN();
    {
        pg8::Gemm g{(const pg8::bf16_t*)(ws + WS_XN2), (const pg8::bf16_t*)(ws + WS_WGU), MT, NGU, D}; pg8::StaticOrder S; S.init(MT, NGU, G, bx);
        pg8::EpiSwiglu E{(pg8::bf16_t*)(ws + WS_ACT)};
        pg8::gemm_phase<pg8::EpiSwiglu, pg8::StaticOrder, true, true>(lds, g, S, E);
    }
    }
    XBAR();
    {
    PHASE_BEGIN();
    {
        pg8::Gemm g{(const pg8::bf16_t*)(ws + WS_ACT), (const pg8::bf16_t*)(ws + WS_WDN), MP, D, FF}; pg8::StaticOrder S; S.init(MP, D, G, bx);
        pg8::EpiRes<true> E{nullptr, (pg8::bf16_t*)(ws + WS_X1B), A.out, mod + 5 * 1024};
        pg8::gemm_phase<pg8::EpiRes<true>, pg8::StaticOrder, true, true>(lds, g, S, E);
        small_gemm((const bf16*)(ws + WS_ACT) + (size_t)MP * FF, (const bf16*)(ws + WS_WDN), FF, vcu, G, lds, tid, SmallRes<true>{nullptr, (bf16*)(ws + WS_X1B), A.out, mod + 5 * 1024});
    }
    }
}

extern "C" void kernel_launch(void* const* d_in, const int* in_sizes, int n_in, void* d_out, int out_size, void* d_ws, size_t ws_size, hipStream_t stream) {
    static int grid = 0;
    if (grid == 0) {
        if (n_in != 25 || (size_t)out_size != pg8::O_END || ws_size < WS_END) { fprintf(stderr, "kernel_launch: unexpected shapes: n_in %d out %d ws %zu\n", n_in, out_size, ws_size); grid = -1; return; }
        int dev = 0, cus = 0, per_cu = 0;
        hipGetDevice(&dev); hipDeviceGetAttribute(&cus, hipDeviceAttributeMultiprocessorCount, dev);
        if (hipFuncSetAttribute((const void*)fwd_megakernel, hipFuncAttributeMaxDynamicSharedMemorySize, LDS_BYTES) != hipSuccess) { fprintf(stderr, "kernel_launch: hipFuncSetAttribute failed\n"); grid = -1; return; }
        if (hipOccupancyMaxActiveBlocksPerMultiprocessor(&per_cu, (const void*)fwd_megakernel, NWAVES * 64, LDS_BYTES) != hipSuccess || per_cu < 1) { fprintf(stderr, "kernel_launch: occupancy query gave %d\n", per_cu); per_cu = 1; }
        (void)hipGetLastError();
        grid = cus * 1;
    }
    if (grid < 0) return;
    Args a{};
    const float** f = (const float**)&a;
    for (int i = 0; i < 25; ++i) f[i] = (const float*)d_in[i];
    a.out = (float*)d_out; a.ws = (unsigned char*)d_ws;
    if (hipMemsetAsync((char*)d_ws + WS_BAR, 0, 16384, stream) != hipSuccess) { fprintf(stderr, "kernel_launch: hipMemsetAsync failed\n"); return; }
    void* args[] = {&a};
    hipError_t e = hipLaunchCooperativeKernel((const void*)fwd_megakernel, dim3(grid), dim3(NWAVES * 64), args, LDS_BYTES, stream);
    if (e != hipSuccess) fprintf(stderr, "cooperative launch failed: %s (grid %d)\n", hipGetErrorString(e), grid);
}
```

```cpp
#include <hip/hip_runtime.h>
#include <cstdio>
#include <cstdint>
namespace pg8 {
#define PG8_LAS __attribute__((address_space(3)))
typedef unsigned short bf16_t;
typedef short bf16x8 __attribute__((ext_vector_type(8)));
typedef float f32x4 __attribute__((ext_vector_type(4)));
typedef unsigned u32x4 __attribute__((ext_vector_type(4)));
constexpr int BM = 256, BK = 64, HALF = 128, HTB = HALF * BK * 2  , STAGE_BYTES = 8 * HTB, NXCD = 8, WGM = 8;

__host__ __device__ __forceinline__ int lds_byte(int r, int c) { const int st = (r >> 4) * 2 + (c >> 5), rr = r & 15, cc = c & 31, ob = rr * 64 + cc * 2; return st * 1024 + (ob ^ (((ob >> 9) & 1) << 5)); }
__host__ __device__ __forceinline__ void stage_rc(int b, int& R, int& C) { const int st = b / 1024, sb = b % 1024, swz = sb ^ (((sb >> 9) & 1) << 5); R = (st >> 1) * 16 + swz / 64; C = (st & 1) * 32 + (swz % 64) / 2; }
__host__ __device__ __forceinline__ int perm32(int rho) { const int n = rho >> 4, i = rho & 15; return 8 * (i >> 2) + 4 * n + (i & 3); }

struct Unit { int pm, pn, seg; };
struct Gemm { const bf16_t* A; const bf16_t* Bt; int M, N, K; const bf16_t* A2; const bf16_t* Bt2; };

struct StaticOrder {
    int nM, nN, nwg, G, c;
    __host__ __device__ void init(int M, int N, int G_, int c_) { nM = M / BM; nN = N / BM; nwg = nM * nN; G = G_; c = c_; }
    __host__ __device__ bool next(int i, Unit& u) const {
        const long L = (long)i * G + c; if (L >= nwg) return false;
        int wgid = (int)L; { const int q = nwg / NXCD, r = nwg % NXCD, xcd = wgid % NXCD, off = wgid / NXCD; wgid = (xcd < r ? xcd * (q + 1) : r * (q + 1) + (xcd - r) * q) + off; }
        const int nig = WGM * nN, gid = wgid / nig, fm = gid * WGM, gsz = (nM - fm) < WGM ? (nM - fm) : WGM;
        u.pm = fm + ((wgid % nig) % gsz); u.pn = (wgid % nig) / gsz; u.seg = 0; return true;
    }
    __device__ __forceinline__ void a_ready(const Unit&) const {}
    __device__ __forceinline__ void done(const Unit&) const {}
};

__device__ __forceinline__ unsigned cvt_pk_bf16(float lo, float hi) { unsigned r; asm volatile("v_cvt_pk_bf16_f32 %0, %1, %2" : "=v"(r) : "v"(lo), "v"(hi)); return r; }
typedef float f32x2 __attribute__((ext_vector_type(2)));
constexpr int MP = 65536, MS = 256, MT = MP + MS;
constexpr size_t O_Y = 0, O_KP = (size_t)MT * 1024, O_VP = O_KP + (size_t)MP * 1024, O_CP = O_VP + (size_t)MP * 1024, O_KS = O_CP + 16384, O_VS = O_KS + (size_t)MS * 1024, O_CS = O_VS + (size_t)MS * 1024, O_END = O_CS + 16384;
constexpr float QK_C2 = 0.125f * 1.4426950408889634f;
constexpr float RMS_EPS = 1e-6f;
__device__ __forceinline__ float bf_lo(unsigned w) { return __uint_as_float(w << 16); }
__device__ __forceinline__ float bf_hi(unsigned w) { return __uint_as_float(w & 0xffff0000u); }
__device__ __forceinline__ float sigm(float x) { return __builtin_amdgcn_rcpf(1.0f + __builtin_amdgcn_exp2f(-1.4426950408889634f * x)); }
__device__ __forceinline__ u32x4 pack8(f32x4 a, f32x4 b) { u32x4 w; w.x = cvt_pk_bf16(a[0], a[1]); w.y = cvt_pk_bf16(a[2], a[3]); w.z = cvt_pk_bf16(b[0], b[1]); w.w = cvt_pk_bf16(b[2], b[3]); return w; }

struct EpiInProj {
    static constexpr bool PERM = true, AFTER_DRAIN = false, PAIRED = false;
    bf16_t *Q, *Kb, *Vb, *U, *GB, *GA2, *GB2; float* out; const float *qg, *kg;
    __device__ __forceinline__ void operator()(const f32x4 (&acc)[2][2][4][2], const Unit& u, int wr, int wc, int fr, int fq) const {
        const int pn = u.pn, pm = u.pm; const bool smp = pm >= (MP / BM);
        const int row0 = pm * BM + wr * 64 + fr;
        if (pn >= 12 && pn < 20) {
            const int col = 128 * (pn - 12) + 32 * wc + 8 * fq;
#pragma unroll
            for (int ai = 0; ai < 2; ++ai)
#pragma unroll
                for (int m = 0; m < 4; ++m) { const int row = row0 + ai * HALF + m * 16;
                    const f32x4 a0 = acc[ai][0][m][0] * acc[ai][1][m][0], a1 = acc[ai][0][m][1] * acc[ai][1][m][1];
                    *(u32x4*)(U + (size_t)row * 1024 + col) = pack8(a0, a1);
                    if (!smp) { const int t = row & 8191; if (t >= 8190) { float* o = out + O_CP + (size_t)((row >> 13) * 2 + (t - 8190)) * 1024 + col; *(f32x4*)o = a0; *(f32x4*)(o + 4) = a1; } }
                    else { const int lr = row - MP, t = lr & 31; if (t >= 30) { float* o = out + O_CS + (size_t)((lr >> 5) * 2 + (t - 30)) * 1024 + col; *(f32x4*)o = a0; *(f32x4*)(o + 4) = a1; } }
                }
            return;
        }
        int sect, tloc; if (pn < 12) { sect = pn >> 2; tloc = pn & 3; } else { sect = 3 + ((pn - 20) >> 2); tloc = (pn - 20) & 3; }
        bf16_t* dst = sect == 0 ? Q : sect == 1 ? Kb : sect == 2 ? Vb : sect == 3 ? GB : sect == 4 ? GA2 : GB2;
        const int col0 = 256 * tloc + 64 * wc + 8 * fq;
        float* fo = nullptr;
        if (sect == 1 && smp) fo = out + O_KS - (size_t)MP * 1024;
        if (sect == 2 && smp) fo = out + O_VS - (size_t)MP * 1024;
        f32x4 g[2][2];
        if (sect < 2) { const float* gp = (sect == 0 ? qg : kg) + 8 * fq; const float sc = sect == 0 ? QK_C2 : 1.0f;
#pragma unroll
            for (int bj = 0; bj < 2; ++bj)
#pragma unroll
                for (int n = 0; n < 2; ++n) g[bj][n] = *(const f32x4*)(gp + 32 * bj + 4 * n) * sc; }
#pragma unroll
        for (int ai = 0; ai < 2; ++ai)
#pragma unroll
            for (int m = 0; m < 4; ++m) { const int row = row0 + ai * HALF + m * 16;
                f32x4 v[2][2];
#pragma unroll
                for (int bj = 0; bj < 2; ++bj)
#pragma unroll
                    for (int n = 0; n < 2; ++n) v[bj][n] = acc[ai][bj][m][n];
                if (sect < 2) { float ss = 0.f;
#pragma unroll
                    for (int bj = 0; bj < 2; ++bj)
#pragma unroll
                        for (int n = 0; n < 2; ++n) { const f32x4 x = v[bj][n]; ss += (x[0] * x[0] + x[1] * x[1]) + (x[2] * x[2] + x[3] * x[3]); }
                    ss += __shfl_xor(ss, 16); ss += __shfl_xor(ss, 32);
                    const float rstd = __builtin_amdgcn_rsqf(ss * (1.0f / 64.0f) + RMS_EPS);
#pragma unroll
                    for (int bj = 0; bj < 2; ++bj)
#pragma unroll
                        for (int n = 0; n < 2; ++n) v[bj][n] = v[bj][n] * rstd * g[bj][n]; }
#pragma unroll
                for (int bj = 0; bj < 2; ++bj) { *(u32x4*)(dst + (size_t)row * 1024 + col0 + 32 * bj) = pack8(v[bj][0], v[bj][1]);
                    if (fo) { float* o = fo + (size_t)row * 1024 + col0 + 32 * bj; *(f32x4*)o = v[bj][0]; *(f32x4*)(o + 4) = v[bj][1]; } }
            }
    }
};
template <int STEP> struct EpiGate {
    static constexpr bool PERM = true, AFTER_DRAIN = false, PAIRED = false;
    const bf16_t* G; float* T; bf16_t* Mx;
    __device__ __forceinline__ void operator()(const f32x4 (&acc)[2][2][4][2], const Unit& u, int wr, int wc, int fr, int fq) const {
        const int row0 = u.pm * BM + wr * 64 + fr, col0 = u.pn * BM + wc * 32 + 8 * fq;
#pragma unroll
        for (int ai = 0; ai < 2; ++ai)
#pragma unroll
            for (int m = 0; m < 4; ++m) { const size_t ro = (size_t)(row0 + ai * HALF + m * 16) * 1024 + col0;
#pragma unroll
                for (int bj = 0; bj < 2; ++bj) { const size_t o = ro + bj * HALF; const u32x4 gw = *(const u32x4*)(G + o);
                    f32x4 s0, s1; s0[0] = sigm(bf_lo(gw.x)); s0[1] = sigm(bf_hi(gw.x)); s0[2] = sigm(bf_lo(gw.y)); s0[3] = sigm(bf_hi(gw.y));
                    s1[0] = sigm(bf_lo(gw.z)); s1[1] = sigm(bf_hi(gw.z)); s1[2] = sigm(bf_lo(gw.w)); s1[3] = sigm(bf_hi(gw.w));
                    f32x4 v0 = s0 * acc[ai][bj][m][0], v1 = s1 * acc[ai][bj][m][1];
                    if (STEP == 0) { *(f32x4*)(T + o) = v0; *(f32x4*)(T + o + 4) = v1; }
                    else { v0 += *(const f32x4*)(T + o); v1 += *(const f32x4*)(T + o + 4); *(u32x4*)(Mx + o) = pack8(v0, v1); } } }
    }
};
template <bool FINAL> struct EpiRes {
    static constexpr bool PERM = true, AFTER_DRAIN = false, PAIRED = false;
    const float* xin; bf16_t* x1b; float* out; const float* gate;
    __device__ __forceinline__ void operator()(const f32x4 (&acc)[2][2][4][2], const Unit& u, int wr, int wc, int fr, int fq) const {
        const int row0 = u.pm * BM + wr * 64 + fr, col0 = u.pn * BM + wc * 32 + 8 * fq;
        const float* gp = gate + (size_t)(u.pm >> 5) * 6144 + col0;
        f32x4 g[2][2];
#pragma unroll
        for (int bj = 0; bj < 2; ++bj) { g[bj][0] = *(const f32x4*)(gp + bj * HALF); g[bj][1] = *(const f32x4*)(gp + bj * HALF + 4); }
#pragma unroll
        for (int ai = 0; ai < 2; ++ai)
#pragma unroll
            for (int m = 0; m < 4; ++m) { const size_t ro = (size_t)(row0 + ai * HALF + m * 16) * 1024 + col0;
#pragma unroll
                for (int bj = 0; bj < 2; ++bj) { const size_t o = ro + bj * HALF;
                    if constexpr (!FINAL) { const f32x4 b0 = *(const f32x4*)(xin + o), b1 = *(const f32x4*)(xin + o + 4);
                        *(u32x4*)(x1b + o) = pack8(b0 + g[bj][0] * acc[ai][bj][m][0], b1 + g[bj][1] * acc[ai][bj][m][1]); }
                    else { const u32x4 w = *(const u32x4*)(x1b + o);
                        const f32x4 b0 = {bf_lo(w.x), bf_hi(w.x), bf_lo(w.y), bf_hi(w.y)}, b1 = {bf_lo(w.z), bf_hi(w.z), bf_lo(w.w), bf_hi(w.w)};
                        *(f32x4*)(out + o) = b0 + g[bj][0] * acc[ai][bj][m][0]; *(f32x4*)(out + o + 4) = b1 + g[bj][1] * acc[ai][bj][m][1]; } } }
    }
};
struct EpiSwiglu {
    static constexpr bool PERM = true, AFTER_DRAIN = false, PAIRED = false;
    bf16_t* ACT;
    __device__ __forceinline__ void operator()(const f32x4 (&acc)[2][2][4][2], const Unit& u, int wr, int wc, int fr, int fq) const {
        const int row0 = u.pm * BM + wr * 64 + fr, col0 = u.pn * HALF + wc * 32 + 8 * fq;
#pragma unroll
        for (int ai = 0; ai < 2; ++ai)
#pragma unroll
            for (int m = 0; m < 4; ++m) { f32x4 r[2];
#pragma unroll
                for (int n = 0; n < 2; ++n) { const f32x4 g = acc[ai][0][m][n], up = acc[ai][1][m][n];
#pragma unroll
                    for (int i = 0; i < 4; ++i) r[n][i] = g[i] * sigm(g[i]) * up[i]; }
                *(u32x4*)(ACT + (size_t)(row0 + ai * HALF + m * 16) * 2816 + col0) = pack8(r[0], r[1]); }
    }
};
struct SingleOrder { int pm, pn;
    __device__ __forceinline__ bool next(int i, Unit& u) const { if (i != 0) return false; u.pm = pm; u.pn = pn; u.seg = 0; return true; }
    __device__ __forceinline__ void a_ready(const Unit&) const {}
    __device__ __forceinline__ void done(const Unit&) const {} };
struct PairOrder { StaticOrder base;
    __device__ __forceinline__ bool next(int i, Unit& u) const { if (!base.next(i >> 1, u)) return false; u.seg = i & 1; return true; }
    __device__ __forceinline__ void a_ready(const Unit&) const {}
    __device__ __forceinline__ void done(const Unit&) const {} };
struct EpiGatePair {
    static constexpr bool PERM = true, AFTER_DRAIN = false, PAIRED = true;
    const bf16_t* GA; const bf16_t* GBr; bf16_t* Mx;
    static __device__ __forceinline__ float em(float x) { return __builtin_amdgcn_exp2f(-1.4426950408889634f * x); }
    __device__ __forceinline__ void mid(f32x4 (&acc)[2][2][4][2], const Unit& u, int wr, int wc, int fr, int fq) const {
        const int row0 = u.pm * BM + wr * 64 + fr, col0 = u.pn * BM + wc * 32 + 8 * fq;
#pragma unroll
        for (int ai = 0; ai < 2; ++ai)
#pragma unroll
            for (int m = 0; m < 4; ++m) { const size_t ro = (size_t)(row0 + ai * HALF + m * 16) * 1024 + col0;
#pragma unroll
                for (int bj = 0; bj < 2; ++bj) { const size_t o = ro + bj * HALF; const u32x4 a = *(const u32x4*)(GA + o), b = *(const u32x4*)(GBr + o);
                    const unsigned aw[4] = {a.x, a.y, a.z, a.w}, bw[4] = {b.x, b.y, b.z, b.w};
#pragma unroll
                    for (int j = 0; j < 4; ++j) { const float r0 = (1.0f + em(fmaxf(bf_lo(bw[j]), -30.f))) * __builtin_amdgcn_rcpf(1.0f + em(bf_lo(aw[j]))), r1 = (1.0f + em(fmaxf(bf_hi(bw[j]), -30.f))) * __builtin_amdgcn_rcpf(1.0f + em(bf_hi(aw[j])));
                        acc[ai][bj][m][j >> 1][2 * (j & 1)] *= r0; acc[ai][bj][m][j >> 1][2 * (j & 1) + 1] *= r1; } } }
    }
    __device__ __forceinline__ void operator()(const f32x4 (&acc)[2][2][4][2], const Unit& u, int wr, int wc, int fr, int fq) const {
        const int row0 = u.pm * BM + wr * 64 + fr, col0 = u.pn * BM + wc * 32 + 8 * fq;
#pragma unroll
        for (int ai = 0; ai < 2; ++ai)
#pragma unroll
            for (int m = 0; m < 4; ++m) { const size_t ro = (size_t)(row0 + ai * HALF + m * 16) * 1024 + col0;
#pragma unroll
                for (int bj = 0; bj < 2; ++bj) { const size_t o = ro + bj * HALF; const u32x4 b = *(const u32x4*)(GBr + o);
                    f32x4 s0, s1; s0[0] = sigm(fmaxf(bf_lo(b.x), -30.f)); s0[1] = sigm(fmaxf(bf_hi(b.x), -30.f)); s0[2] = sigm(fmaxf(bf_lo(b.y), -30.f)); s0[3] = sigm(fmaxf(bf_hi(b.y), -30.f));
                    s1[0] = sigm(fmaxf(bf_lo(b.z), -30.f)); s1[1] = sigm(fmaxf(bf_hi(b.z), -30.f)); s1[2] = sigm(fmaxf(bf_lo(b.w), -30.f)); s1[3] = sigm(fmaxf(bf_hi(b.w), -30.f));
                    *(u32x4*)(Mx + o) = pack8(s0 * acc[ai][bj][m][0], s1 * acc[ai][bj][m][1]); } }
    }
};
template <class Epi, class Sched, bool ALIGN_EPI = false, bool SP2 = false>
__device__ __forceinline__ void gemm_phase(PG8_LAS unsigned char* lds, const Gemm g, const Sched& S, const Epi& E) {
    int tid_ = threadIdx.x; asm volatile("" : "+v"(tid_));
    const int tid = tid_, wid = __builtin_amdgcn_readfirstlane(tid >> 6), lane = tid & 63, wr = wid >> 2, wc = wid & 3, fr = lane & 15, fq = lane >> 4;
    const int K = g.K, nt = K / BK;
    unsigned voffA[2], voffB[2];
#pragma unroll
    for (int i = 0; i < 2; ++i) { int R, C; stage_rc(tid * 16 + i * 8192, R, C); const int Rb = Epi::PERM ? ((R & ~31) + perm32(R & 31)) : R;
        voffA[i] = (unsigned)(R * K + C) * 2u; voffB[i] = (unsigned)(Rb * K + C) * 2u; }
    const size_t kstep = (size_t)(BK * 2);
    const size_t hstep = (size_t)HALF * K * 2;
    const size_t tstep = 2 * hstep;
    const unsigned ldsw = (unsigned)wid * 1024u;
    const int aoff = lds_byte(wr * 64 + fr, fq * 8), boff = lds_byte(wc * 32 + fr, fq * 8);
#define PG8_SA(b, h) (((b) * 2 + (h)) * HTB)
#define PG8_SB(b, h) ((4 + (b) * 2 + (h)) * HTB)
#define PG8_STAGE(bufoff, gbase, voff) do { _Pragma("unroll") for (int _i = 0; _i < 2; ++_i) \
        __builtin_amdgcn_global_load_lds((const unsigned*)((const char*)(gbase) + (voff)[_i]), (PG8_LAS unsigned*)(lds + (bufoff) + ldsw + _i * 8192), 16, 0, 0); } while (0)
#define PG8_LDA(dst, b, h) do { _Pragma("unroll") for (int m = 0; m < 4; ++m) _Pragma("unroll") for (int k = 0; k < 2; ++k) dst[m][k] = *(const PG8_LAS bf16x8*)(lds + PG8_SA(b, h) + aoff + m * 2048 + k * 1024); } while (0)
#define PG8_LDB(dst, b, h) do { _Pragma("unroll") for (int n = 0; n < 2; ++n) _Pragma("unroll") for (int k = 0; k < 2; ++k) dst[n][k] = *(const PG8_LAS bf16x8*)(lds + PG8_SB(b, h) + boff + n * 2048 + k * 1024); } while (0)
#define PG8_MMA(ai, bj, At, Bt) do { __builtin_amdgcn_s_setprio(1); _Pragma("unroll") for (int m = 0; m < 4; ++m) _Pragma("unroll") for (int n = 0; n < 2; ++n) _Pragma("unroll") for (int k = 0; k < 2; ++k) \
        acc[ai][bj][m][n] = __builtin_amdgcn_mfma_f32_16x16x32_bf16(Bt[n][k], At[m][k], acc[ai][bj][m][n], 0, 0, 0); __builtin_amdgcn_s_setprio(0); } while (0)
#define PG8_WAIT_V(n) asm volatile("s_waitcnt vmcnt(" #n ")" ::: "memory")
#define PG8_WAIT_L(n) asm volatile("s_waitcnt lgkmcnt(" #n ")" ::: "memory")
#define PG8_BAR __builtin_amdgcn_s_barrier()
#define PG8_SCHED __builtin_amdgcn_sched_barrier(0)
    Unit cur, nxt; int ui = 0;
    if (!S.next(0, cur)) return;
    f32x4 acc[2][2][4][2];
#pragma unroll
    for (int a = 0; a < 2; ++a)
#pragma unroll
        for (int b = 0; b < 2; ++b)
#pragma unroll
            for (int m = 0; m < 4; ++m)
#pragma unroll
                for (int n = 0; n < 2; ++n) acc[a][b][m][n] = (f32x4){0.f, 0.f, 0.f, 0.f};
    bf16x8 At[4][2], B0[2][2], B1[2][2];
#define PG8_ABASE(u) ((const char*)((u).seg ? g.A2 : g.A) + (size_t)(u).pm * tstep)
#define PG8_BBASE(u) ((const char*)((u).seg ? g.Bt2 : g.Bt) + (size_t)(u).pn * tstep)
    const char* cA = PG8_ABASE(cur); const char* cB = PG8_BBASE(cur);
    S.a_ready(cur);
    if constexpr (SP2) {
        PG8_STAGE(PG8_SB(0, 0), cB, voffB); PG8_STAGE(PG8_SB(0, 1), cB + hstep, voffB); PG8_STAGE(PG8_SA(0, 0), cA, voffA); PG8_STAGE(PG8_SA(0, 1), cA + hstep, voffA);
        if (wr == 1) PG8_BAR;
        PG8_WAIT_V(2); PG8_BAR;
        PG8_STAGE(PG8_SB(1, 0), cB + kstep, voffB); PG8_STAGE(PG8_SA(1, 0), cA + kstep, voffA); PG8_STAGE(PG8_SB(1, 1), cB + hstep + kstep, voffB);
        PG8_WAIT_V(6); PG8_BAR;
    } else {
        PG8_STAGE(PG8_SB(0, 0), cB, voffB); PG8_STAGE(PG8_SA(0, 0), cA, voffA); PG8_STAGE(PG8_SB(0, 1), cB + hstep, voffB); PG8_STAGE(PG8_SA(0, 1), cA + hstep, voffA);
        if (wr == 1) PG8_BAR;
        PG8_WAIT_V(4); PG8_BAR;
        PG8_STAGE(PG8_SB(1, 0), cB + kstep, voffB); PG8_STAGE(PG8_SA(1, 0), cA + kstep, voffA); PG8_STAGE(PG8_SB(1, 1), cB + hstep + kstep, voffB);
        PG8_WAIT_V(6); PG8_BAR;
    }
    for (;;) {
        const bool has_next = S.next(ui + 1, nxt);
        const char* nA = has_next ? PG8_ABASE(nxt) : cA; const char* nB = has_next ? PG8_BBASE(nxt) : cB;
        for (int t = 0; t < nt; t += 2) {
            const bool last = (t == nt - 2);
            const char* a1 = cA + (size_t)(t + 1) * kstep;
            const char* a2 = last ? nA : cA + (size_t)(t + 2) * kstep; const char* b2 = last ? nB : cB + (size_t)(t + 2) * kstep;
            const char* a3 = a2 + kstep; const char* b3 = b2 + kstep;
            if (last && has_next) S.a_ready(nxt);
            if constexpr (SP2) {
            PG8_LDB(B0, 0, 0); PG8_LDB(B1, 0, 1); PG8_SCHED; PG8_LDA(At, 0, 0); PG8_STAGE(PG8_SA(1, 1), a1 + hstep, voffA);
            PG8_WAIT_V(8); PG8_WAIT_L(0); PG8_BAR; PG8_MMA(0, 0, At, B0); PG8_MMA(0, 1, At, B1); PG8_BAR; PG8_SCHED;
            PG8_LDA(At, 0, 1); PG8_STAGE(PG8_SB(0, 0), b2, voffB); PG8_STAGE(PG8_SB(0, 1), b2 + hstep, voffB); PG8_STAGE(PG8_SA(0, 0), a2, voffA);
            PG8_WAIT_V(8); PG8_WAIT_L(0); PG8_BAR; PG8_MMA(1, 0, At, B0); PG8_MMA(1, 1, At, B1); PG8_BAR; PG8_SCHED;
            PG8_LDB(B0, 1, 0); PG8_LDB(B1, 1, 1); PG8_SCHED; PG8_LDA(At, 1, 0); PG8_STAGE(PG8_SA(0, 1), a2 + hstep, voffA);
            PG8_WAIT_V(8); PG8_WAIT_L(0); PG8_BAR; PG8_MMA(0, 0, At, B0); PG8_MMA(0, 1, At, B1); PG8_BAR; PG8_SCHED;
            PG8_LDA(At, 1, 1); PG8_STAGE(PG8_SB(1, 0), b3, voffB); PG8_STAGE(PG8_SB(1, 1), b3 + hstep, voffB); PG8_STAGE(PG8_SA(1, 0), a3, voffA);
            PG8_WAIT_V(8); PG8_WAIT_L(0); PG8_BAR; PG8_MMA(1, 0, At, B0); PG8_MMA(1, 1, At, B1); PG8_BAR; PG8_SCHED;
            } else {
            PG8_LDB(B0, 0, 0); PG8_SCHED; PG8_LDA(At, 0, 0); PG8_STAGE(PG8_SA(1, 1), a1 + hstep, voffA);
            PG8_WAIT_L(8); PG8_BAR; PG8_WAIT_L(0); PG8_MMA(0, 0, At, B0); PG8_BAR; PG8_SCHED;
            PG8_LDB(B1, 0, 1); PG8_STAGE(PG8_SB(0, 0), b2, voffB);
            PG8_BAR; PG8_WAIT_L(0); PG8_MMA(0, 1, At, B1); PG8_BAR;
            PG8_LDA(At, 0, 1); PG8_STAGE(PG8_SA(0, 0), a2, voffA);
            PG8_BAR; PG8_WAIT_L(0); PG8_MMA(1, 0, At, B0); PG8_BAR; PG8_SCHED;
            PG8_STAGE(PG8_SB(0, 1), b2 + hstep, voffB);
            PG8_WAIT_V(6); PG8_BAR; PG8_MMA(1, 1, At, B1); PG8_BAR;
            PG8_LDB(B0, 1, 0); PG8_SCHED; PG8_LDA(At, 1, 0); PG8_STAGE(PG8_SA(0, 1), a2 + hstep, voffA);
            PG8_WAIT_L(8); PG8_BAR; PG8_WAIT_L(0); PG8_MMA(0, 0, At, B0); PG8_BAR; PG8_SCHED;
            PG8_LDB(B1, 1, 1); PG8_STAGE(PG8_SB(1, 0), b3, voffB);
            PG8_BAR; PG8_WAIT_L(0); PG8_MMA(0, 1, At, B1); PG8_BAR;
            PG8_LDA(At, 1, 1); PG8_STAGE(PG8_SA(1, 0), a3, voffA);
            PG8_BAR; PG8_WAIT_L(0); PG8_MMA(1, 0, At, B0); PG8_BAR; PG8_SCHED;
            PG8_STAGE(PG8_SB(1, 1), b3 + hstep, voffB);
            PG8_WAIT_V(6); PG8_BAR; PG8_MMA(1, 1, At, B1); PG8_BAR;
            }
        }
        if constexpr (ALIGN_EPI) { if (wr == 0) PG8_BAR; }
        bool keep_acc = false;
        if constexpr (Epi::PAIRED) { if (cur.seg == 0) { E.mid(acc, cur, wr, wc, fr, fq); keep_acc = true; } else E(acc, cur, wr, wc, fr, fq); S.done(cur); }
        else if constexpr (!Epi::AFTER_DRAIN) { E(acc, cur, wr, wc, fr, fq); S.done(cur); }
        if (!has_next) break;
        if (!keep_acc)
#pragma unroll
        for (int a = 0; a < 2; ++a)
#pragma unroll
            for (int b = 0; b < 2; ++b)
#pragma unroll
                for (int m = 0; m < 4; ++m)
#pragma unroll
                    for (int n = 0; n < 2; ++n) acc[a][b][m][n] = (f32x4){0.f, 0.f, 0.f, 0.f};
        cur = nxt; cA = nA; cB = nB; ++ui;
        if constexpr (ALIGN_EPI) { if (wr == 1) PG8_BAR; }
    }
    PG8_WAIT_V(0);
    if constexpr (!ALIGN_EPI) { if (wr == 0) PG8_BAR; }
    PG8_BAR;
    if constexpr (Epi::AFTER_DRAIN) { E.fused(acc, cur, wr, wc, fr, fq, lds, wid, lane); S.done(cur); }
#undef PG8_ABASE
#undef PG8_BBASE
#undef PG8_SA
#undef PG8_SB
#undef PG8_STAGE
#undef PG8_LDA
#undef PG8_LDB
#undef PG8_MMA
#undef PG8_WAIT_V
#undef PG8_WAIT_L
#undef PG8_BAR
#undef PG8_SCHED
}
}
#include <hip/hip_bf16.h>
#include <cmath>
namespace attn2 {
using bf16=__hip_bfloat16;
using bf16x8=__attribute__((ext_vector_type(8)))short;
using s16x4=__attribute__((ext_vector_type(4)))short;
using f32x16=__attribute__((ext_vector_type(16)))float;
using u32x4=__attribute__((ext_vector_type(4)))unsigned;
constexpr int SEQ=8192,DM=1024;
constexpr int NW=8,QBLK=32,QB=QBLK*NW,KVBLK=64;
__device__ __forceinline__ int crow(int r,int hi){return (r&3)+8*(r>>2)+4*hi;}
#define SBAR() __builtin_amdgcn_sched_barrier(0)
constexpr int NSLOT=3, SLOTB=8192;
constexpr int LDS_K=0, LDS_V=NSLOT*SLOTB, LDS_WS=LDS_V+2*NSLOT*SLOTB, LDS_OST=LDS_WS+NW*64*4, LDS_BYTES=LDS_OST+NW*4096;
__device__ __forceinline__ void glds16(const void*gsrc,unsigned lds_dst){unsigned keep;
  asm volatile("s_mov_b32 %0, m0\n\ts_mov_b32 m0, %2\n\ts_nop 0\n\tglobal_load_lds_dwordx4 %1, off\n\ts_mov_b32 m0, %0":"=&s"(keep):"v"(gsrc),"s"(lds_dst):"memory");}
typedef float f32x2_t __attribute__((ext_vector_type(2))); typedef __bf16 bf16x2_t __attribute__((ext_vector_type(2)));
__device__ __forceinline__ unsigned cvtpk_s(float lo,float hi){f32x2_t v={lo,hi};bf16x2_t b=__builtin_convertvector(v,bf16x2_t);return __builtin_bit_cast(unsigned,b);}
#define WAIT_BAR(N) asm volatile("s_waitcnt vmcnt(" #N ") lgkmcnt(0)\n\ts_barrier":::"memory")
typedef __attribute__((address_space(3))) const char* lds_cptr;
typedef short v4i16_t __attribute__((ext_vector_type(4)));
__device__ __forceinline__ void qkt0(f32x16&p0,f32x16&p1,const char*Kslot,const bf16x8*qr,int r32,int hi){
  const char*kb=Kslot+hi*1024+r32*16; const f32x16 z=f32x16{};
  #pragma unroll
  for(int d0=0;d0<4;++d0){
    const bf16x8 b0=*reinterpret_cast<const bf16x8*>(kb+d0*2048);
    const bf16x8 b1=*reinterpret_cast<const bf16x8*>(kb+d0*2048+512);
    if(d0==0){p0=__builtin_amdgcn_mfma_f32_32x32x16_bf16(b0,qr[0],z,0,0,0);p1=__builtin_amdgcn_mfma_f32_32x32x16_bf16(b1,qr[0],z,0,0,0);}
    else{p0=__builtin_amdgcn_mfma_f32_32x32x16_bf16(b0,qr[d0],p0,0,0,0);p1=__builtin_amdgcn_mfma_f32_32x32x16_bf16(b1,qr[d0],p1,0,0,0);}}
}
__device__ __forceinline__ void kload8(bf16x8*kf,lds_cptr kp){
  kf[0]=*(const __attribute__((address_space(3))) bf16x8*)(kp);      kf[1]=*(const __attribute__((address_space(3))) bf16x8*)(kp+512);
  kf[2]=*(const __attribute__((address_space(3))) bf16x8*)(kp+2048); kf[3]=*(const __attribute__((address_space(3))) bf16x8*)(kp+2560);
  kf[4]=*(const __attribute__((address_space(3))) bf16x8*)(kp+4096); kf[5]=*(const __attribute__((address_space(3))) bf16x8*)(kp+4608);
  kf[6]=*(const __attribute__((address_space(3))) bf16x8*)(kp+6144); kf[7]=*(const __attribute__((address_space(3))) bf16x8*)(kp+6656);
}
__device__ __forceinline__ void kload2(bf16x8*kf,lds_cptr kp,int j){ kf[2*j]=*(const __attribute__((address_space(3))) bf16x8*)(kp+j*2048); kf[2*j+1]=*(const __attribute__((address_space(3))) bf16x8*)(kp+j*2048+512); }
__device__ __forceinline__ s16x4 vtr(lds_cptr p){ return __builtin_bit_cast(s16x4,__builtin_amdgcn_ds_read_tr16_b64_v4i16((__attribute__((address_space(3))) v4i16_t*)p)); }
__device__ __forceinline__ void pv4(f32x16*o,int vb,bf16x8 pa0,bf16x8 pa1,bf16x8 pa2,bf16x8 pa3){
  #pragma unroll
  for(int d0=0;d0<4;++d0){s16x4 lo[4],hi[4];
    #pragma unroll
    for(int ks=0;ks<4;++ks){
      asm volatile("ds_read_b64_tr_b16 %0,%1 offset:%c2":"=&v"(lo[ks]):"v"(vb),"i"(d0*4096+ks*1024):"memory");
      asm volatile("ds_read_b64_tr_b16 %0,%1 offset:%c2":"=&v"(hi[ks]):"v"(vb),"i"(d0*4096+ks*1024+512):"memory");}
    asm volatile("s_waitcnt lgkmcnt(0)":::"memory");SBAR();
    #define PK(k) (bf16x8){lo[k][0],lo[k][1],lo[k][2],lo[k][3],hi[k][0],hi[k][1],hi[k][2],hi[k][3]}
    o[d0]=__builtin_amdgcn_mfma_f32_32x32x16_bf16(pa0,PK(0),o[d0],0,0,0);
    o[d0]=__builtin_amdgcn_mfma_f32_32x32x16_bf16(pa1,PK(1),o[d0],0,0,0);
    o[d0]=__builtin_amdgcn_mfma_f32_32x32x16_bf16(pa2,PK(2),o[d0],0,0,0);
    o[d0]=__builtin_amdgcn_mfma_f32_32x32x16_bf16(pa3,PK(3),o[d0],0,0,0);
    #undef PK
  }
}
#ifndef ATTN_STORE16
#define ATTN_STORE16(p,v) (*(u32x4*)(p)=(v))
#endif
template<bool SHIFT,int OP> __device__ __forceinline__ void attn_unit(int b,int qcol,int vcol,int ocol,int qb,float mshift,int mode,float lam,const float*subg,float gmul,float*o2s,float*kout,float*vout,const bf16*Uc,bf16*GBc,const float*convw,const bf16*Q,const bf16*__restrict__ K,const bf16*__restrict__ V,bf16*O,char*shm){
  int tid_=threadIdx.x; asm volatile("":"+v"(tid_)); const int tid=tid_,lane=tid&63,r32=lane&31,hi=lane>>5; const int wid=__builtin_amdgcn_readfirstlane(tid>>6);
  const long rowbase=(long)b*SEQ; const int q0=qb*QB;
  const bf16*Qw=Q+(rowbase+q0+wid*QBLK)*DM+qcol;
  const bf16*Kh=K+rowbase*DM+qcol,*Vh=V+rowbase*DM+vcol;
  const unsigned lds0=(unsigned)(uintptr_t)shm;
  float*wsf=(float*)(shm+LDS_WS)+wid*64;
  const bf16*ksrc=Kh+(long)lane*DM+wid*8;
  const bf16*vsrc=Vh+(long)(16*(wid&3)+(lane>>2))*DM+(wid>>2)*32+(lane&3)*8;
  const unsigned kdst=lds0+LDS_K+wid*1024, vdst=lds0+LDS_V+wid*1024;
  #define DMA_K(t,slot) glds16(ksrc+(long)(t)*KVBLK*DM,(unsigned)__builtin_amdgcn_readfirstlane(kdst+(slot)))
  #define DMA_V(t,slot) do{ glds16(vsrc+(long)(t)*KVBLK*DM,(unsigned)__builtin_amdgcn_readfirstlane(vdst+2*(slot))); glds16(vsrc+(long)(t)*KVBLK*DM+64,(unsigned)__builtin_amdgcn_readfirstlane(vdst+2*(slot)+8192)); }while(0)
  const int vb0=(int)(lds0+LDS_V)+((lane>>4)&1)*32+(lane&3)*8+(4*hi+((lane&15)>>2))*64;
  const char*Kbase=shm+LDS_K; bf16x8 kf[8];
  const lds_cptr shm3=(lds_cptr)shm; const lds_cptr kp0=shm3+LDS_K+hi*1024+r32*16; const lds_cptr vp0=shm3+LDS_V+((lane>>4)&1)*32+(lane&3)*8+(4*hi+((lane&15)>>2))*64;
  const int NT=(q0+QB)/KVBLK;
  DMA_K(0,0);DMA_V(0,0);DMA_K(1,SLOTB);
  bf16x8 qr[4];
  #pragma unroll
  for(int d0=0;d0<4;++d0)qr[d0]=*reinterpret_cast<const bf16x8*>(&Qw[(long)r32*DM+d0*16+hi*8]);
  float l_reg=0.f;f32x16 o[4];o[0]=f32x16{};o[1]=f32x16{};o[2]=f32x16{};o[3]=f32x16{};
  const int chunkw=wid>>1;
  #define CMASK_BAND(P0,P1,t) do{int jb_=(t)-(NT-4); if(jb_>chunkw){ asm volatile("":::"memory"); _Pragma("unroll") for(int r=0;r<16;++r){P0[r]=-INFINITY;P1[r]=-INFINITY;} } }while(0)
  #define CMASK(P0,P1,t) CMASK_BAND(P0,P1,t)
  #define EX(v) __builtin_amdgcn_exp2f(v)
  #define EXS(v) (SHIFT?EX((v)-mshift):EX(v))
  f32x16 pA0,pA1,pB0,pB1;
  int sl_prev=0,sl_cur=0,sl_next=SLOTB;
  #define ROT() do{sl_prev=sl_cur;sl_cur=sl_next;sl_next=(sl_next==(NSLOT-1)*SLOTB)?0:sl_next+SLOTB;}while(0)
  DMA_K(2,2*SLOTB);
  WAIT_BAR(4);
  qkt0(pA0,pA1,Kbase,qr,r32,hi);CMASK(pA0,pA1,0);
  _Pragma("unroll") for(int r=0;r<16;++r){pA0[r]=EXS(pA0[r]);pA1[r]=EXS(pA1[r]);}
  WAIT_BAR(0);
  DMA_K(3,0);DMA_V(1,SLOTB);
  ROT();
  kload8(kf,kp0+sl_cur);
  WAIT_BAR(3);
  s16x4 vlo[8],vhi[8]; u32x4 pw0,pw1,pw2,pw3;
  #define PKW(P,B) cvtpk_s(P[B],P[B+1])
  #define PAF(k) __builtin_bit_cast(bf16x8,pw##k)
  #define VFR(i) (bf16x8){vlo[i][0],vlo[i][1],vlo[i][2],vlo[i][3],vhi[i][0],vhi[i][1],vhi[i][2],vhi[i][3]}
  #define PIN(x) asm volatile("":"+v"(x))
  #define GAPA(MF,A0,A1,A2,A3,W0,W1,PW) do{ MF; sacc+=A0; sacc+=A1; sacc+=A2; sacc+=A3; PIN(sacc); W0; W1; PIN(PW); SBAR(); }while(0)
  #define GAPB(MF,X,B) do{ MF; X[B]=EXS(X[B]); X[B+1]=EXS(X[B+1]); PIN(X); SBAR(); }while(0)
  #define VRD(i,db) do{ vlo[i]=vtr(vp_+((db)*4096+((i)&3)*1024)); vhi[i]=vtr(vp_+((db)*4096+((i)&3)*1024+512)); }while(0)
  #define KRD(G,j) do{ if(G){ kload2(kf,kp0+sl_next,j); SBAR(); } }while(0)
  #define STEP(C0,C1,P0,P1,t,GK,GV,GL) do{ SBAR(); \
    const lds_cptr vp_=vp0+2*sl_prev; const f32x16 z_=f32x16{}; \
    VRD(0,0); SBAR(); float sacc=(P0[0]+P0[1]); \
    GAPA(C0=__builtin_amdgcn_mfma_f32_32x32x16_bf16(kf[0],qr[0],z_,0,0,0), P0[2],P0[3],P0[4],P0[5],     pw0[0]=PKW(P0,0), pw0[1]=PKW(P0,2), pw0); \
    VRD(4,1); SBAR(); GAPA(C1=__builtin_amdgcn_mfma_f32_32x32x16_bf16(kf[1],qr[0],z_,0,0,0), P0[6],P0[7],P0[8],P0[9],     pw0[2]=PKW(P0,4), pw0[3]=PKW(P0,6), pw0); \
    VRD(1,0); SBAR(); GAPA(C0=__builtin_amdgcn_mfma_f32_32x32x16_bf16(kf[2],qr[1],C0,0,0,0),   P0[10],P0[11],P0[12],P0[13], pw1[0]=PKW(P0,8), pw1[1]=PKW(P0,10), pw1); \
    VRD(5,1); SBAR(); GAPA(C1=__builtin_amdgcn_mfma_f32_32x32x16_bf16(kf[3],qr[1],C1,0,0,0),   P0[14],P0[15],P1[0],P1[1],   pw1[2]=PKW(P0,12),pw1[3]=PKW(P0,14), pw1); \
    VRD(2,0); SBAR(); GAPA(C0=__builtin_amdgcn_mfma_f32_32x32x16_bf16(kf[4],qr[2],C0,0,0,0),   P1[2],P1[3],P1[4],P1[5],     pw2[0]=PKW(P1,0), pw2[1]=PKW(P1,2), pw2); \
    VRD(6,1); SBAR(); GAPA(C1=__builtin_amdgcn_mfma_f32_32x32x16_bf16(kf[5],qr[2],C1,0,0,0),   P1[6],P1[7],P1[8],P1[9],     pw2[2]=PKW(P1,4), pw2[3]=PKW(P1,6), pw2); \
    VRD(3,0); SBAR(); GAPA(C0=__builtin_amdgcn_mfma_f32_32x32x16_bf16(kf[6],qr[3],C0,0,0,0),   P1[10],P1[11],P1[12],P1[13], pw3[0]=PKW(P1,8), pw3[1]=PKW(P1,10), pw3); \
    VRD(7,1); SBAR(); GAPA(C1=__builtin_amdgcn_mfma_f32_32x32x16_bf16(kf[7],qr[3],C1,0,0,0),   P1[14],P1[15],0.f,0.f,       pw3[2]=PKW(P1,12),pw3[3]=PKW(P1,14), pw3); \
    l_reg+=sacc; \
    if(GK){DMA_K((t)+3,sl_cur);} if(GV){DMA_V((t)+1,sl_next);} \
    CMASK(C0,C1,t); \
    SBAR(); \
    GAPB(o[0]=__builtin_amdgcn_mfma_f32_32x32x16_bf16(PAF(0),VFR(0),o[0],0,0,0), C0,0);  VRD(0,2); SBAR(); \
    GAPB(o[1]=__builtin_amdgcn_mfma_f32_32x32x16_bf16(PAF(0),VFR(4),o[1],0,0,0), C0,2);  VRD(4,3); SBAR(); \
    KRD(GL,0); GAPB(o[0]=__builtin_amdgcn_mfma_f32_32x32x16_bf16(PAF(1),VFR(1),o[0],0,0,0), C0,4);  VRD(1,2); SBAR(); \
    KRD(GL,1); GAPB(o[1]=__builtin_amdgcn_mfma_f32_32x32x16_bf16(PAF(1),VFR(5),o[1],0,0,0), C0,6);  VRD(5,3); SBAR(); \
    KRD(GL,2); GAPB(o[0]=__builtin_amdgcn_mfma_f32_32x32x16_bf16(PAF(2),VFR(2),o[0],0,0,0), C0,8);  VRD(2,2); SBAR(); \
    KRD(GL,3); GAPB(o[1]=__builtin_amdgcn_mfma_f32_32x32x16_bf16(PAF(2),VFR(6),o[1],0,0,0), C0,10); VRD(6,3); SBAR(); \
    GAPB(o[0]=__builtin_amdgcn_mfma_f32_32x32x16_bf16(PAF(3),VFR(3),o[0],0,0,0), C0,12); VRD(3,2); SBAR(); \
    GAPB(o[1]=__builtin_amdgcn_mfma_f32_32x32x16_bf16(PAF(3),VFR(7),o[1],0,0,0), C0,14); VRD(7,3); SBAR(); \
    GAPB(o[2]=__builtin_amdgcn_mfma_f32_32x32x16_bf16(PAF(0),VFR(0),o[2],0,0,0), C1,0); \
    GAPB(o[3]=__builtin_amdgcn_mfma_f32_32x32x16_bf16(PAF(0),VFR(4),o[3],0,0,0), C1,2); \
    GAPB(o[2]=__builtin_amdgcn_mfma_f32_32x32x16_bf16(PAF(1),VFR(1),o[2],0,0,0), C1,4); \
    GAPB(o[3]=__builtin_amdgcn_mfma_f32_32x32x16_bf16(PAF(1),VFR(5),o[3],0,0,0), C1,6); \
    GAPB(o[2]=__builtin_amdgcn_mfma_f32_32x32x16_bf16(PAF(2),VFR(2),o[2],0,0,0), C1,8); \
    GAPB(o[3]=__builtin_amdgcn_mfma_f32_32x32x16_bf16(PAF(2),VFR(6),o[3],0,0,0), C1,10); \
    GAPB(o[2]=__builtin_amdgcn_mfma_f32_32x32x16_bf16(PAF(3),VFR(3),o[2],0,0,0), C1,12); \
    GAPB(o[3]=__builtin_amdgcn_mfma_f32_32x32x16_bf16(PAF(3),VFR(7),o[3],0,0,0), C1,14); \
    }while(0)
  if(wid>=4)__builtin_amdgcn_s_setprio(1);
  int t=1;
  #undef CMASK
  #define CMASK(P0,P1,t) do{}while(0)
  for(;t+5<NT;t+=2){
    STEP(pB0,pB1,pA0,pA1,t,true,true,true);     WAIT_BAR(3); ROT();
    STEP(pA0,pA1,pB0,pB1,t+1,true,true,true);   WAIT_BAR(3); ROT();
  }
  #undef CMASK
  #define CMASK(P0,P1,t) CMASK_BAND(P0,P1,t)
  #define ENDW(tt) do{ if((tt)+3<NT){WAIT_BAR(3);} else if((tt)+2<NT){WAIT_BAR(2);} else {WAIT_BAR(0);} }while(0)
  for(;t+1<NT;t+=2){
    STEP(pB0,pB1,pA0,pA1,t,(t+3<NT),(t+1<NT),(t+1<NT));       ENDW(t);   ROT();
    STEP(pA0,pA1,pB0,pB1,t+1,(t+4<NT),(t+2<NT),(t+2<NT));     ENDW(t+1); ROT();
  }
  STEP(pB0,pB1,pA0,pA1,NT-1,false,false,false);
  { float sacc=pB0[0]+pB0[1]; _Pragma("unroll") for(int r=2;r<16;++r)sacc+=pB0[r]; _Pragma("unroll") for(int r=0;r<16;++r)sacc+=pB1[r]; l_reg+=sacc;
    pw0=(u32x4){PKW(pB0,0),PKW(pB0,2),PKW(pB0,4),PKW(pB0,6)};pw1=(u32x4){PKW(pB0,8),PKW(pB0,10),PKW(pB0,12),PKW(pB0,14)};pw2=(u32x4){PKW(pB1,0),PKW(pB1,2),PKW(pB1,4),PKW(pB1,6)};pw3=(u32x4){PKW(pB1,8),PKW(pB1,10),PKW(pB1,12),PKW(pB1,14)};
    SBAR(); pv4(o,vb0+2*sl_cur,PAF(0),PAF(1),PAF(2),PAF(3)); }
  #undef PKW
  #undef PAF
  #undef VFR
  #undef PIN
  #undef GAPA
  #undef GAPB
  #undef EX
  #undef EXS
  #undef VRD
  #undef KRD
  #undef STEP
  #undef ENDW
  __builtin_amdgcn_s_setprio(0);
  {auto rr=__builtin_amdgcn_permlane32_swap(__float_as_uint(l_reg),__float_as_uint(l_reg),false,false);l_reg=__uint_as_float(rr[0])+__uint_as_float(rr[1]);}
  if(hi==0)wsf[32+r32]=l_reg;asm volatile("s_waitcnt lgkmcnt(0)":::"memory");
  { float rli[16];
  #pragma unroll
  for(int r=0;r<16;++r)rli[r]=__builtin_amdgcn_rcpf(wsf[32+crow(r,hi)]);
  #pragma unroll
  for(int d0=0;d0<4;++d0)
    #pragma unroll
    for(int r=0;r<16;++r)o[d0][r]*=rli[r]; }
  typedef float f32x4o __attribute__((ext_vector_type(4)));
  f32x4o*o2w=(f32x4o*)(o2s+(size_t)wid*4096)+lane;
  if(mode==0){
    #pragma unroll
    for(int d0=0;d0<4;++d0)
      #pragma unroll
      for(int j=0;j<4;++j)o2w[(d0*4+j)*64]=(f32x4o){o[d0][4*j],o[d0][4*j+1],o[d0][4*j+2],o[d0][4*j+3]};
  } else {
    #pragma unroll
    for(int d0=0;d0<4;++d0)
      #pragma unroll
      for(int j=0;j<4;++j){ const f32x4o t=o2w[(d0*4+j)*64]; o[d0][4*j]-=lam*t.x; o[d0][4*j+1]-=lam*t.y; o[d0][4*j+2]-=lam*t.z; o[d0][4*j+3]-=lam*t.w; }
    float sg[4];
    #pragma unroll
    for(int d0=0;d0<4;++d0)sg[d0]=subg[32*d0+r32]*gmul;
    #pragma unroll
    for(int r=0;r<16;++r){ float ss=(o[0][r]*o[0][r]+o[1][r]*o[1][r])+(o[2][r]*o[2][r]+o[3][r]*o[3][r]);
      ss+=__shfl_xor(ss,1);ss+=__shfl_xor(ss,2);ss+=__shfl_xor(ss,4);ss+=__shfl_xor(ss,8);ss+=__shfl_xor(ss,16);
      const float rs=__builtin_amdgcn_rsqf(ss*(1.0f/128.0f)+1e-6f);
      #pragma unroll
      for(int d0=0;d0<4;++d0)o[d0][r]*=rs*sg[d0]; }
    bf16*Ow=O+(rowbase+q0+wid*QBLK)*OP+ocol;
    bf16*stg=(bf16*)(shm+LDS_OST)+wid*2048;
    #pragma unroll
    for(int ps=0;ps<2;++ps){
      #pragma unroll
      for(int r=0;r<16;++r){const int orow=crow(r,hi);
        #pragma unroll
        for(int d0=0;d0<2;++d0)stg[orow*64+d0*32+r32]=__float2bfloat16(o[2*ps+d0][r]);}
      asm volatile("s_waitcnt lgkmcnt(0)":::"memory");
      #pragma unroll
      for(int i=0;i<4;++i){const int row=i*8+(lane>>3),ch=lane&7; const u32x4 v=*(const u32x4*)(stg+row*64+ch*8); ATTN_STORE16(Ow+(long)row*OP+ps*64+ch*8,v);}
      asm volatile("s_waitcnt lgkmcnt(0)":::"memory"); } }
  { typedef float f32x4a __attribute__((ext_vector_type(4)));
    #pragma unroll
    for(int i=0;i<4;++i){ const int gI=tid+512*i,row=gI>>3,c8=gI&7; const u32x4 w=*(const u32x4*)(Kh+(long)(q0+row)*DM+c8*8); float*dst=kout+(rowbase+q0+row)*DM+qcol+c8*8;
      *(f32x4a*)dst=(f32x4a){__uint_as_float(w.x<<16),__uint_as_float(w.x&0xffff0000u),__uint_as_float(w.y<<16),__uint_as_float(w.y&0xffff0000u)};
      *(f32x4a*)(dst+4)=(f32x4a){__uint_as_float(w.z<<16),__uint_as_float(w.z&0xffff0000u),__uint_as_float(w.w<<16),__uint_as_float(w.w&0xffff0000u)}; }
    { const int c8=tid&7; float cw0[8],cw1[8],cw2[8];
      #pragma unroll
      for(int e=0;e<8;++e){ cw0[e]=convw[qcol+c8*8+e]; cw1[e]=convw[1024+qcol+c8*8+e]; cw2[e]=convw[2048+qcol+c8*8+e]; }
      #pragma unroll
      for(int i=0;i<4;++i){ const int row=(tid+512*i)>>3, tt=q0+row; const long mrow=rowbase+tt; const u32x4 zz={0u,0u,0u,0u};
        const u32x4 a0=*(const u32x4*)(Uc+mrow*DM+qcol+c8*8), gw_=*(const u32x4*)(GBc+mrow*DM+qcol+c8*8);
        const u32x4 a1=tt>=1?*(const u32x4*)(Uc+(mrow-1)*DM+qcol+c8*8):zz, a2=tt>=2?*(const u32x4*)(Uc+(mrow-2)*DM+qcol+c8*8):zz;
        const unsigned w0_[4]={a0.x,a0.y,a0.z,a0.w},w1_[4]={a1.x,a1.y,a1.z,a1.w},w2_[4]={a2.x,a2.y,a2.z,a2.w},wg_[4]={gw_.x,gw_.y,gw_.z,gw_.w}; unsigned zo[4];
        #pragma unroll
        for(int j=0;j<4;++j){
          const float zl=__uint_as_float(wg_[j]<<16)*(cw0[2*j]*__uint_as_float(w2_[j]<<16)+cw1[2*j]*__uint_as_float(w1_[j]<<16)+cw2[2*j]*__uint_as_float(w0_[j]<<16));
          const float zh=__uint_as_float(wg_[j]&0xffff0000u)*(cw0[2*j+1]*__uint_as_float(w2_[j]&0xffff0000u)+cw1[2*j+1]*__uint_as_float(w1_[j]&0xffff0000u)+cw2[2*j+1]*__uint_as_float(w0_[j]&0xffff0000u));
          zo[j]=cvtpk_s(zl,zh); }
        *(u32x4*)(GBc+mrow*DM+qcol+c8*8)=(u32x4){zo[0],zo[1],zo[2],zo[3]}; } }
    if(mode==1){
      #pragma unroll
      for(int i=0;i<8;++i){ const int gI=tid+512*i,row=gI>>4,c8=gI&15; const u32x4 w=*(const u32x4*)(Vh+(long)(q0+row)*DM+c8*8); float*dst=vout+(rowbase+q0+row)*DM+vcol+c8*8;
        *(f32x4a*)dst=(f32x4a){__uint_as_float(w.x<<16),__uint_as_float(w.x&0xffff0000u),__uint_as_float(w.y<<16),__uint_as_float(w.y&0xffff0000u)};
        *(f32x4a*)(dst+4)=(f32x4a){__uint_as_float(w.z<<16),__uint_as_float(w.z&0xffff0000u),__uint_as_float(w.w<<16),__uint_as_float(w.w&0xffff0000u)}; } } }
  asm volatile("s_waitcnt lgkmcnt(0)\n\ts_barrier":::"memory");
  #undef DMA_K
  #undef DMA_V
  #undef CMASK
  #undef CMASK_BAND
  #undef ROT
}
#undef SBAR
#undef WAIT_BAR
}
#include <hip/hip_cooperative_groups.h>
namespace cg = cooperative_groups;
constexpr int NWAVES = 8;
constexpr int MP = pg8::MP, MS = pg8::MS, MT = pg8::MT, D = 1024, TP = 8192, TS = 32, PAST = 1024, NIN = 8192, FF = 2816, NGU = 2 * FF;
constexpr float LAM0 = 0.2f;
constexpr size_t MiB = 1u << 20;
constexpr size_t ROWB = (size_t)MT * D * 2;
constexpr size_t WS_MOD = 0;
constexpr size_t WS_WIN = 1 * MiB, WS_WAO = 17 * MiB, WS_WCO = 19 * MiB, WS_WOUT = 21 * MiB, WS_WGU = 23 * MiB, WS_WDN = 34 * MiB;
constexpr size_t WS_XN = 40 * MiB;
constexpr size_t WS_O12 = 40 * MiB;
constexpr size_t WS_T = WS_O12;
constexpr size_t WS_Q = WS_O12 + 2 * ROWB, WS_K = WS_Q + ROWB, WS_V = WS_K + ROWB, WS_U = WS_V + ROWB, WS_GB = WS_U + ROWB, WS_END = WS_GB + ROWB;
constexpr size_t WS_ON = WS_Q;
constexpr size_t WS_MX = WS_K;
constexpr size_t WS_X1B = WS_U;
constexpr size_t WS_XN2 = WS_V;
constexpr size_t WS_ACT = 40 * MiB;
static_assert(WS_ACT + (size_t)MT * FF * 2 <= WS_MX && WS_END <= 1024 * MiB, "d_ws map");
constexpr int LDS_BYTES = 147456;
constexpr size_t WS_BAR = 512 * 1024;
constexpr int XBAR_LDS_OFF = 147456 - 64;

#define GAS __attribute__((address_space(1)))
#define LAS __attribute__((address_space(3)))
typedef unsigned short bf16;
typedef unsigned v4u __attribute__((ext_vector_type(4)));
typedef unsigned v2u __attribute__((ext_vector_type(2)));
typedef float f32x4 __attribute__((ext_vector_type(4)));
#define LDS_WAIT() asm volatile("s_waitcnt lgkmcnt(0)" ::: "memory")
__device__ __forceinline__ unsigned f2bf(float f) { unsigned u = __builtin_bit_cast(unsigned, f); return (u + 0x7fffu + ((u >> 16) & 1u)) >> 16; }
__device__ __forceinline__ unsigned pk2(float lo, float hi) { return f2bf(lo) | (f2bf(hi) << 16); }
__device__ __forceinline__ float bflo(unsigned w) { return __uint_as_float(w << 16); }
__device__ __forceinline__ float bfhi(unsigned w) { return __uint_as_float(w & 0xffff0000u); }
__device__ __forceinline__ float bf1(bf16 b) { return __uint_as_float((unsigned)b << 16); }
__device__ __forceinline__ float wave_sum(float v) {
#pragma unroll
    for (int o = 1; o < 64; o <<= 1) v += __shfl_xor(v, o);
    return v;
}
__device__ __forceinline__ float wave_max(float v) {
#pragma unroll
    for (int o = 1; o < 64; o <<= 1) v = fmaxf(v, __shfl_xor(v, o));
    return v;
}

__device__ __forceinline__ void ld16(const bf16* p, float (&d)[16]) { const v4u* q = (const v4u*)p;
#pragma unroll
    for (int e = 0; e < 2; ++e) { const v4u a = q[e]; d[8 * e + 0] = bflo(a.x); d[8 * e + 1] = bfhi(a.x); d[8 * e + 2] = bflo(a.y); d[8 * e + 3] = bfhi(a.y); d[8 * e + 4] = bflo(a.z); d[8 * e + 5] = bfhi(a.z); d[8 * e + 6] = bflo(a.w); d[8 * e + 7] = bfhi(a.w); } }
__device__ __forceinline__ void ldf(const float* p, float (&d)[16]) { const f32x4* q = (const f32x4*)p;
#pragma unroll
    for (int e = 0; e < 4; ++e) { const f32x4 a = q[e]; d[4 * e] = a.x; d[4 * e + 1] = a.y; d[4 * e + 2] = a.z; d[4 * e + 3] = a.w; } }
struct Args {
    const float *x_prompt, *x_sample, *cache_k, *cache_v, *state_conv, *c_prompt, *c_sample, *w_ada, *b_ada, *norm1_g, *norm2_g, *w_in, *q_norm_g, *k_norm_g,
        *lq1, *lk1, *lq2, *lk2, *sub_g, *w_ao, *conv_w, *w_co, *w_out, *w_gu, *w_dn;
    float* out; unsigned char* ws;
};

__device__ __forceinline__ void transpose_item(const float* W, int K, int N, bf16* WT, int kb, int n0, int drow, LAS float* scr, int lane) {
    const int k0 = 64 * kb;
#pragma unroll 8
    for (int i = 0; i < 32; ++i) { const int kk = 2 * i + (lane >> 5); scr[kk * 33 + (lane & 31)] = W[(size_t)(k0 + kk) * N + n0 + (lane & 31)]; }
    LDS_WAIT(); asm volatile("" ::: "memory");
    const int c = lane & 7;
#pragma unroll
    for (int j = 0; j < 4; ++j) { const int n = (lane >> 3) + 8 * j; const LAS float* s = scr + (8 * c) * 33 + n;
        v4u o; o.x = pk2(s[0 * 33], s[1 * 33]); o.y = pk2(s[2 * 33], s[3 * 33]); o.z = pk2(s[4 * 33], s[5 * 33]); o.w = pk2(s[6 * 33], s[7 * 33]);
        *(GAS v4u*)(WT + (size_t)(drow + n) * K + k0 + 8 * c) = o; }
    LDS_WAIT(); asm volatile("" ::: "memory");
}
__device__ __forceinline__ int win_drow(int c0) {
    const int sect = c0 >> 10, cc = c0 & 1023;
    if (sect == 3) return 256 * (12 + (cc >> 7)) + (cc & 127);
    if (sect == 5) return 256 * (12 + (cc >> 7)) + 128 + (cc & 127);
    const int tile = (sect < 3 ? sect * 4 : sect == 4 ? 20 : sect == 6 ? 24 : 28) + (cc >> 8), sl = cc & 255;
    return 256 * tile + 128 * ((sl >> 5) & 1) + 32 * (sl >> 6);
}
__device__ __forceinline__ int wgu_drow(int c0) { const int ch = c0 < FF ? c0 : c0 - FF; return 256 * (ch >> 7) + (c0 < FF ? 0 : 128) + (ch & 127); }

__device__ __forceinline__ void norm_row(const float* xrow, const float* g, const float* shift, const float* scale, bf16* orow, int lane) {
    const GAS f32x4* xr = (const GAS f32x4*)xrow + lane;
    f32x4 v[4]; float s = 0.f;
#pragma unroll
    for (int j = 0; j < 4; ++j) { v[j] = xr[64 * j]; s += (v[j].x * v[j].x + v[j].y * v[j].y) + (v[j].z * v[j].z + v[j].w * v[j].w); }
    const float rstd = __builtin_amdgcn_rsqf(wave_sum(s) * (1.f / D) + pg8::RMS_EPS);
    GAS unsigned long long* o8 = (GAS unsigned long long*)orow + lane;
#pragma unroll
    for (int j = 0; j < 4; ++j) { const int c = 4 * (lane + 64 * j); const f32x4 gg = *(const f32x4*)(g + c), sh = *(const f32x4*)(shift + c), sc = *(const f32x4*)(scale + c);
        const f32x4 o = v[j] * rstd * gg * (sc + 1.0f) + sh;
        o8[64 * j] = (unsigned long long)pk2(o.x, o.y) | ((unsigned long long)pk2(o.z, o.w) << 32); }
}

__device__ __forceinline__ void norm_row_bf(const bf16* xrow, const float* g, const float* shift, const float* scale, bf16* orow, int lane) {
    float v[16]; float s = 0.f;
#pragma unroll
    for (int j = 0; j < 2; ++j) { const v4u w = *(const v4u*)(xrow + 512 * j + 8 * lane);
        v[8 * j + 0] = bflo(w.x); v[8 * j + 1] = bfhi(w.x); v[8 * j + 2] = bflo(w.y); v[8 * j + 3] = bfhi(w.y); v[8 * j + 4] = bflo(w.z); v[8 * j + 5] = bfhi(w.z); v[8 * j + 6] = bflo(w.w); v[8 * j + 7] = bfhi(w.w); }
#pragma unroll
    for (int i = 0; i < 16; ++i) s += v[i] * v[i];
    const float rstd = __builtin_amdgcn_rsqf(wave_sum(s) * (1.f / D) + pg8::RMS_EPS);
#pragma unroll
    for (int j = 0; j < 2; ++j) { const int c = 512 * j + 8 * lane; float o[8];
#pragma unroll
        for (int h = 0; h < 2; ++h) { const f32x4 gg = *(const f32x4*)(g + c + 4 * h), sh = *(const f32x4*)(shift + c + 4 * h), sc = *(const f32x4*)(scale + c + 4 * h);
            o[4 * h + 0] = v[8 * j + 4 * h + 0] * rstd * gg.x * (sc.x + 1.0f) + sh.x; o[4 * h + 1] = v[8 * j + 4 * h + 1] * rstd * gg.y * (sc.y + 1.0f) + sh.y;
            o[4 * h + 2] = v[8 * j + 4 * h + 2] * rstd * gg.z * (sc.z + 1.0f) + sh.z; o[4 * h + 3] = v[8 * j + 4 * h + 3] * rstd * gg.w * (sc.w + 1.0f) + sh.w; }
        v4u w; w.x = pk2(o[0], o[1]); w.y = pk2(o[2], o[3]); w.z = pk2(o[4], o[5]); w.w = pk2(o[6], o[7]); *(v4u*)(orow + c) = w; }
}
typedef short sbf16x8 __attribute__((ext_vector_type(8)));
typedef float sf32x16 __attribute__((ext_vector_type(16)));
__device__ __forceinline__ unsigned cvtpk2(float lo, float hi) { unsigned r; asm("v_cvt_pk_bf16_f32 %0, %1, %2" : "=v"(r) : "v"(lo), "v"(hi)); return r; }
__device__ __forceinline__ sbf16x8 pack_f8(f32x4 a, f32x4 b) { v4u w; w.x = cvtpk2(a.x, a.y); w.y = cvtpk2(a.z, a.w); w.z = cvtpk2(b.x, b.y); w.w = cvtpk2(b.z, b.w); return __builtin_bit_cast(sbf16x8, w); }
__device__ __forceinline__ int crow_(int r, int hi) { return (r & 3) + 8 * (r >> 2) + 4 * hi; }
__device__ __forceinline__ void sample_attn_item(const Args& A, LAS unsigned char* lds, int b, int h, int mm, int tid) {
    constexpr int SP = 1060, NK = PAST + TS;
    const bf16* Q = (const bf16*)(A.ws + WS_Q); const bf16* Kb = (const bf16*)(A.ws + WS_K); const bf16* Vb = (const bf16*)(A.ws + WS_V); bf16* O12 = (bf16*)(A.ws + WS_O12);
    LAS float* S = (LAS float*)lds;
    LAS float* linv = (LAS float*)(lds + 32 * SP * 4);
    const int lane = tid & 63, wave = __builtin_amdgcn_readfirstlane(tid >> 6), r32 = lane & 31, hi = lane >> 5;
    sbf16x8 qr[4];
#pragma unroll
    for (int d0 = 0; d0 < 4; ++d0) qr[d0] = *(const sbf16x8*)(Q + (size_t)(MP + b * TS + r32) * D + (h * 2 + mm) * 64 + d0 * 16 + hi * 8);
    for (int kb = wave; kb < NK / 32; kb += 8) {
        sbf16x8 kf[4];
        if (kb < PAST / 32) { const float* kp = A.cache_k + ((size_t)(b * PAST + kb * 32 + r32) * 8 + h) * 128 + mm * 64 + hi * 8;
#pragma unroll
            for (int d0 = 0; d0 < 4; ++d0) kf[d0] = pack_f8(*(const f32x4*)(kp + d0 * 16), *(const f32x4*)(kp + d0 * 16 + 4)); }
        else { const bf16* kp = Kb + (size_t)(MP + b * TS + r32) * D + (h * 2 + mm) * 64 + hi * 8;
#pragma unroll
            for (int d0 = 0; d0 < 4; ++d0) kf[d0] = *(const sbf16x8*)(kp + d0 * 16); }
        sf32x16 acc = sf32x16{};
#pragma unroll
        for (int d0 = 0; d0 < 4; ++d0) acc = __builtin_amdgcn_mfma_f32_32x32x16_bf16(kf[d0], qr[d0], acc, 0, 0, 0);
#pragma unroll
        for (int r = 0; r < 16; ++r) S[r32 * SP + kb * 32 + crow_(r, hi)] = acc[r];
    }
    __syncthreads();
#pragma unroll 1
    for (int ii = 0; ii < 4; ++ii) { const int i = 4 * wave + ii; LAS float* sr = S + i * SP;
        float mx = -INFINITY; for (int j = lane; j < NK; j += 64) mx = fmaxf(mx, sr[j]);
        mx = wave_max(mx); float sum = 0.f;
        for (int j = lane; j < NK; j += 64) { const float p = __builtin_amdgcn_exp2f(sr[j] - mx); sr[j] = p; sum += p; }
        sum = wave_sum(sum); if (lane == 0) linv[i] = 1.0f / sum; }
    __syncthreads();
    const int db = wave & 3, kh = wave >> 2;
    sf32x16 o = sf32x16{};
    for (int k2 = 33 * kh; k2 < 33 * kh + 33; ++k2) {
        const LAS f32x4* pp = (const LAS f32x4*)(S + r32 * SP + k2 * 16 + hi * 8);
        const sbf16x8 pa = pack_f8(pp[0], pp[1]);
        sbf16x8 vf;
        if (k2 < PAST / 16) { const float* vp = A.cache_v + ((size_t)(b * PAST + k2 * 16 + hi * 8) * 8 + h) * 128 + db * 32 + r32;
            f32x4 v0, v1; v0.x = vp[0]; v0.y = vp[1024]; v0.z = vp[2048]; v0.w = vp[3072]; v1.x = vp[4096]; v1.y = vp[5120]; v1.z = vp[6144]; v1.w = vp[7168];
            vf = pack_f8(v0, v1); }
        else { const bf16* vp = Vb + (size_t)(MP + b * TS + (k2 * 16 - PAST) + hi * 8) * D + h * 128 + db * 32 + r32;
            v4u w; w.x = (unsigned)vp[0] | ((unsigned)vp[1024] << 16); w.y = (unsigned)vp[2048] | ((unsigned)vp[3072] << 16); w.z = (unsigned)vp[4096] | ((unsigned)vp[5120] << 16); w.w = (unsigned)vp[6144] | ((unsigned)vp[7168] << 16);
            vf = __builtin_bit_cast(sbf16x8, w); }
        o = __builtin_amdgcn_mfma_f32_32x32x16_bf16(pa, vf, o, 0, 0, 0);
    }
    __syncthreads();
    LAS float* red = (LAS float*)lds;
    if (kh == 1) {
#pragma unroll
        for (int r = 0; r < 16; ++r) red[(db * 16 + r) * 64 + lane] = o[r]; }
    __syncthreads();
    if (kh == 0) {
#pragma unroll
        for (int r = 0; r < 16; ++r) { const int q = crow_(r, hi); const float v = (o[r] + red[(db * 16 + r) * 64 + lane]) * linv[q];
            O12[(size_t)(MP + b * TS + q) * 2048 + mm * 1024 + h * 128 + db * 32 + r32] = (bf16)f2bf(v); } }
    __syncthreads();
}

typedef float sf32x4 __attribute__((ext_vector_type(4)));
template <class F> __device__ __forceinline__ void small_gemm(const bf16* A, const bf16* Bt, int K, int vcu, int G, LAS unsigned char* lds, int tid, const F& f) {
    const int lane = tid & 63, wave = __builtin_amdgcn_readfirstlane(tid >> 6), fr = lane & 15, fq = lane >> 4, cb = wave & 3, kh = wave >> 2, K2 = K >> 1;
    for (int item = vcu; item < 256; item += G) {
        const int r0 = (item >> 4) * 16, c0 = (item & 15) * 64 + cb * 16;
        const bf16* ap = A + (size_t)(r0 + fr) * K + kh * K2 + fq * 8;
        const bf16* bp = Bt + (size_t)(c0 + fr) * K + kh * K2 + fq * 8;
        sf32x4 acc = {0.f, 0.f, 0.f, 0.f};
#pragma unroll 8
        for (int k = 0; k < K2; k += 32) acc = __builtin_amdgcn_mfma_f32_16x16x32_bf16(*(const sbf16x8*)(bp + k), *(const sbf16x8*)(ap + k), acc, 0, 0, 0);
        LAS sf32x4* red = (LAS sf32x4*)lds;
        if (kh == 1) red[cb * 64 + lane] = acc;
        __syncthreads();
        if (kh == 0) { acc += red[cb * 64 + lane]; f(MP + r0 + fr, c0 + 4 * fq, acc); }
        __syncthreads();
    }
}
__device__ __forceinline__ float sigm_(float x) { return __builtin_amdgcn_rcpf(1.0f + __builtin_amdgcn_exp2f(-1.4426950408889634f * x)); }
struct SmallGate0 { const bf16* G; float* T;
    __device__ __forceinline__ void operator()(int row, int col, sf32x4 acc) const { const size_t o = (size_t)row * 1024 + col; const v2u g = *(const v2u*)(G + o);
        sf32x4 s; s.x = sigm_(bflo(g.x)); s.y = sigm_(bfhi(g.x)); s.z = sigm_(bflo(g.y)); s.w = sigm_(bfhi(g.y)); *(sf32x4*)(T + o) = s * acc; } };
struct SmallGate1 { const bf16* G; const float* T; bf16* Mx;
    __device__ __forceinline__ void operator()(int row, int col, sf32x4 acc) const { const size_t o = (size_t)row * 1024 + col; const v2u g = *(const v2u*)(G + o);
        sf32x4 s; s.x = sigm_(bflo(g.x)); s.y = sigm_(bfhi(g.x)); s.z = sigm_(bflo(g.y)); s.w = sigm_(bfhi(g.y)); const sf32x4 v = *(const sf32x4*)(T + o) + s * acc;
        v2u w; w.x = pk2(v.x, v.y); w.y = pk2(v.z, v.w); *(v2u*)(Mx + o) = w; } };
template <bool FINAL> struct SmallRes { const float* xin; bf16* x1b; float* out; const float* gate;
    __device__ __forceinline__ void operator()(int row, int col, sf32x4 acc) const { const size_t o = (size_t)row * 1024 + col; const int mrow = 8 + ((row - MP) >> 5);
        const sf32x4 g = *(const sf32x4*)(gate + (size_t)mrow * 6144 + col);
        if constexpr (!FINAL) { const sf32x4 v = *(const sf32x4*)(xin + o) + g * acc; v2u w; w.x = pk2(v.x, v.y); w.y = pk2(v.z, v.w); *(v2u*)(x1b + o) = w; }
        else { const v2u w = *(const v2u*)(x1b + o); const sf32x4 b = {bflo(w.x), bfhi(w.x), bflo(w.y), bfhi(w.y)}; *(sf32x4*)(out + o) = b + g * acc; } } };

typedef const __attribute__((address_space(4))) Args* kargs_t;
#define XB_TMO      128
#define XB_XCNT(j)  (256  + 64 * (j))
#define XB_XSUB(j)  (1280 + 64 * (j))
#define XB_XGEN(j)  (2304 + 64 * (j))
#define XB_TOP      3328
#define XB_TOPGEN   3392
#define XCD_BAR_WORDS 3456
#define XB_SPIN_CAP (1u << 22)

__device__ __forceinline__ unsigned xb_ld(unsigned* p)              { return __hip_atomic_load(p, __ATOMIC_RELAXED, __HIP_MEMORY_SCOPE_AGENT); }
__device__ __forceinline__ unsigned xb_add(unsigned* p, unsigned v) { return __hip_atomic_fetch_add(p, v, __ATOMIC_RELAXED, __HIP_MEMORY_SCOPE_AGENT); }
__device__ __forceinline__ unsigned xb_xcc_id() { return (unsigned)__builtin_amdgcn_s_getreg((3 << 11) | 20) & 0xFu; }
#define XB_SPIN(cond, bar) do { unsigned _sp = 0; while (cond) { __builtin_amdgcn_s_sleep(1); \
    if ((++_sp & 255u) == 0u) { if (xb_ld(&(bar)[XB_TMO])) break; if (_sp > XB_SPIN_CAP) { atomicAdd(&(bar)[XB_TMO], 1u); break; } } } } while (0)

struct XcdBarrier {
    unsigned* bar; unsigned x;
    volatile LAS unsigned* st;
};

__device__ __forceinline__ XcdBarrier xcd_barrier_post(unsigned* bar, volatile LAS unsigned* st) {
    XcdBarrier b; b.bar = bar; b.x = xb_xcc_id(); b.st = st;
    if (threadIdx.x == 0) (void)xb_add(&bar[XB_XCNT(b.x)], 1u);
    return b;
}
__device__ __forceinline__ void xcd_barrier_complete(unsigned* bar, unsigned x, unsigned& nloc, unsigned& nx) {
    const unsigned G = gridDim.x * gridDim.y * gridDim.z;
    unsigned sum, cnt, mine, sp = 0u;
    for (;;) {
        sum = 0u; cnt = 0u; mine = 0u;
#pragma unroll
        for (unsigned j = 0; j < 16; ++j) { const unsigned c = xb_ld(&bar[XB_XCNT(j)]); sum += c; cnt += (c > 0u) ? 1u : 0u; mine = (j == x) ? c : mine; }
        if (sum == G) break;
        __builtin_amdgcn_s_sleep(1);
        if ((++sp & 255u) == 0u) { if (xb_ld(&bar[XB_TMO])) break; if (sp > XB_SPIN_CAP) { atomicAdd(&bar[XB_TMO], 1u); break; } }
    }
    nloc = mine > 0u ? mine : 1u; nx = cnt > 0u ? cnt : 1u;
}

__device__ __forceinline__ void xcd_barrier(const XcdBarrier& b) {
    asm volatile("s_waitcnt vmcnt(0)" ::: "memory");
    __syncthreads();
    if (threadIdx.x == 0) {
        unsigned* bar = b.bar;
        __builtin_amdgcn_s_waitcnt(0);
        unsigned nloc = b.st[0], nx = b.st[1];
        if (nloc == 0u) { xcd_barrier_complete(bar, b.x, nloc, nx); b.st[0] = nloc; b.st[1] = nx; }
        const unsigned old = xb_add(&bar[XB_XSUB(b.x)], 1u);
        const unsigned gen = old / nloc;
        if (old + 1u == (gen + 1u) * nloc) {
            __builtin_amdgcn_fence(__ATOMIC_RELEASE, "agent");
            asm volatile("s_waitcnt vmcnt(0)" ::: "memory");
            const unsigned og = xb_add(&bar[XB_TOP], 1u);
            const unsigned tg = og / nx;
            if (og + 1u == (tg + 1u) * nx) xb_add(&bar[XB_TOPGEN], 1u);
            else XB_SPIN(xb_ld(&bar[XB_TOPGEN]) == tg, bar);
            __builtin_amdgcn_fence(__ATOMIC_ACQUIRE, "agent");
            xb_add(&bar[XB_XGEN(b.x)], 1u);
            asm volatile("s_waitcnt vmcnt(0)" ::: "memory");
        } else {
            XB_SPIN(xb_ld(&bar[XB_XGEN(b.x)]) == gen, bar);
            __builtin_amdgcn_fence(__ATOMIC_ACQUIRE, "agent");
            asm volatile("s_waitcnt vmcnt(0)" ::: "memory");
        }
    }
    __syncthreads();
}

#define XBAR() do { XcdBarrier xb_; xb_.bar = (unsigned*)(((const Args*)(kargs_t)__builtin_amdgcn_kernarg_segment_ptr())->ws + WS_BAR); xb_.x = xb_xcc_id(); xb_.st = (volatile LAS unsigned*)((LAS unsigned char*)lds_raw + XBAR_LDS_OFF); xcd_barrier(xb_); } while (0)
#define PHASE_BEGIN() \
    kargs_t ap_ = (kargs_t)__builtin_amdgcn_kernarg_segment_ptr(); asm volatile("" : "+s"(ap_)); const Args& A = *(const Args*)ap_; \
    int tid_ = threadIdx.x; asm volatile("" : "+v"(tid_)); const int tid = tid_, lane = tid & 63, wave = __builtin_amdgcn_readfirstlane(tid >> 6); \
    int G_ = gridDim.x, bx_ = blockIdx.x; asm volatile("" : "+s"(G_), "+s"(bx_)); const int G = G_, bx = bx_, vcu = (G % 8 == 0) ? (bx % 8) * (G / 8) + bx / 8 : bx; \
    const int gw = vcu * NWAVES + wave, NGW = G * NWAVES; unsigned char* const ws = A.ws; float* const mod = (float*)(ws + WS_MOD); \
    LAS unsigned char* const lds = (LAS unsigned char*)lds_raw; (void)lane; (void)gw; (void)NGW; (void)mod; (void)lds; (void)tid; (void)vcu;
__global__ void __launch_bounds__(NWAVES * 64, 2) fwd_megakernel(Args A_unused) {
    extern __shared__ __attribute__((aligned(16))) unsigned char lds_raw[];
    cg::grid_group grid = cg::this_grid();
    { if (threadIdx.x < 2) ((LAS unsigned*)((LAS unsigned char*)lds_raw + XBAR_LDS_OFF))[threadIdx.x] = 0u; __syncthreads();
      (void)xcd_barrier_post((unsigned*)(((const Args*)(kargs_t)__builtin_amdgcn_kernarg_segment_ptr())->ws + WS_BAR), (volatile LAS unsigned*)((LAS unsigned char*)lds_raw + XBAR_LDS_OFF)); }
    {
    PHASE_BEGIN();
    {
        LAS float* cs = (LAS float*)lds;
        LAS float* part = (LAS float*)(lds + 65536);
        bool have_cs = false;
        for (int item = bx; item < 192; item += G) {
            if (!have_cs) { for (int idx = tid; idx < 16384; idx += 512) { const int r = idx >> 10, k = idx & 1023; const float c = r < 8 ? A.c_prompt[r * 1024 + k] : A.c_sample[(r - 8) * 1024 + k]; cs[idx] = c * pg8::sigm(c); } have_cs = true; }
            __syncthreads();
            const int n0 = item * 32, slice = tid >> 5, col = tid & 31; float acc[16];
#pragma unroll
            for (int r = 0; r < 16; ++r) acc[r] = 0.f;
#pragma unroll 4
            for (int kk = 0; kk < 64; ++kk) { const int k = slice * 64 + kk; const float w = A.w_ada[(size_t)k * 6144 + n0 + col];
#pragma unroll
                for (int r = 0; r < 16; ++r) acc[r] += cs[r * 1024 + k] * w; }
#pragma unroll
            for (int r = 0; r < 16; ++r) part[(slice * 16 + r) * 32 + col] = acc[r];
            __syncthreads();
            { const int r = tid >> 5; float s = A.b_ada[n0 + col];
#pragma unroll
                for (int sl = 0; sl < 16; ++sl) s += part[(sl * 16 + r) * 32 + col];
                mod[r * 6144 + n0 + col] = s; }
            __syncthreads();
        }
        __syncthreads();
        LAS float* scr = (LAS float*)(lds + wave * 16384);
        constexpr int I_IN = 16 * 256, I_SQ = 16 * 32, I_GU = 16 * 176, I_DN = 44 * 32, NITEMS = I_IN + 3 * I_SQ + I_GU + I_DN;
        for (int it = gw; it < NITEMS; it += NGW) {
            int r = it;
            if (r < I_IN) { const int kb = r / 256, nb = r % 256; transpose_item(A.w_in, D, NIN, (bf16*)(ws + WS_WIN), kb, 32 * nb, win_drow(32 * nb), scr, lane); continue; } r -= I_IN;
            if (r < I_SQ) { transpose_item(A.w_ao, D, D, (bf16*)(ws + WS_WAO), r / 32, 32 * (r % 32), 32 * (r % 32), scr, lane); continue; } r -= I_SQ;
            if (r < I_SQ) { transpose_item(A.w_co, D, D, (bf16*)(ws + WS_WCO), r / 32, 32 * (r % 32), 32 * (r % 32), scr, lane); continue; } r -= I_SQ;
            if (r < I_SQ) { transpose_item(A.w_out, D, D, (bf16*)(ws + WS_WOUT), r / 32, 32 * (r % 32), 32 * (r % 32), scr, lane); continue; } r -= I_SQ;
            if (r < I_GU) { const int kb = r / 176, nb = r % 176; transpose_item(A.w_gu, D, NGU, (bf16*)(ws + WS_WGU), kb, 32 * nb, wgu_drow(32 * nb), scr, lane); continue; } r -= I_GU;
            transpose_item(A.w_dn, FF, D, (bf16*)(ws + WS_WDN), r / 32, 32 * (r % 32), 32 * (r % 32), scr, lane);
        }
    }
    }
    if (__builtin_expect(((const Args*)(kargs_t)__builtin_amdgcn_kernarg_segment_ptr())->ws == nullptr, 0)) grid.sync();
    XBAR();
    {
    PHASE_BEGIN();
    constexpr int NS1 = NIN / 256;
    if (G > 2 * NS1 && vcu < NS1) {
        for (int m = MP + wave; m < MT; m += NWAVES) { const float* mr = mod + (size_t)(8 + ((m - MP) >> 5)) * 6144;
            norm_row(A.x_sample + (size_t)(m - MP) * D, A.norm1_g, mr, mr + 1024, (bf16*)(ws + WS_XN) + (size_t)m * D, lane); }
        asm volatile("s_waitcnt vmcnt(0)" ::: "memory"); __syncthreads();
        pg8::Gemm g{(const pg8::bf16_t*)(ws + WS_XN), (const pg8::bf16_t*)(ws + WS_WIN), MT, NIN, D}; pg8::SingleOrder S{MP / 256, vcu};
        pg8::EpiInProj E{(pg8::bf16_t*)(ws + WS_Q), (pg8::bf16_t*)(ws + WS_K), (pg8::bf16_t*)(ws + WS_V), (pg8::bf16_t*)(ws + WS_U), (pg8::bf16_t*)(ws + WS_GB),
                         (pg8::bf16_t*)(A.out), (pg8::bf16_t*)(A.out) + (size_t)MT * D, A.out, A.q_norm_g, A.k_norm_g};
        pg8::gemm_phase<pg8::EpiInProj, pg8::SingleOrder, true, true>(lds, g, S, E);
    } else {
        const bool split = G > 2 * NS1; const int w0 = split ? (vcu - NS1) * NWAVES + wave : gw, nw = split ? (G - NS1) * NWAVES : NGW, mend = split ? MP : MT;
        for (int m = w0; m < mend; m += nw) {
            const float* xr = m < MP ? A.x_prompt + (size_t)m * D : A.x_sample + (size_t)(m - MP) * D;
            const float* mr = mod + (size_t)(m < MP ? (m >> 13) : 8 + ((m - MP) >> 5)) * 6144;
            norm_row(xr, A.norm1_g, mr, mr + 1024, (bf16*)(ws + WS_XN) + (size_t)m * D, lane);
        }
    }
    }
    XBAR();
    {
    PHASE_BEGIN();
    {
        pg8::Gemm g{(const pg8::bf16_t*)(ws + WS_XN), (const pg8::bf16_t*)(ws + WS_WIN), MT, NIN, D}; pg8::StaticOrder S; S.init(G > 2 * (NIN / 256) ? MP : MT, NIN, G, bx);
        pg8::EpiInProj E{(pg8::bf16_t*)(ws + WS_Q), (pg8::bf16_t*)(ws + WS_K), (pg8::bf16_t*)(ws + WS_V), (pg8::bf16_t*)(ws + WS_U), (pg8::bf16_t*)(ws + WS_GB),
                         (pg8::bf16_t*)(A.out), (pg8::bf16_t*)(A.out) + (size_t)MT * D, A.out, A.q_norm_g, A.k_norm_g};
        pg8::gemm_phase<pg8::EpiInProj, pg8::StaticOrder, true, true>(lds, g, S, E);
    }
    }
    XBAR();
    {
    PHASE_BEGIN();
    {
        const attn2::bf16* Qp = (const attn2::bf16*)(ws + WS_Q); const attn2::bf16* Kp = (const attn2::bf16*)(ws + WS_K); const attn2::bf16* Vp = (const attn2::bf16*)(ws + WS_V);
        attn2::bf16* Op = (attn2::bf16*)(ws + WS_ON);
        float* o2s = (float*)(ws + WS_O12) + (size_t)vcu * 32768;
        const float mq = wave_max(fabsf(A.q_norm_g[lane])), mk = wave_max(fabsf(A.k_norm_g[lane]));
        const float mshift = __uint_as_float(__builtin_amdgcn_readfirstlane(__float_as_uint(fmaxf(0.f, 64.f * pg8::QK_C2 * mq * mk * 1.02f - 64.f))));
        const float lam = __uint_as_float(__builtin_amdgcn_readfirstlane(__float_as_uint(__expf(wave_sum(A.lq1[lane] * A.lk1[lane])) - __expf(wave_sum(A.lq2[lane] * A.lk2[lane])) + LAM0)));
        const float* subg = A.sub_g;
        float* const kout = A.out + pg8::O_KP; float* const vout = A.out + pg8::O_VP;
        const attn2::bf16* Ucp = (const attn2::bf16*)(ws + WS_U); attn2::bf16* GBcp = (attn2::bf16*)(ws + WS_GB);
#define ATTN_RUN(SH) do { \
        if (G == 256) { const int b = vcu >> 5, lc = vcu & 31, g2 = lc >> 4, s = lc & 15; \
            for (int u = 0; u < 16; ++u) { const int h = 2 * (u >> 2) + g2, mm = 1 - (u & 1), qb = (u & 2) ? 31 - s : s; \
                attn2::attn_unit<SH, 1024>(b, (h * 2 + mm) * 64, h * 128, h * 128, qb, mshift, mm == 0, lam, subg, 1.0f - LAM0, o2s, kout, vout, Ucp, GBcp, A.conv_w, Qp, Kp, Vp, Op, (char*)lds_raw); } \
        } else { \
            for (int it = vcu; it < 8 * 8 * 32; it += G) { const int b = it >> 8, h = (it >> 5) & 7, qb = it & 31; \
                for (int mm = 1; mm >= 0; --mm) \
                    attn2::attn_unit<SH, 1024>(b, (h * 2 + mm) * 64, h * 128, h * 128, qb, mshift, mm == 0, lam, subg, 1.0f - LAM0, o2s, kout, vout, Ucp, GBcp, A.conv_w, Qp, Kp, Vp, Op, (char*)lds_raw); } \
        } } while (0)
        if (mshift == 0.f) ATTN_RUN(false); else ATTN_RUN(true);
#undef ATTN_RUN
        asm volatile("s_waitcnt vmcnt(0) lgkmcnt(0)" ::: "memory"); __syncthreads();
        for (int it = (G - 1 - vcu); it < 128; it += G) sample_attn_item(A, lds, it >> 4, (it >> 1) & 7, it & 1, tid);
    }
    }
    XBAR();
    {
    PHASE_BEGIN();
    {
        float lam;
        { const float p1 = lane < 64 ? A.lq1[lane] * A.lk1[lane] : 0.f, p2 = A.lq2[lane] * A.lk2[lane]; lam = __expf(wave_sum(p1)) - __expf(wave_sum(p2)) + LAM0; }
        const bf16* O12 = (const bf16*)(ws + WS_O12); bf16* ON = (bf16*)(ws + WS_ON); const bf16* U = (const bf16*)(ws + WS_U); bf16* GBp = (bf16*)(ws + WS_GB);
        const int c16 = 16 * lane;
        float sg[16], w0[16], w1[16], w2[16];
#pragma unroll
        for (int i = 0; i < 16; ++i) { sg[i] = A.sub_g[(c16 + i) & 127] * (1.0f - LAM0); w0[i] = A.conv_w[c16 + i]; w1[i] = A.conv_w[1024 + c16 + i]; w2[i] = A.conv_w[2048 + c16 + i]; }
        for (int m = MP + gw; m < MT; m += NGW) {
            if (m >= MP) { const v4u* p1 = (const v4u*)(O12 + (size_t)m * 2048 + c16); const v4u* p2 = (const v4u*)(O12 + (size_t)m * 2048 + 1024 + c16);
              float o[16]; float ss = 0.f;
#pragma unroll
              for (int e = 0; e < 2; ++e) { const v4u a = p1[e], c = p2[e];
                  o[8 * e + 0] = bflo(a.x) - lam * bflo(c.x); o[8 * e + 1] = bfhi(a.x) - lam * bfhi(c.x); o[8 * e + 2] = bflo(a.y) - lam * bflo(c.y); o[8 * e + 3] = bfhi(a.y) - lam * bfhi(c.y);
                  o[8 * e + 4] = bflo(a.z) - lam * bflo(c.z); o[8 * e + 5] = bfhi(a.z) - lam * bfhi(c.z); o[8 * e + 6] = bflo(a.w) - lam * bflo(c.w); o[8 * e + 7] = bfhi(a.w) - lam * bfhi(c.w); }
#pragma unroll
              for (int i = 0; i < 16; ++i) ss += o[i] * o[i];
              ss += __shfl_xor(ss, 1); ss += __shfl_xor(ss, 2); ss += __shfl_xor(ss, 4);
              const float rstd = __builtin_amdgcn_rsqf(ss * (1.0f / 128.0f) + pg8::RMS_EPS);
              v4u w[2];
#pragma unroll
              for (int e = 0; e < 2; ++e) { w[e].x = pk2(o[8 * e + 0] * rstd * sg[8 * e + 0], o[8 * e + 1] * rstd * sg[8 * e + 1]); w[e].y = pk2(o[8 * e + 2] * rstd * sg[8 * e + 2], o[8 * e + 3] * rstd * sg[8 * e + 3]);
                  w[e].z = pk2(o[8 * e + 4] * rstd * sg[8 * e + 4], o[8 * e + 5] * rstd * sg[8 * e + 5]); w[e].w = pk2(o[8 * e + 6] * rstd * sg[8 * e + 6], o[8 * e + 7] * rstd * sg[8 * e + 7]); }
              v4u* po = (v4u*)(ON + (size_t)m * D + c16); po[0] = w[0]; po[1] = w[1]; }
            { const bool smp = m >= MP; const int t = smp ? ((m - MP) & 31) : (m & 8191); const int sb = (m - MP) >> 5;
              float u0[16], u1[16], u2[16], gbv[16];
              ld16(U + (size_t)m * D + c16, u0); ld16(GBp + (size_t)m * D + c16, gbv);
              if (t >= 1) ld16(U + (size_t)(m - 1) * D + c16, u1);
              else if (smp) ldf(A.state_conv + (size_t)(sb * 2 + 1) * 1024 + c16, u1);
              else {
#pragma unroll
                  for (int i = 0; i < 16; ++i) u1[i] = 0.f; }
              if (t >= 2) ld16(U + (size_t)(m - 2) * D + c16, u2);
              else if (smp) ldf(A.state_conv + (size_t)(sb * 2 + t) * 1024 + c16, u2);
              else {
#pragma unroll
                  for (int i = 0; i < 16; ++i) u2[i] = 0.f; }
              v4u w[2]; float z[16];
#pragma unroll
              for (int i = 0; i < 16; ++i) z[i] = gbv[i] * (w0[i] * u2[i] + w1[i] * u1[i] + w2[i] * u0[i]);
#pragma unroll
              for (int e = 0; e < 2; ++e) { w[e].x = pk2(z[8 * e + 0], z[8 * e + 1]); w[e].y = pk2(z[8 * e + 2], z[8 * e + 3]); w[e].z = pk2(z[8 * e + 4], z[8 * e + 5]); w[e].w = pk2(z[8 * e + 6], z[8 * e + 7]); }
              v4u* po = (v4u*)(GBp + (size_t)m * D + c16); po[0] = w[0]; po[1] = w[1]; }
        }
    }
    }
    XBAR();
    {
    PHASE_BEGIN();
    {
        { pg8::PairOrder S; S.base.init(MP, D, G, bx);
          pg8::Gemm g{(const pg8::bf16_t*)(ws + WS_ON), (const pg8::bf16_t*)(ws + WS_WAO), MP, D, D, (const pg8::bf16_t*)(ws + WS_GB), (const pg8::bf16_t*)(ws + WS_WCO)};
          pg8::EpiGatePair E{(const pg8::bf16_t*)(A.out), (const pg8::bf16_t*)(A.out) + (size_t)MT * D, (pg8::bf16_t*)(ws + WS_MX)};
          pg8::gemm_phase<pg8::EpiGatePair, pg8::PairOrder, true, true>(lds, g, S, E); }
        small_gemm((const bf16*)(ws + WS_ON) + (size_t)MP * D, (const bf16*)(ws + WS_WAO), D, vcu, G, lds, tid, SmallGate0{(const bf16*)(A.out), (float*)(ws + WS_T)});
        small_gemm((const bf16*)(ws + WS_GB) + (size_t)MP * D, (const bf16*)(ws + WS_WCO), D, vcu, G, lds, tid, SmallGate1{(const bf16*)(A.out) + (size_t)MT * D, (const float*)(ws + WS_T), (bf16*)(ws + WS_MX)});
    }
    }
    XBAR();
    {
    PHASE_BEGIN();
    {
        pg8::Gemm g{(const pg8::bf16_t*)(ws + WS_MX), (const pg8::bf16_t*)(ws + WS_WOUT), MP, D, D}; pg8::StaticOrder S; S.init(MP, D, G, bx);
        pg8::EpiRes<false> E{A.x_prompt, (pg8::bf16_t*)(ws + WS_X1B), nullptr, mod + 2 * 1024};
        pg8::gemm_phase<pg8::EpiRes<false>, pg8::StaticOrder, true, true>(lds, g, S, E);
        small_gemm((const bf16*)(ws + WS_MX) + (size_t)MP * D, (const bf16*)(ws + WS_WOUT), D, vcu, G, lds, tid, SmallRes<false>{A.x_sample - (size_t)MP * D, (bf16*)(ws + WS_X1B), nullptr, mod + 2 * 1024});
    }
    }
    XBAR();
    {
    PHASE_BEGIN();
    constexpr int NS5 = NGU / 256;
    if (G > 2 * NS5 && vcu < NS5) {
        for (int m = MP + wave; m < MT; m += NWAVES) { const float* mr = mod + (size_t)(8 + ((m - MP) >> 5)) * 6144;
            norm_row_bf(((const bf16*)(ws + WS_X1B)) + (size_t)m * D, A.norm2_g, mr + 3 * 1024, mr + 4 * 1024, (bf16*)(ws + WS_XN2) + (size_t)m * D, lane); }
        asm volatile("s_waitcnt vmcnt(0)" ::: "memory"); __syncthreads();
        pg8::Gemm g{(const pg8::bf16_t*)(ws + WS_XN2), (const pg8::bf16_t*)(ws + WS_WGU), MT, NGU, D}; pg8::SingleOrder S{MP / 256, vcu};
        pg8::EpiSwiglu E{(pg8::bf16_t*)(ws + WS_ACT)};
        pg8::gemm_phase<pg8::EpiSwiglu, pg8::SingleOrder, true, true>(lds, g, S, E);
    } else {
        const bool split = G > 2 * NS5; const int w0 = split ? (vcu - NS5) * NWAVES + wave : gw, nw = split ? (G - NS5) * NWAVES : NGW, mend = split ? MP : MT;
        for (int m = w0; m < mend; m += nw) {
            const float* mr = mod + (size_t)(m < MP ? (m >> 13) : 8 + ((m - MP) >> 5)) * 6144;
            norm_row_bf(((const bf16*)(ws + WS_X1B)) + (size_t)m * D, A.norm2_g, mr + 3 * 1024, mr + 4 * 1024, (bf16*)(ws + WS_XN2) + (size_t)m * D, lane);
        }
    }
    }
    XBAR();
    {
    PHASE_BEGIN();
    {
        pg8::Gemm g{(const pg8::bf16_t*)(ws + WS_XN2), (const pg8::bf16_t*)(ws + WS_WGU), MT, NGU, D}; pg8::StaticOrder S; S.init(G > 2 * (NGU / 256) ? MP : MT, NGU, G, bx);
        pg8::EpiSwiglu E{(pg8::bf16_t*)(ws + WS_ACT)};
        pg8::gemm_phase<pg8::EpiSwiglu, pg8::StaticOrder, true, true>(lds, g, S, E);
    }
    }
    XBAR();
    {
    PHASE_BEGIN();
    {
        pg8::Gemm g{(const pg8::bf16_t*)(ws + WS_ACT), (const pg8::bf16_t*)(ws + WS_WDN), MP, D, FF}; pg8::StaticOrder S; S.init(MP, D, G, bx);
        pg8::EpiRes<true> E{nullptr, (pg8::bf16_t*)(ws + WS_X1B), A.out, mod + 5 * 1024};
        pg8::gemm_phase<pg8::EpiRes<true>, pg8::StaticOrder, true, true>(lds, g, S, E);
        small_gemm((const bf16*)(ws + WS_ACT) + (size_t)MP * FF, (const bf16*)(ws + WS_WDN), FF, vcu, G, lds, tid, SmallRes<true>{nullptr, (bf16*)(ws + WS_X1B), A.out, mod + 5 * 1024});
    }
    }
}

extern "C" void kernel_launch(void* const* d_in, const int* in_sizes, int n_in, void* d_out, int out_size, void* d_ws, size_t ws_size, hipStream_t stream) {
    static int grid = 0;
    if (grid == 0) {
        if (n_in != 25 || (size_t)out_size != pg8::O_END || ws_size < WS_END) { fprintf(stderr, "kernel_launch: unexpected shapes: n_in %d out %d ws %zu\n", n_in, out_size, ws_size); grid = -1; return; }
        int dev = 0, cus = 0, per_cu = 0;
        hipGetDevice(&dev); hipDeviceGetAttribute(&cus, hipDeviceAttributeMultiprocessorCount, dev);
        if (hipFuncSetAttribute((const void*)fwd_megakernel, hipFuncAttributeMaxDynamicSharedMemorySize, LDS_BYTES) != hipSuccess) { fprintf(stderr, "kernel_launch: hipFuncSetAttribute failed\n"); grid = -1; return; }
        if (hipOccupancyMaxActiveBlocksPerMultiprocessor(&per_cu, (const void*)fwd_megakernel, NWAVES * 64, LDS_BYTES) != hipSuccess || per_cu < 1) { fprintf(stderr, "kernel_launch: occupancy query gave %d\n", per_cu); per_cu = 1; }
        (void)hipGetLastError();
        grid = cus * 1;
    }
    if (grid < 0) return;
    Args a{};
    const float** f = (const float**)&a;
    for (int i = 0; i < 25; ++i) f[i] = (const float*)d_in[i];
    a.out = (float*)d_out; a.ws = (unsigned char*)d_ws;
    if (hipMemsetAsync((char*)d_ws + WS_BAR, 0, 16384, stream) != hipSuccess) { fprintf(stderr, "kernel_launch: hipMemsetAsync failed\n"); return; }
    void* args[] = {&a};
    hipError_t e = hipLaunchCooperativeKernel((const void*)fwd_megakernel, dim3(grid), dim3(NWAVES * 64), args, LDS_BYTES, stream);
    if (e != hipSuccess) fprintf(stderr, "cooperative launch failed: %s (grid %d)\n", hipGetErrorString(e), grid);
}
```

```cpp
#include <hip/hip_runtime.h>
#include <cstdio>
#include <cstdint>
namespace pg8 {
#define PG8_LAS __attribute__((address_space(3)))
typedef unsigned short bf16_t;
typedef short bf16x8 __attribute__((ext_vector_type(8)));
typedef float f32x4 __attribute__((ext_vector_type(4)));
typedef unsigned u32x4 __attribute__((ext_vector_type(4)));
constexpr int BM = 256, BK = 64, HALF = 128, HTB = HALF * BK * 2  , STAGE_BYTES = 8 * HTB, NXCD = 8, WGM = 8;

__host__ __device__ __forceinline__ int lds_byte(int r, int c) { const int st = (r >> 4) * 2 + (c >> 5), rr = r & 15, cc = c & 31, ob = rr * 64 + cc * 2; return st * 1024 + (ob ^ (((ob >> 9) & 1) << 5)); }
__host__ __device__ __forceinline__ void stage_rc(int b, int& R, int& C) { const int st = b / 1024, sb = b % 1024, swz = sb ^ (((sb >> 9) & 1) << 5); R = (st >> 1) * 16 + swz / 64; C = (st & 1) * 32 + (swz % 64) / 2; }
__host__ __device__ __forceinline__ int perm32(int rho) { const int n = rho >> 4, i = rho & 15; return 8 * (i >> 2) + 4 * n + (i & 3); }

struct Unit { int pm, pn, seg; };
struct Gemm { const bf16_t* A; const bf16_t* Bt; int M, N, K; const bf16_t* A2; const bf16_t* Bt2; };

struct StaticOrder {
    int nM, nN, nwg, G, c;
    __host__ __device__ void init(int M, int N, int G_, int c_) { nM = M / BM; nN = N / BM; nwg = nM * nN; G = G_; c = c_; }
    __host__ __device__ bool next(int i, Unit& u) const {
        const long L = (long)i * G + c; if (L >= nwg) return false;
        int wgid = (int)L; { const int q = nwg / NXCD, r = nwg % NXCD, xcd = wgid % NXCD, off = wgid / NXCD; wgid = (xcd < r ? xcd * (q + 1) : r * (q + 1) + (xcd - r) * q) + off; }
        const int nig = WGM * nN, gid = wgid / nig, fm = gid * WGM, gsz = (nM - fm) < WGM ? (nM - fm) : WGM;
        u.pm = fm + ((wgid % nig) % gsz); u.pn = (wgid % nig) / gsz; u.seg = 0; return true;
    }
    __device__ __forceinline__ void a_ready(const Unit&) const {}
    __device__ __forceinline__ void done(const Unit&) const {}
};

__device__ __forceinline__ unsigned cvt_pk_bf16(float lo, float hi) { unsigned r; asm volatile("v_cvt_pk_bf16_f32 %0, %1, %2" : "=v"(r) : "v"(lo), "v"(hi)); return r; }
typedef float f32x2 __attribute__((ext_vector_type(2)));
constexpr int MP = 65536, MS = 256, MT = MP + MS;
constexpr size_t O_Y = 0, O_KP = (size_t)MT * 1024, O_VP = O_KP + (size_t)MP * 1024, O_CP = O_VP + (size_t)MP * 1024, O_KS = O_CP + 16384, O_VS = O_KS + (size_t)MS * 1024, O_CS = O_VS + (size_t)MS * 1024, O_END = O_CS + 16384;
constexpr float QK_C2 = 0.125f * 1.4426950408889634f;
constexpr float RMS_EPS = 1e-6f;
__device__ __forceinline__ float bf_lo(unsigned w) { return __uint_as_float(w << 16); }
__device__ __forceinline__ float bf_hi(unsigned w) { return __uint_as_float(w & 0xffff0000u); }
__device__ __forceinline__ float sigm(float x) { return __builtin_amdgcn_rcpf(1.0f + __builtin_amdgcn_exp2f(-1.4426950408889634f * x)); }
__device__ __forceinline__ u32x4 pack8(f32x4 a, f32x4 b) { u32x4 w; w.x = cvt_pk_bf16(a[0], a[1]); w.y = cvt_pk_bf16(a[2], a[3]); w.z = cvt_pk_bf16(b[0], b[1]); w.w = cvt_pk_bf16(b[2], b[3]); return w; }

struct EpiInProj {
    static constexpr bool PERM = true, AFTER_DRAIN = false, PAIRED = false;
    bf16_t *Q, *Kb, *Vb, *U, *GB, *GA2, *GB2; float* out; const float *qg, *kg;
    __device__ __forceinline__ void operator()(const f32x4 (&acc)[2][2][4][2], const Unit& u, int wr, int wc, int fr, int fq) const {
        const int pn = u.pn, pm = u.pm; const bool smp = pm >= (MP / BM);
        const int row0 = pm * BM + wr * 64 + fr;
        if (pn >= 12 && pn < 20) {
            const int col = 128 * (pn - 12) + 32 * wc + 8 * fq;
#pragma unroll
            for (int ai = 0; ai < 2; ++ai)
#pragma unroll
                for (int m = 0; m < 4; ++m) { const int row = row0 + ai * HALF + m * 16;
                    const f32x4 a0 = acc[ai][0][m][0] * acc[ai][1][m][0], a1 = acc[ai][0][m][1] * acc[ai][1][m][1];
                    *(u32x4*)(U + (size_t)row * 1024 + col) = pack8(a0, a1);
                    if (!smp) { const int t = row & 8191; if (t >= 8190) { float* o = out + O_CP + (size_t)((row >> 13) * 2 + (t - 8190)) * 1024 + col; *(f32x4*)o = a0; *(f32x4*)(o + 4) = a1; } }
                    else { const int lr = row - MP, t = lr & 31; if (t >= 30) { float* o = out + O_CS + (size_t)((lr >> 5) * 2 + (t - 30)) * 1024 + col; *(f32x4*)o = a0; *(f32x4*)(o + 4) = a1; } }
                }
            return;
        }
        int sect, tloc; if (pn < 12) { sect = pn >> 2; tloc = pn & 3; } else { sect = 3 + ((pn - 20) >> 2); tloc = (pn - 20) & 3; }
        bf16_t* dst = sect == 0 ? Q : sect == 1 ? Kb : sect == 2 ? Vb : sect == 3 ? GB : sect == 4 ? GA2 : GB2;
        const int col0 = 256 * tloc + 64 * wc + 8 * fq;
        float* fo = nullptr;
        if (sect == 1 && smp) fo = out + O_KS - (size_t)MP * 1024;
        if (sect == 2 && smp) fo = out + O_VS - (size_t)MP * 1024;
        f32x4 g[2][2];
        if (sect < 2) { const float* gp = (sect == 0 ? qg : kg) + 8 * fq; const float sc = sect == 0 ? QK_C2 : 1.0f;
#pragma unroll
            for (int bj = 0; bj < 2; ++bj)
#pragma unroll
                for (int n = 0; n < 2; ++n) g[bj][n] = *(const f32x4*)(gp + 32 * bj + 4 * n) * sc; }
#pragma unroll
        for (int ai = 0; ai < 2; ++ai)
#pragma unroll
            for (int m = 0; m < 4; ++m) { const int row = row0 + ai * HALF + m * 16;
                f32x4 v[2][2];
#pragma unroll
                for (int bj = 0; bj < 2; ++bj)
#pragma unroll
                    for (int n = 0; n < 2; ++n) v[bj][n] = acc[ai][bj][m][n];
                if (sect < 2) { float ss = 0.f;
#pragma unroll
                    for (int bj = 0; bj < 2; ++bj)
#pragma unroll
                        for (int n = 0; n < 2; ++n) { const f32x4 x = v[bj][n]; ss += (x[0] * x[0] + x[1] * x[1]) + (x[2] * x[2] + x[3] * x[3]); }
                    ss += __shfl_xor(ss, 16); ss += __shfl_xor(ss, 32);
                    const float rstd = __builtin_amdgcn_rsqf(ss * (1.0f / 64.0f) + RMS_EPS);
#pragma unroll
                    for (int bj = 0; bj < 2; ++bj)
#pragma unroll
                        for (int n = 0; n < 2; ++n) v[bj][n] = v[bj][n] * rstd * g[bj][n]; }
#pragma unroll
                for (int bj = 0; bj < 2; ++bj) { *(u32x4*)(dst + (size_t)row * 1024 + col0 + 32 * bj) = pack8(v[bj][0], v[bj][1]);
                    if (fo) { float* o = fo + (size_t)row * 1024 + col0 + 32 * bj; *(f32x4*)o = v[bj][0]; *(f32x4*)(o + 4) = v[bj][1]; } }
            }
    }
};
template <int STEP> struct EpiGate {
    static constexpr bool PERM = true, AFTER_DRAIN = false, PAIRED = false;
    const bf16_t* G; float* T; bf16_t* Mx;
    __device__ __forceinline__ void operator()(const f32x4 (&acc)[2][2][4][2], const Unit& u, int wr, int wc, int fr, int fq) const {
        const int row0 = u.pm * BM + wr * 64 + fr, col0 = u.pn * BM + wc * 32 + 8 * fq;
#pragma unroll
        for (int ai = 0; ai < 2; ++ai)
#pragma unroll
            for (int m = 0; m < 4; ++m) { const size_t ro = (size_t)(row0 + ai * HALF + m * 16) * 1024 + col0;
#pragma unroll
                for (int bj = 0; bj < 2; ++bj) { const size_t o = ro + bj * HALF; const u32x4 gw = *(const u32x4*)(G + o);
                    f32x4 s0, s1; s0[0] = sigm(bf_lo(gw.x)); s0[1] = sigm(bf_hi(gw.x)); s0[2] = sigm(bf_lo(gw.y)); s0[3] = sigm(bf_hi(gw.y));
                    s1[0] = sigm(bf_lo(gw.z)); s1[1] = sigm(bf_hi(gw.z)); s1[2] = sigm(bf_lo(gw.w)); s1[3] = sigm(bf_hi(gw.w));
                    f32x4 v0 = s0 * acc[ai][bj][m][0], v1 = s1 * acc[ai][bj][m][1];
                    if (STEP == 0) { *(f32x4*)(T + o) = v0; *(f32x4*)(T + o + 4) = v1; }
                    else { v0 += *(const f32x4*)(T + o); v1 += *(const f32x4*)(T + o + 4); *(u32x4*)(Mx + o) = pack8(v0, v1); } } }
    }
};
template <bool FINAL> struct EpiRes {
    static constexpr bool PERM = true, AFTER_DRAIN = false, PAIRED = false;
    const float* xin; bf16_t* x1b; float* out; const float* gate;
    __device__ __forceinline__ void operator()(const f32x4 (&acc)[2][2][4][2], const Unit& u, int wr, int wc, int fr, int fq) const {
        const int row0 = u.pm * BM + wr * 64 + fr, col0 = u.pn * BM + wc * 32 + 8 * fq;
        const float* gp = gate + (size_t)(u.pm >> 5) * 6144 + col0;
        f32x4 g[2][2];
#pragma unroll
        for (int bj = 0; bj < 2; ++bj) { g[bj][0] = *(const f32x4*)(gp + bj * HALF); g[bj][1] = *(const f32x4*)(gp + bj * HALF + 4); }
#pragma unroll
        for (int ai = 0; ai < 2; ++ai)
#pragma unroll
            for (int m = 0; m < 4; ++m) { const size_t ro = (size_t)(row0 + ai * HALF + m * 16) * 1024 + col0;
#pragma unroll
                for (int bj = 0; bj < 2; ++bj) { const size_t o = ro + bj * HALF;
                    if constexpr (!FINAL) { const f32x4 b0 = *(const f32x4*)(xin + o), b1 = *(const f32x4*)(xin + o + 4);
                        *(u32x4*)(x1b + o) = pack8(b0 + g[bj][0] * acc[ai][bj][m][0], b1 + g[bj][1] * acc[ai][bj][m][1]); }
                    else { const u32x4 w = *(const u32x4*)(x1b + o);
                        const f32x4 b0 = {bf_lo(w.x), bf_hi(w.x), bf_lo(w.y), bf_hi(w.y)}, b1 = {bf_lo(w.z), bf_hi(w.z), bf_lo(w.w), bf_hi(w.w)};
                        *(f32x4*)(out + o) = b0 + g[bj][0] * acc[ai][bj][m][0]; *(f32x4*)(out + o + 4) = b1 + g[bj][1] * acc[ai][bj][m][1]; } } }
    }
};
struct EpiSwiglu {
    static constexpr bool PERM = true, AFTER_DRAIN = false, PAIRED = false;
    bf16_t* ACT;
    __device__ __forceinline__ void operator()(const f32x4 (&acc)[2][2][4][2], const Unit& u, int wr, int wc, int fr, int fq) const {
        const int row0 = u.pm * BM + wr * 64 + fr, col0 = u.pn * HALF + wc * 32 + 8 * fq;
#pragma unroll
        for (int ai = 0; ai < 2; ++ai)
#pragma unroll
            for (int m = 0; m < 4; ++m) { f32x4 r[2];
#pragma unroll
                for (int n = 0; n < 2; ++n) { const f32x4 g = acc[ai][0][m][n], up = acc[ai][1][m][n];
#pragma unroll
                    for (int i = 0; i < 4; ++i) r[n][i] = g[i] * sigm(g[i]) * up[i]; }
                *(u32x4*)(ACT + (size_t)(row0 + ai * HALF + m * 16) * 2816 + col0) = pack8(r[0], r[1]); }
    }
};
struct SingleOrder { int pm, pn;
    __device__ __forceinline__ bool next(int i, Unit& u) const { if (i != 0) return false; u.pm = pm; u.pn = pn; u.seg = 0; return true; }
    __device__ __forceinline__ void a_ready(const Unit&) const {}
    __device__ __forceinline__ void done(const Unit&) const {} };
struct PairOrder { StaticOrder base;
    __device__ __forceinline__ bool next(int i, Unit& u) const { if (!base.next(i >> 1, u)) return false; u.seg = i & 1; return true; }
    __device__ __forceinline__ void a_ready(const Unit&) const {}
    __device__ __forceinline__ void done(const Unit&) const {} };
struct EpiGatePair {
    static constexpr bool PERM = true, AFTER_DRAIN = false, PAIRED = true;
    const bf16_t* GA; const bf16_t* GBr; bf16_t* Mx;
    static __device__ __forceinline__ float em(float x) { return __builtin_amdgcn_exp2f(-1.4426950408889634f * x); }
    __device__ __forceinline__ void mid(f32x4 (&acc)[2][2][4][2], const Unit& u, int wr, int wc, int fr, int fq) const {
        const int row0 = u.pm * BM + wr * 64 + fr, col0 = u.pn * BM + wc * 32 + 8 * fq;
#pragma unroll
        for (int ai = 0; ai < 2; ++ai)
#pragma unroll
            for (int m = 0; m < 4; ++m) { const size_t ro = (size_t)(row0 + ai * HALF + m * 16) * 1024 + col0;
#pragma unroll
                for (int bj = 0; bj < 2; ++bj) { const size_t o = ro + bj * HALF; const u32x4 a = *(const u32x4*)(GA + o), b = *(const u32x4*)(GBr + o);
                    const unsigned aw[4] = {a.x, a.y, a.z, a.w}, bw[4] = {b.x, b.y, b.z, b.w};
#pragma unroll
                    for (int j = 0; j < 4; ++j) { const float r0 = (1.0f + em(fmaxf(bf_lo(bw[j]), -30.f))) * __builtin_amdgcn_rcpf(1.0f + em(bf_lo(aw[j]))), r1 = (1.0f + em(fmaxf(bf_hi(bw[j]), -30.f))) * __builtin_amdgcn_rcpf(1.0f + em(bf_hi(aw[j])));
                        acc[ai][bj][m][j >> 1][2 * (j & 1)] *= r0; acc[ai][bj][m][j >> 1][2 * (j & 1) + 1] *= r1; } } }
    }
    __device__ __forceinline__ void operator()(const f32x4 (&acc)[2][2][4][2], const Unit& u, int wr, int wc, int fr, int fq) const {
        const int row0 = u.pm * BM + wr * 64 + fr, col0 = u.pn * BM + wc * 32 + 8 * fq;
#pragma unroll
        for (int ai = 0; ai < 2; ++ai)
#pragma unroll
            for (int m = 0; m < 4; ++m) { const size_t ro = (size_t)(row0 + ai * HALF + m * 16) * 1024 + col0;
#pragma unroll
                for (int bj = 0; bj < 2; ++bj) { const size_t o = ro + bj * HALF; const u32x4 b = *(const u32x4*)(GBr + o);
                    f32x4 s0, s1; s0[0] = sigm(fmaxf(bf_lo(b.x), -30.f)); s0[1] = sigm(fmaxf(bf_hi(b.x), -30.f)); s0[2] = sigm(fmaxf(bf_lo(b.y), -30.f)); s0[3] = sigm(fmaxf(bf_hi(b.y), -30.f));
                    s1[0] = sigm(fmaxf(bf_lo(b.z), -30.f)); s1[1] = sigm(fmaxf(bf_hi(b.z), -30.f)); s1[2] = sigm(fmaxf(bf_lo(b.w), -30.f)); s1[3] = sigm(fmaxf(bf_hi(b.w), -30.f));
                    *(u32x4*)(Mx + o) = pack8(s0 * acc[ai][bj][m][0], s1 * acc[ai][bj][m][1]); } }
    }
};
template <class Epi, class Sched, bool ALIGN_EPI = false, bool SP2 = false>
__device__ __forceinline__ void gemm_phase(PG8_LAS unsigned char* lds, const Gemm g, const Sched& S, const Epi& E) {
    int tid_ = threadIdx.x; asm volatile("" : "+v"(tid_));
    const int tid = tid_, wid = __builtin_amdgcn_readfirstlane(tid >> 6), lane = tid & 63, wr = wid >> 2, wc = wid & 3, fr = lane & 15, fq = lane >> 4;
    const int K = g.K, nt = K / BK;
    unsigned voffA[2], voffB[2];
#pragma unroll
    for (int i = 0; i < 2; ++i) { int R, C; stage_rc(tid * 16 + i * 8192, R, C); const int Rb = Epi::PERM ? ((R & ~31) + perm32(R & 31)) : R;
        voffA[i] = (unsigned)(R * K + C) * 2u; voffB[i] = (unsigned)(Rb * K + C) * 2u; }
    const size_t kstep = (size_t)(BK * 2);
    const size_t hstep = (size_t)HALF * K * 2;
    const size_t tstep = 2 * hstep;
    const unsigned ldsw = (unsigned)wid * 1024u;
    const int aoff = lds_byte(wr * 64 + fr, fq * 8), boff = lds_byte(wc * 32 + fr, fq * 8);
#define PG8_SA(b, h) (((b) * 2 + (h)) * HTB)
#define PG8_SB(b, h) ((4 + (b) * 2 + (h)) * HTB)
#define PG8_STAGE(bufoff, gbase, voff) do { _Pragma("unroll") for (int _i = 0; _i < 2; ++_i) \
        __builtin_amdgcn_global_load_lds((const unsigned*)((const char*)(gbase) + (voff)[_i]), (PG8_LAS unsigned*)(lds + (bufoff) + ldsw + _i * 8192), 16, 0, 0); } while (0)
#define PG8_LDA(dst, b, h) do { _Pragma("unroll") for (int m = 0; m < 4; ++m) _Pragma("unroll") for (int k = 0; k < 2; ++k) dst[m][k] = *(const PG8_LAS bf16x8*)(lds + PG8_SA(b, h) + aoff + m * 2048 + k * 1024); } while (0)
#define PG8_LDB(dst, b, h) do { _Pragma("unroll") for (int n = 0; n < 2; ++n) _Pragma("unroll") for (int k = 0; k < 2; ++k) dst[n][k] = *(const PG8_LAS bf16x8*)(lds + PG8_SB(b, h) + boff + n * 2048 + k * 1024); } while (0)
#define PG8_MMA(ai, bj, At, Bt) do { __builtin_amdgcn_s_setprio(1); _Pragma("unroll") for (int m = 0; m < 4; ++m) _Pragma("unroll") for (int n = 0; n < 2; ++n) _Pragma("unroll") for (int k = 0; k < 2; ++k) \
        acc[ai][bj][m][n] = __builtin_amdgcn_mfma_f32_16x16x32_bf16(Bt[n][k], At[m][k], acc[ai][bj][m][n], 0, 0, 0); __builtin_amdgcn_s_setprio(0); } while (0)
#define PG8_WAIT_V(n) asm volatile("s_waitcnt vmcnt(" #n ")" ::: "memory")
#define PG8_WAIT_L(n) asm volatile("s_waitcnt lgkmcnt(" #n ")" ::: "memory")
#define PG8_BAR __builtin_amdgcn_s_barrier()
#define PG8_SCHED __builtin_amdgcn_sched_barrier(0)
    Unit cur, nxt; int ui = 0;
    if (!S.next(0, cur)) return;
    f32x4 acc[2][2][4][2];
#pragma unroll
    for (int a = 0; a < 2; ++a)
#pragma unroll
        for (int b = 0; b < 2; ++b)
#pragma unroll
            for (int m = 0; m < 4; ++m)
#pragma unroll
                for (int n = 0; n < 2; ++n) acc[a][b][m][n] = (f32x4){0.f, 0.f, 0.f, 0.f};
    bf16x8 At[4][2], B0[2][2], B1[2][2];
#define PG8_ABASE(u) ((const char*)((u).seg ? g.A2 : g.A) + (size_t)(u).pm * tstep)
#define PG8_BBASE(u) ((const char*)((u).seg ? g.Bt2 : g.Bt) + (size_t)(u).pn * tstep)
    const char* cA = PG8_ABASE(cur); const char* cB = PG8_BBASE(cur);
    S.a_ready(cur);
    if constexpr (SP2) {
        PG8_STAGE(PG8_SB(0, 0), cB, voffB); PG8_STAGE(PG8_SB(0, 1), cB + hstep, voffB); PG8_STAGE(PG8_SA(0, 0), cA, voffA); PG8_STAGE(PG8_SA(0, 1), cA + hstep, voffA);
        if (wr == 1) PG8_BAR;
        PG8_WAIT_V(2); PG8_BAR;
        PG8_STAGE(PG8_SB(1, 0), cB + kstep, voffB); PG8_STAGE(PG8_SA(1, 0), cA + kstep, voffA); PG8_STAGE(PG8_SB(1, 1), cB + hstep + kstep, voffB);
        PG8_WAIT_V(6); PG8_BAR;
    } else {
        PG8_STAGE(PG8_SB(0, 0), cB, voffB); PG8_STAGE(PG8_SA(0, 0), cA, voffA); PG8_STAGE(PG8_SB(0, 1), cB + hstep, voffB); PG8_STAGE(PG8_SA(0, 1), cA + hstep, voffA);
        if (wr == 1) PG8_BAR;
        PG8_WAIT_V(4); PG8_BAR;
        PG8_STAGE(PG8_SB(1, 0), cB + kstep, voffB); PG8_STAGE(PG8_SA(1, 0), cA + kstep, voffA); PG8_STAGE(PG8_SB(1, 1), cB + hstep + kstep, voffB);
        PG8_WAIT_V(6); PG8_BAR;
    }
    for (;;) {
        const bool has_next = S.next(ui + 1, nxt);
        const char* nA = has_next ? PG8_ABASE(nxt) : cA; const char* nB = has_next ? PG8_BBASE(nxt) : cB;
        for (int t = 0; t < nt; t += 2) {
            const bool last = (t == nt - 2);
            const char* a1 = cA + (size_t)(t + 1) * kstep;
            const char* a2 = last ? nA : cA + (size_t)(t + 2) * kstep; const char* b2 = last ? nB : cB + (size_t)(t + 2) * kstep;
            const char* a3 = a2 + kstep; const char* b3 = b2 + kstep;
            if (last && has_next) S.a_ready(nxt);
            if constexpr (SP2) {
            PG8_LDB(B0, 0, 0); PG8_LDB(B1, 0, 1); PG8_SCHED; PG8_LDA(At, 0, 0); PG8_STAGE(PG8_SA(1, 1), a1 + hstep, voffA);
            PG8_WAIT_V(8); PG8_WAIT_L(0); PG8_BAR; PG8_MMA(0, 0, At, B0); PG8_MMA(0, 1, At, B1); PG8_BAR; PG8_SCHED;
            PG8_LDA(At, 0, 1); PG8_STAGE(PG8_SB(0, 0), b2, voffB); PG8_STAGE(PG8_SB(0, 1), b2 + hstep, voffB); PG8_STAGE(PG8_SA(0, 0), a2, voffA);
            PG8_WAIT_V(8); PG8_WAIT_L(0); PG8_BAR; PG8_MMA(1, 0, At, B0); PG8_MMA(1, 1, At, B1); PG8_BAR; PG8_SCHED;
            PG8_LDB(B0, 1, 0); PG8_LDB(B1, 1, 1); PG8_SCHED; PG8_LDA(At, 1, 0); PG8_STAGE(PG8_SA(0, 1), a2 + hstep, voffA);
            PG8_WAIT_V(8); PG8_WAIT_L(0); PG8_BAR; PG8_MMA(0, 0, At, B0); PG8_MMA(0, 1, At, B1); PG8_BAR; PG8_SCHED;
            PG8_LDA(At, 1, 1); PG8_STAGE(PG8_SB(1, 0), b3, voffB); PG8_STAGE(PG8_SB(1, 1), b3 + hstep, voffB); PG8_STAGE(PG8_SA(1, 0), a3, voffA);
            PG8_WAIT_V(8); PG8_WAIT_L(0); PG8_BAR; PG8_MMA(1, 0, At, B0); PG8_MMA(1, 1, At, B1); PG8_BAR; PG8_SCHED;
            } else {
            PG8_LDB(B0, 0, 0); PG8_SCHED; PG8_LDA(At, 0, 0); PG8_STAGE(PG8_SA(1, 1), a1 + hstep, voffA);
            PG8_WAIT_L(8); PG8_BAR; PG8_WAIT_L(0); PG8_MMA(0, 0, At, B0); PG8_BAR; PG8_SCHED;
            PG8_LDB(B1, 0, 1); PG8_STAGE(PG8_SB(0, 0), b2, voffB);
            PG8_BAR; PG8_WAIT_L(0); PG8_MMA(0, 1, At, B1); PG8_BAR;
            PG8_LDA(At, 0, 1); PG8_STAGE(PG8_SA(0, 0), a2, voffA);
            PG8_BAR; PG8_WAIT_L(0); PG8_MMA(1, 0, At, B0); PG8_BAR; PG8_SCHED;
            PG8_STAGE(PG8_SB(0, 1), b2 + hstep, voffB);
            PG8_WAIT_V(6); PG8_BAR; PG8_MMA(1, 1, At, B1); PG8_BAR;
            PG8_LDB(B0, 1, 0); PG8_SCHED; PG8_LDA(At, 1, 0); PG8_STAGE(PG8_SA(0, 1), a2 + hstep, voffA);
            PG8_WAIT_L(8); PG8_BAR; PG8_WAIT_L(0); PG8_MMA(0, 0, At, B0); PG8_BAR; PG8_SCHED;
            PG8_LDB(B1, 1, 1); PG8_STAGE(PG8_SB(1, 0), b3, voffB);
            PG8_BAR; PG8_WAIT_L(0); PG8_MMA(0, 1, At, B1); PG8_BAR;
            PG8_LDA(At, 1, 1); PG8_STAGE(PG8_SA(1, 0), a3, voffA);
            PG8_BAR; PG8_WAIT_L(0); PG8_MMA(1, 0, At, B0); PG8_BAR; PG8_SCHED;
            PG8_STAGE(PG8_SB(1, 1), b3 + hstep, voffB);
            PG8_WAIT_V(6); PG8_BAR; PG8_MMA(1, 1, At, B1); PG8_BAR;
            }
        }
        if constexpr (ALIGN_EPI) { if (wr == 0) PG8_BAR; }
        bool keep_acc = false;
        if constexpr (Epi::PAIRED) { if (cur.seg == 0) { E.mid(acc, cur, wr, wc, fr, fq); keep_acc = true; } else E(acc, cur, wr, wc, fr, fq); S.done(cur); }
        else if constexpr (!Epi::AFTER_DRAIN) { E(acc, cur, wr, wc, fr, fq); S.done(cur); }
        if (!has_next) break;
        if (!keep_acc)
#pragma unroll
        for (int a = 0; a < 2; ++a)
#pragma unroll
            for (int b = 0; b < 2; ++b)
#pragma unroll
                for (int m = 0; m < 4; ++m)
#pragma unroll
                    for (int n = 0; n < 2; ++n) acc[a][b][m][n] = (f32x4){0.f, 0.f, 0.f, 0.f};
        cur = nxt; cA = nA; cB = nB; ++ui;
        if constexpr (ALIGN_EPI) { if (wr == 1) PG8_BAR; }
    }
    PG8_WAIT_V(0);
    if constexpr (!ALIGN_EPI) { if (wr == 0) PG8_BAR; }
    PG8_BAR;
    if constexpr (Epi::AFTER_DRAIN) { E.fused(acc, cur, wr, wc, fr, fq, lds, wid, lane); S.done(cur); }
#undef PG8_ABASE
#undef PG8_BBASE
#undef PG8_SA
#undef PG8_SB
#undef PG8_STAGE
#undef PG8_LDA
#undef PG8_LDB
#undef PG8_MMA
#undef PG8_WAIT_V
#undef PG8_WAIT_L
#undef PG8_BAR
#undef PG8_SCHED
}
}
#include <hip/hip_bf16.h>
#include <cmath>
namespace attn2 {
using bf16=__hip_bfloat16;
using bf16x8=__attribute__((ext_vector_type(8)))short;
using s16x4=__attribute__((ext_vector_type(4)))short;
using f32x16=__attribute__((ext_vector_type(16)))float;
using u32x4=__attribute__((ext_vector_type(4)))unsigned;
constexpr int SEQ=8192,DM=1024;
constexpr int NW=8,QBLK=32,QB=QBLK*NW,KVBLK=64;
__device__ __forceinline__ int crow(int r,int hi){return (r&3)+8*(r>>2)+4*hi;}
#define SBAR() __builtin_amdgcn_sched_barrier(0)
constexpr int NSLOT=3, SLOTB=8192;
constexpr int LDS_K=0, LDS_V=NSLOT*SLOTB, LDS_WS=LDS_V+2*NSLOT*SLOTB, LDS_OST=LDS_WS+NW*64*4, LDS_BYTES=LDS_OST+NW*4096;
__device__ __forceinline__ void glds16(const void*gsrc,unsigned lds_dst){unsigned keep;
  asm volatile("s_mov_b32 %0, m0\n\ts_mov_b32 m0, %2\n\ts_nop 0\n\tglobal_load_lds_dwordx4 %1, off\n\ts_mov_b32 m0, %0":"=&s"(keep):"v"(gsrc),"s"(lds_dst):"memory");}
typedef float f32x2_t __attribute__((ext_vector_type(2))); typedef __bf16 bf16x2_t __attribute__((ext_vector_type(2)));
__device__ __forceinline__ unsigned cvtpk_s(float lo,float hi){f32x2_t v={lo,hi};bf16x2_t b=__builtin_convertvector(v,bf16x2_t);return __builtin_bit_cast(unsigned,b);}
#define WAIT_BAR(N) asm volatile("s_waitcnt vmcnt(" #N ") lgkmcnt(0)\n\ts_barrier":::"memory")
typedef __attribute__((address_space(3))) const char* lds_cptr;
typedef short v4i16_t __attribute__((ext_vector_type(4)));
__device__ __forceinline__ void qkt0(f32x16&p0,f32x16&p1,const char*Kslot,const bf16x8*qr,int r32,int hi){
  const char*kb=Kslot+hi*1024+r32*16; const f32x16 z=f32x16{};
  #pragma unroll
  for(int d0=0;d0<4;++d0){
    const bf16x8 b0=*reinterpret_cast<const bf16x8*>(kb+d0*2048);
    const bf16x8 b1=*reinterpret_cast<const bf16x8*>(kb+d0*2048+512);
    if(d0==0){p0=__builtin_amdgcn_mfma_f32_32x32x16_bf16(b0,qr[0],z,0,0,0);p1=__builtin_amdgcn_mfma_f32_32x32x16_bf16(b1,qr[0],z,0,0,0);}
    else{p0=__builtin_amdgcn_mfma_f32_32x32x16_bf16(b0,qr[d0],p0,0,0,0);p1=__builtin_amdgcn_mfma_f32_32x32x16_bf16(b1,qr[d0],p1,0,0,0);}}
}
__device__ __forceinline__ void kload8(bf16x8*kf,lds_cptr kp){
  kf[0]=*(const __attribute__((address_space(3))) bf16x8*)(kp);      kf[1]=*(const __attribute__((address_space(3))) bf16x8*)(kp+512);
  kf[2]=*(const __attribute__((address_space(3))) bf16x8*)(kp+2048); kf[3]=*(const __attribute__((address_space(3))) bf16x8*)(kp+2560);
  kf[4]=*(const __attribute__((address_space(3))) bf16x8*)(kp+4096); kf[5]=*(const __attribute__((address_space(3))) bf16x8*)(kp+4608);
  kf[6]=*(const __attribute__((address_space(3))) bf16x8*)(kp+6144); kf[7]=*(const __attribute__((address_space(3))) bf16x8*)(kp+6656);
}
__device__ __forceinline__ void kload2(bf16x8*kf,lds_cptr kp,int j){ kf[2*j]=*(const __attribute__((address_space(3))) bf16x8*)(kp+j*2048); kf[2*j+1]=*(const __attribute__((address_space(3))) bf16x8*)(kp+j*2048+512); }
__device__ __forceinline__ s16x4 vtr(lds_cptr p){ return __builtin_bit_cast(s16x4,__builtin_amdgcn_ds_read_tr16_b64_v4i16((__attribute__((address_space(3))) v4i16_t*)p)); }
__device__ __forceinline__ void pv4(f32x16*o,int vb,bf16x8 pa0,bf16x8 pa1,bf16x8 pa2,bf16x8 pa3){
  #pragma unroll
  for(int d0=0;d0<4;++d0){s16x4 lo[4],hi[4];
    #pragma unroll
    for(int ks=0;ks<4;++ks){
      asm volatile("ds_read_b64_tr_b16 %0,%1 offset:%c2":"=&v"(lo[ks]):"v"(vb),"i"(d0*4096+ks*1024):"memory");
      asm volatile("ds_read_b64_tr_b16 %0,%1 offset:%c2":"=&v"(hi[ks]):"v"(vb),"i"(d0*4096+ks*1024+512):"memory");}
    asm volatile("s_waitcnt lgkmcnt(0)":::"memory");SBAR();
    #define PK(k) (bf16x8){lo[k][0],lo[k][1],lo[k][2],lo[k][3],hi[k][0],hi[k][1],hi[k][2],hi[k][3]}
    o[d0]=__builtin_amdgcn_mfma_f32_32x32x16_bf16(pa0,PK(0),o[d0],0,0,0);
    o[d0]=__builtin_amdgcn_mfma_f32_32x32x16_bf16(pa1,PK(1),o[d0],0,0,0);
    o[d0]=__builtin_amdgcn_mfma_f32_32x32x16_bf16(pa2,PK(2),o[d0],0,0,0);
    o[d0]=__builtin_amdgcn_mfma_f32_32x32x16_bf16(pa3,PK(3),o[d0],0,0,0);
    #undef PK
  }
}
#ifndef ATTN_STORE16
#define ATTN_STORE16(p,v) (*(u32x4*)(p)=(v))
#endif
template<bool SHIFT,int OP> __device__ __forceinline__ void attn_unit(int b,int qcol,int vcol,int ocol,int qb,float mshift,int mode,float lam,const float*subg,float gmul,float*o2s,float*kout,float*vout,const bf16*Uc,bf16*GBc,const float*convw,const bf16*Q,const bf16*__restrict__ K,const bf16*__restrict__ V,bf16*O,char*shm){
  int tid_=threadIdx.x; asm volatile("":"+v"(tid_)); const int tid=tid_,lane=tid&63,r32=lane&31,hi=lane>>5; const int wid=__builtin_amdgcn_readfirstlane(tid>>6);
  const long rowbase=(long)b*SEQ; const int q0=qb*QB;
  const bf16*Qw=Q+(rowbase+q0+wid*QBLK)*DM+qcol;
  const bf16*Kh=K+rowbase*DM+qcol,*Vh=V+rowbase*DM+vcol;
  const unsigned lds0=(unsigned)(uintptr_t)shm;
  float*wsf=(float*)(shm+LDS_WS)+wid*64;
  const bf16*ksrc=Kh+(long)lane*DM+wid*8;
  const bf16*vsrc=Vh+(long)(16*(wid&3)+(lane>>2))*DM+(wid>>2)*32+(lane&3)*8;
  const unsigned kdst=lds0+LDS_K+wid*1024, vdst=lds0+LDS_V+wid*1024;
  #define DMA_K(t,slot) glds16(ksrc+(long)(t)*KVBLK*DM,(unsigned)__builtin_amdgcn_readfirstlane(kdst+(slot)))
  #define DMA_V(t,slot) do{ glds16(vsrc+(long)(t)*KVBLK*DM,(unsigned)__builtin_amdgcn_readfirstlane(vdst+2*(slot))); glds16(vsrc+(long)(t)*KVBLK*DM+64,(unsigned)__builtin_amdgcn_readfirstlane(vdst+2*(slot)+8192)); }while(0)
  const int vb0=(int)(lds0+LDS_V)+((lane>>4)&1)*32+(lane&3)*8+(4*hi+((lane&15)>>2))*64;
  const char*Kbase=shm+LDS_K; bf16x8 kf[8];
  const lds_cptr shm3=(lds_cptr)shm; const lds_cptr kp0=shm3+LDS_K+hi*1024+r32*16; const lds_cptr vp0=shm3+LDS_V+((lane>>4)&1)*32+(lane&3)*8+(4*hi+((lane&15)>>2))*64;
  const int NT=(q0+QB)/KVBLK;
  DMA_K(0,0);DMA_V(0,0);DMA_K(1,SLOTB);
  bf16x8 qr[4];
  #pragma unroll
  for(int d0=0;d0<4;++d0)qr[d0]=*reinterpret_cast<const bf16x8*>(&Qw[(long)r32*DM+d0*16+hi*8]);
  float l_reg=0.f;f32x16 o[4];o[0]=f32x16{};o[1]=f32x16{};o[2]=f32x16{};o[3]=f32x16{};
  const int chunkw=wid>>1;
  #define CMASK_BAND(P0,P1,t) do{int jb_=(t)-(NT-4); if(jb_>chunkw){ asm volatile("":::"memory"); _Pragma("unroll") for(int r=0;r<16;++r){P0[r]=-INFINITY;P1[r]=-INFINITY;} } }while(0)
  #define CMASK(P0,P1,t) CMASK_BAND(P0,P1,t)
  #define EX(v) __builtin_amdgcn_exp2f(v)
  #define EXS(v) (SHIFT?EX((v)-mshift):EX(v))
  f32x16 pA0,pA1,pB0,pB1;
  int sl_prev=0,sl_cur=0,sl_next=SLOTB;
  #define ROT() do{sl_prev=sl_cur;sl_cur=sl_next;sl_next=(sl_next==(NSLOT-1)*SLOTB)?0:sl_next+SLOTB;}while(0)
  DMA_K(2,2*SLOTB);
  WAIT_BAR(4);
  qkt0(pA0,pA1,Kbase,qr,r32,hi);CMASK(pA0,pA1,0);
  _Pragma("unroll") for(int r=0;r<16;++r){pA0[r]=EXS(pA0[r]);pA1[r]=EXS(pA1[r]);}
  WAIT_BAR(0);
  DMA_K(3,0);DMA_V(1,SLOTB);
  ROT();
  kload8(kf,kp0+sl_cur);
  WAIT_BAR(3);
  s16x4 vlo[8],vhi[8]; u32x4 pw0,pw1,pw2,pw3;
  #define PKW(P,B) cvtpk_s(P[B],P[B+1])
  #define PAF(k) __builtin_bit_cast(bf16x8,pw##k)
  #define VFR(i) (bf16x8){vlo[i][0],vlo[i][1],vlo[i][2],vlo[i][3],vhi[i][0],vhi[i][1],vhi[i][2],vhi[i][3]}
  #define PIN(x) asm volatile("":"+v"(x))
  #define GAPA(MF,A0,A1,A2,A3,W0,W1,PW) do{ MF; sacc+=A0; sacc+=A1; sacc+=A2; sacc+=A3; PIN(sacc); W0; W1; PIN(PW); SBAR(); }while(0)
  #define GAPB(MF,X,B) do{ MF; X[B]=EXS(X[B]); X[B+1]=EXS(X[B+1]); PIN(X); SBAR(); }while(0)
  #define VRD(i,db) do{ vlo[i]=vtr(vp_+((db)*4096+((i)&3)*1024)); vhi[i]=vtr(vp_+((db)*4096+((i)&3)*1024+512)); }while(0)
  #define KRD(G,j) do{ if(G){ kload2(kf,kp0+sl_next,j); SBAR(); } }while(0)
  #define STEP(C0,C1,P0,P1,t,GK,GV,GL) do{ SBAR(); \
    const lds_cptr vp_=vp0+2*sl_prev; const f32x16 z_=f32x16{}; \
    VRD(0,0); SBAR(); float sacc=(P0[0]+P0[1]); \
    GAPA(C0=__builtin_amdgcn_mfma_f32_32x32x16_bf16(kf[0],qr[0],z_,0,0,0), P0[2],P0[3],P0[4],P0[5],     pw0[0]=PKW(P0,0), pw0[1]=PKW(P0,2), pw0); \
    VRD(4,1); SBAR(); GAPA(C1=__builtin_amdgcn_mfma_f32_32x32x16_bf16(kf[1],qr[0],z_,0,0,0), P0[6],P0[7],P0[8],P0[9],     pw0[2]=PKW(P0,4), pw0[3]=PKW(P0,6), pw0); \
    VRD(1,0); SBAR(); GAPA(C0=__builtin_amdgcn_mfma_f32_32x32x16_bf16(kf[2],qr[1],C0,0,0,0),   P0[10],P0[11],P0[12],P0[13], pw1[0]=PKW(P0,8), pw1[1]=PKW(P0,10), pw1); \
    VRD(5,1); SBAR(); GAPA(C1=__builtin_amdgcn_mfma_f32_32x32x16_bf16(kf[3],qr[1],C1,0,0,0),   P0[14],P0[15],P1[0],P1[1],   pw1[2]=PKW(P0,12),pw1[3]=PKW(P0,14), pw1); \
    VRD(2,0); SBAR(); GAPA(C0=__builtin_amdgcn_mfma_f32_32x32x16_bf16(kf[4],qr[2],C0,0,0,0),   P1[2],P1[3],P1[4],P1[5],     pw2[0]=PKW(P1,0), pw2[1]=PKW(P1,2), pw2); \
    VRD(6,1); SBAR(); GAPA(C1=__builtin_amdgcn_mfma_f32_32x32x16_bf16(kf[5],qr[2],C1,0,0,0),   P1[6],P1[7],P1[8],P1[9],     pw2[2]=PKW(P1,4), pw2[3]=PKW(P1,6), pw2); \
    VRD(3,0); SBAR(); GAPA(C0=__builtin_amdgcn_mfma_f32_32x32x16_bf16(kf[6],qr[3],C0,0,0,0),   P1[10],P1[11],P1[12],P1[13], pw3[0]=PKW(P1,8), pw3[1]=PKW(P1,10), pw3); \
    VRD(7,1); SBAR(); GAPA(C1=__builtin_amdgcn_mfma_f32_32x32x16_bf16(kf[7],qr[3],C1,0,0,0),   P1[14],P1[15],0.f,0.f,       pw3[2]=PKW(P1,12),pw3[3]=PKW(P1,14), pw3); \
    l_reg+=sacc; \
    if(GK){DMA_K((t)+3,sl_cur);} if(GV){DMA_V((t)+1,sl_next);} \
    CMASK(C0,C1,t); \
    SBAR(); \
    GAPB(o[0]=__builtin_amdgcn_mfma_f32_32x32x16_bf16(PAF(0),VFR(0),o[0],0,0,0), C0,0);  VRD(0,2); SBAR(); \
    GAPB(o[1]=__builtin_amdgcn_mfma_f32_32x32x16_bf16(PAF(0),VFR(4),o[1],0,0,0), C0,2);  VRD(4,3); SBAR(); \
    KRD(GL,0); GAPB(o[0]=__builtin_amdgcn_mfma_f32_32x32x16_bf16(PAF(1),VFR(1),o[0],0,0,0), C0,4);  VRD(1,2); SBAR(); \
    KRD(GL,1); GAPB(o[1]=__builtin_amdgcn_mfma_f32_32x32x16_bf16(PAF(1),VFR(5),o[1],0,0,0), C0,6);  VRD(5,3); SBAR(); \
    KRD(GL,2); GAPB(o[0]=__builtin_amdgcn_mfma_f32_32x32x16_bf16(PAF(2),VFR(2),o[0],0,0,0), C0,8);  VRD(2,2); SBAR(); \
    KRD(GL,3); GAPB(o[1]=__builtin_amdgcn_mfma_f32_32x32x16_bf16(PAF(2),VFR(6),o[1],0,0,0), C0,10); VRD(6,3); SBAR(); \
    GAPB(o[0]=__builtin_amdgcn_mfma_f32_32x32x16_bf16(PAF(3),VFR(3),o[0],0,0,0), C0,12); VRD(3,2); SBAR(); \
    GAPB(o[1]=__builtin_amdgcn_mfma_f32_32x32x16_bf16(PAF(3),VFR(7),o[1],0,0,0), C0,14); VRD(7,3); SBAR(); \
    GAPB(o[2]=__builtin_amdgcn_mfma_f32_32x32x16_bf16(PAF(0),VFR(0),o[2],0,0,0), C1,0); \
    GAPB(o[3]=__builtin_amdgcn_mfma_f32_32x32x16_bf16(PAF(0),VFR(4),o[3],0,0,0), C1,2); \
    GAPB(o[2]=__builtin_amdgcn_mfma_f32_32x32x16_bf16(PAF(1),VFR(1),o[2],0,0,0), C1,4); \
    GAPB(o[3]=__builtin_amdgcn_mfma_f32_32x32x16_bf16(PAF(1),VFR(5),o[3],0,0,0), C1,6); \
    GAPB(o[2]=__builtin_amdgcn_mfma_f32_32x32x16_bf16(PAF(2),VFR(2),o[2],0,0,0), C1,8); \
    GAPB(o[3]=__builtin_amdgcn_mfma_f32_32x32x16_bf16(PAF(2),VFR(6),o[3],0,0,0), C1,10); \
    GAPB(o[2]=__builtin_amdgcn_mfma_f32_32x32x16_bf16(PAF(3),VFR(3),o[2],0,0,0), C1,12); \
    GAPB(o[3]=__builtin_amdgcn_mfma_f32_32x32x16_bf16(PAF(3),VFR(7),o[3],0,0,0), C1,14); \
    }while(0)
  if(wid>=4)__builtin_amdgcn_s_setprio(1);
  int t=1;
  #undef CMASK
  #define CMASK(P0,P1,t) do{}while(0)
  for(;t+5<NT;t+=2){
    STEP(pB0,pB1,pA0,pA1,t,true,true,true);     WAIT_BAR(3); ROT();
    STEP(pA0,pA1,pB0,pB1,t+1,true,true,true);   WAIT_BAR(3); ROT();
  }
  #undef CMASK
  #define CMASK(P0,P1,t) CMASK_BAND(P0,P1,t)
  #define ENDW(tt) do{ if((tt)+3<NT){WAIT_BAR(3);} else if((tt)+2<NT){WAIT_BAR(2);} else {WAIT_BAR(0);} }while(0)
  for(;t+1<NT;t+=2){
    STEP(pB0,pB1,pA0,pA1,t,(t+3<NT),(t+1<NT),(t+1<NT));       ENDW(t);   ROT();
    STEP(pA0,pA1,pB0,pB1,t+1,(t+4<NT),(t+2<NT),(t+2<NT));     ENDW(t+1); ROT();
  }
  STEP(pB0,pB1,pA0,pA1,NT-1,false,false,false);
  { float sacc=pB0[0]+pB0[1]; _Pragma("unroll") for(int r=2;r<16;++r)sacc+=pB0[r]; _Pragma("unroll") for(int r=0;r<16;++r)sacc+=pB1[r]; l_reg+=sacc;
    pw0=(u32x4){PKW(pB0,0),PKW(pB0,2),PKW(pB0,4),PKW(pB0,6)};pw1=(u32x4){PKW(pB0,8),PKW(pB0,10),PKW(pB0,12),PKW(pB0,14)};pw2=(u32x4){PKW(pB1,0),PKW(pB1,2),PKW(pB1,4),PKW(pB1,6)};pw3=(u32x4){PKW(pB1,8),PKW(pB1,10),PKW(pB1,12),PKW(pB1,14)};
    SBAR(); pv4(o,vb0+2*sl_cur,PAF(0),PAF(1),PAF(2),PAF(3)); }
  #undef PKW
  #undef PAF
  #undef VFR
  #undef PIN
  #undef GAPA
  #undef GAPB
  #undef EX
  #undef EXS
  #undef VRD
  #undef KRD
  #undef STEP
  #undef ENDW
  __builtin_amdgcn_s_setprio(0);
  {auto rr=__builtin_amdgcn_permlane32_swap(__float_as_uint(l_reg),__float_as_uint(l_reg),false,false);l_reg=__uint_as_float(rr[0])+__uint_as_float(rr[1]);}
  if(hi==0)wsf[32+r32]=l_reg;asm volatile("s_waitcnt lgkmcnt(0)":::"memory");
  { float rli[16];
  #pragma unroll
  for(int r=0;r<16;++r)rli[r]=__builtin_amdgcn_rcpf(wsf[32+crow(r,hi)]);
  #pragma unroll
  for(int d0=0;d0<4;++d0)
    #pragma unroll
    for(int r=0;r<16;++r)o[d0][r]*=rli[r]; }
  u32x4*o2w=(u32x4*)(o2s+(size_t)wid*4096)+lane;
  if(mode==0){
    #pragma unroll
    for(int d0=0;d0<4;++d0)
      #pragma unroll
      for(int j=0;j<2;++j)o2w[(d0*2+j)*64]=(u32x4){cvtpk_s(o[d0][8*j],o[d0][8*j+1]),cvtpk_s(o[d0][8*j+2],o[d0][8*j+3]),cvtpk_s(o[d0][8*j+4],o[d0][8*j+5]),cvtpk_s(o[d0][8*j+6],o[d0][8*j+7])};
  } else {
    #pragma unroll
    for(int d0=0;d0<4;++d0)
      #pragma unroll
      for(int j=0;j<2;++j){ const u32x4 t=o2w[(d0*2+j)*64]; const unsigned tw[4]={t.x,t.y,t.z,t.w};
        #pragma unroll
        for(int e=0;e<4;++e){ o[d0][8*j+2*e]-=lam*__uint_as_float(tw[e]<<16); o[d0][8*j+2*e+1]-=lam*__uint_as_float(tw[e]&0xffff0000u); } }
    float sg[4];
    #pragma unroll
    for(int d0=0;d0<4;++d0)sg[d0]=subg[32*d0+r32]*gmul;
    #pragma unroll
    for(int r=0;r<16;++r){ float ss=(o[0][r]*o[0][r]+o[1][r]*o[1][r])+(o[2][r]*o[2][r]+o[3][r]*o[3][r]);
      ss+=__shfl_xor(ss,1);ss+=__shfl_xor(ss,2);ss+=__shfl_xor(ss,4);ss+=__shfl_xor(ss,8);ss+=__shfl_xor(ss,16);
      const float rs=__builtin_amdgcn_rsqf(ss*(1.0f/128.0f)+1e-6f);
      #pragma unroll
      for(int d0=0;d0<4;++d0)o[d0][r]*=rs*sg[d0]; }
    bf16*Ow=O+(rowbase+q0+wid*QBLK)*OP+ocol;
    bf16*stg=(bf16*)(shm+LDS_OST)+wid*2048;
    #pragma unroll
    for(int ps=0;ps<2;++ps){
      #pragma unroll
      for(int r=0;r<16;++r){const int orow=crow(r,hi);
        #pragma unroll
        for(int d0=0;d0<2;++d0)stg[orow*64+d0*32+r32]=__float2bfloat16(o[2*ps+d0][r]);}
      asm volatile("s_waitcnt lgkmcnt(0)":::"memory");
      #pragma unroll
      for(int i=0;i<4;++i){const int row=i*8+(lane>>3),ch=lane&7; const u32x4 v=*(const u32x4*)(stg+row*64+ch*8); ATTN_STORE16(Ow+(long)row*OP+ps*64+ch*8,v);}
      asm volatile("s_waitcnt lgkmcnt(0)":::"memory"); } }
  { typedef float f32x4a __attribute__((ext_vector_type(4)));
    #pragma unroll
    for(int i=0;i<4;++i){ const int gI=tid+512*i,row=gI>>3,c8=gI&7; const u32x4 w=*(const u32x4*)(Kh+(long)(q0+row)*DM+c8*8); float*dst=kout+(rowbase+q0+row)*DM+qcol+c8*8;
      *(f32x4a*)dst=(f32x4a){__uint_as_float(w.x<<16),__uint_as_float(w.x&0xffff0000u),__uint_as_float(w.y<<16),__uint_as_float(w.y&0xffff0000u)};
      *(f32x4a*)(dst+4)=(f32x4a){__uint_as_float(w.z<<16),__uint_as_float(w.z&0xffff0000u),__uint_as_float(w.w<<16),__uint_as_float(w.w&0xffff0000u)}; }
    { const int c8=tid&7; float cw0[8],cw1[8],cw2[8];
      #pragma unroll
      for(int e=0;e<8;++e){ cw0[e]=convw[qcol+c8*8+e]; cw1[e]=convw[1024+qcol+c8*8+e]; cw2[e]=convw[2048+qcol+c8*8+e]; }
      #pragma unroll
      for(int i=0;i<4;++i){ const int row=(tid+512*i)>>3, tt=q0+row; const long mrow=rowbase+tt; const u32x4 zz={0u,0u,0u,0u};
        const u32x4 a0=*(const u32x4*)(Uc+mrow*DM+qcol+c8*8), gw_=*(const u32x4*)(GBc+mrow*DM+qcol+c8*8);
        const u32x4 a1=tt>=1?*(const u32x4*)(Uc+(mrow-1)*DM+qcol+c8*8):zz, a2=tt>=2?*(const u32x4*)(Uc+(mrow-2)*DM+qcol+c8*8):zz;
        const unsigned w0_[4]={a0.x,a0.y,a0.z,a0.w},w1_[4]={a1.x,a1.y,a1.z,a1.w},w2_[4]={a2.x,a2.y,a2.z,a2.w},wg_[4]={gw_.x,gw_.y,gw_.z,gw_.w}; unsigned zo[4];
        #pragma unroll
        for(int j=0;j<4;++j){
          const float zl=__uint_as_float(wg_[j]<<16)*(cw0[2*j]*__uint_as_float(w2_[j]<<16)+cw1[2*j]*__uint_as_float(w1_[j]<<16)+cw2[2*j]*__uint_as_float(w0_[j]<<16));
          const float zh=__uint_as_float(wg_[j]&0xffff0000u)*(cw0[2*j+1]*__uint_as_float(w2_[j]&0xffff0000u)+cw1[2*j+1]*__uint_as_float(w1_[j]&0xffff0000u)+cw2[2*j+1]*__uint_as_float(w0_[j]&0xffff0000u));
          zo[j]=cvtpk_s(zl,zh); }
        *(u32x4*)(GBc+mrow*DM+qcol+c8*8)=(u32x4){zo[0],zo[1],zo[2],zo[3]}; } }
    if(mode==1){
      #pragma unroll
      for(int i=0;i<8;++i){ const int gI=tid+512*i,row=gI>>4,c8=gI&15; const u32x4 w=*(const u32x4*)(Vh+(long)(q0+row)*DM+c8*8); float*dst=vout+(rowbase+q0+row)*DM+vcol+c8*8;
        *(f32x4a*)dst=(f32x4a){__uint_as_float(w.x<<16),__uint_as_float(w.x&0xffff0000u),__uint_as_float(w.y<<16),__uint_as_float(w.y&0xffff0000u)};
        *(f32x4a*)(dst+4)=(f32x4a){__uint_as_float(w.z<<16),__uint_as_float(w.z&0xffff0000u),__uint_as_float(w.w<<16),__uint_as_float(w.w&0xffff0000u)}; } } }
  asm volatile("s_waitcnt lgkmcnt(0)\n\ts_barrier":::"memory");
  #undef DMA_K
  #undef DMA_V
  #undef CMASK
  #undef CMASK_BAND
  #undef ROT
}
#undef SBAR
#undef WAIT_BAR
}
#include <hip/hip_cooperative_groups.h>
namespace cg = cooperative_groups;
constexpr int NWAVES = 8;
constexpr int MP = pg8::MP, MS = pg8::MS, MT = pg8::MT, D = 1024, TP = 8192, TS = 32, PAST = 1024, NIN = 8192, FF = 2816, NGU = 2 * FF;
constexpr float LAM0 = 0.2f;
constexpr size_t MiB = 1u << 20;
constexpr size_t ROWB = (size_t)MT * D * 2;
constexpr size_t WS_MOD = 0;
constexpr size_t WS_WIN = 1 * MiB, WS_WAO = 17 * MiB, WS_WCO = 19 * MiB, WS_WOUT = 21 * MiB, WS_WGU = 23 * MiB, WS_WDN = 34 * MiB;
constexpr size_t WS_XN = 40 * MiB;
constexpr size_t WS_O12 = 40 * MiB;
constexpr size_t WS_T = WS_O12;
constexpr size_t WS_Q = WS_O12 + 2 * ROWB, WS_K = WS_Q + ROWB, WS_V = WS_K + ROWB, WS_U = WS_V + ROWB, WS_GB = WS_U + ROWB, WS_END = WS_GB + ROWB;
constexpr size_t WS_ON = WS_Q;
constexpr size_t WS_MX = WS_K;
constexpr size_t WS_X1B = WS_U;
constexpr size_t WS_XN2 = WS_V;
constexpr size_t WS_ACT = 40 * MiB;
static_assert(WS_ACT + (size_t)MT * FF * 2 <= WS_MX && WS_END <= 1024 * MiB, "d_ws map");
constexpr int LDS_BYTES = 147456;
constexpr size_t WS_BAR = 512 * 1024;
constexpr int XBAR_LDS_OFF = 147456 - 64;

#define GAS __attribute__((address_space(1)))
#define LAS __attribute__((address_space(3)))
typedef unsigned short bf16;
typedef unsigned v4u __attribute__((ext_vector_type(4)));
typedef unsigned v2u __attribute__((ext_vector_type(2)));
typedef float f32x4 __attribute__((ext_vector_type(4)));
#define LDS_WAIT() asm volatile("s_waitcnt lgkmcnt(0)" ::: "memory")
__device__ __forceinline__ unsigned f2bf(float f) { unsigned u = __builtin_bit_cast(unsigned, f); return (u + 0x7fffu + ((u >> 16) & 1u)) >> 16; }
__device__ __forceinline__ unsigned pk2(float lo, float hi) { return f2bf(lo) | (f2bf(hi) << 16); }
__device__ __forceinline__ float bflo(unsigned w) { return __uint_as_float(w << 16); }
__device__ __forceinline__ float bfhi(unsigned w) { return __uint_as_float(w & 0xffff0000u); }
__device__ __forceinline__ float bf1(bf16 b) { return __uint_as_float((unsigned)b << 16); }
__device__ __forceinline__ float wave_sum(float v) {
#pragma unroll
    for (int o = 1; o < 64; o <<= 1) v += __shfl_xor(v, o);
    return v;
}
__device__ __forceinline__ float wave_max(float v) {
#pragma unroll
    for (int o = 1; o < 64; o <<= 1) v = fmaxf(v, __shfl_xor(v, o));
    return v;
}

__device__ __forceinline__ void ld16(const bf16* p, float (&d)[16]) { const v4u* q = (const v4u*)p;
#pragma unroll
    for (int e = 0; e < 2; ++e) { const v4u a = q[e]; d[8 * e + 0] = bflo(a.x); d[8 * e + 1] = bfhi(a.x); d[8 * e + 2] = bflo(a.y); d[8 * e + 3] = bfhi(a.y); d[8 * e + 4] = bflo(a.z); d[8 * e + 5] = bfhi(a.z); d[8 * e + 6] = bflo(a.w); d[8 * e + 7] = bfhi(a.w); } }
__device__ __forceinline__ void ldf(const float* p, float (&d)[16]) { const f32x4* q = (const f32x4*)p;
#pragma unroll
    for (int e = 0; e < 4; ++e) { const f32x4 a = q[e]; d[4 * e] = a.x; d[4 * e + 1] = a.y; d[4 * e + 2] = a.z; d[4 * e + 3] = a.w; } }
struct Args {
    const float *x_prompt, *x_sample, *cache_k, *cache_v, *state_conv, *c_prompt, *c_sample, *w_ada, *b_ada, *norm1_g, *norm2_g, *w_in, *q_norm_g, *k_norm_g,
        *lq1, *lk1, *lq2, *lk2, *sub_g, *w_ao, *conv_w, *w_co, *w_out, *w_gu, *w_dn;
    float* out; unsigned char* ws;
};

__device__ __forceinline__ void transpose_item(const float* W, int K, int N, bf16* WT, int kb, int n0, int drow, LAS float* scr, int lane) {
    const int k0 = 64 * kb;
#pragma unroll 8
    for (int i = 0; i < 32; ++i) { const int kk = 2 * i + (lane >> 5); scr[kk * 33 + (lane & 31)] = W[(size_t)(k0 + kk) * N + n0 + (lane & 31)]; }
    LDS_WAIT(); asm volatile("" ::: "memory");
    const int c = lane & 7;
#pragma unroll
    for (int j = 0; j < 4; ++j) { const int n = (lane >> 3) + 8 * j; const LAS float* s = scr + (8 * c) * 33 + n;
        v4u o; o.x = pk2(s[0 * 33], s[1 * 33]); o.y = pk2(s[2 * 33], s[3 * 33]); o.z = pk2(s[4 * 33], s[5 * 33]); o.w = pk2(s[6 * 33], s[7 * 33]);
        *(GAS v4u*)(WT + (size_t)(drow + n) * K + k0 + 8 * c) = o; }
    LDS_WAIT(); asm volatile("" ::: "memory");
}
__device__ __forceinline__ int win_drow(int c0) {
    const int sect = c0 >> 10, cc = c0 & 1023;
    if (sect == 3) return 256 * (12 + (cc >> 7)) + (cc & 127);
    if (sect == 5) return 256 * (12 + (cc >> 7)) + 128 + (cc & 127);
    const int tile = (sect < 3 ? sect * 4 : sect == 4 ? 20 : sect == 6 ? 24 : 28) + (cc >> 8), sl = cc & 255;
    return 256 * tile + 128 * ((sl >> 5) & 1) + 32 * (sl >> 6);
}
__device__ __forceinline__ int wgu_drow(int c0) { const int ch = c0 < FF ? c0 : c0 - FF; return 256 * (ch >> 7) + (c0 < FF ? 0 : 128) + (ch & 127); }

__device__ __forceinline__ void norm_row(const float* xrow, const float* g, const float* shift, const float* scale, bf16* orow, int lane) {
    const GAS f32x4* xr = (const GAS f32x4*)xrow + lane;
    f32x4 v[4]; float s = 0.f;
#pragma unroll
    for (int j = 0; j < 4; ++j) { v[j] = xr[64 * j]; s += (v[j].x * v[j].x + v[j].y * v[j].y) + (v[j].z * v[j].z + v[j].w * v[j].w); }
    const float rstd = __builtin_amdgcn_rsqf(wave_sum(s) * (1.f / D) + pg8::RMS_EPS);
    GAS unsigned long long* o8 = (GAS unsigned long long*)orow + lane;
#pragma unroll
    for (int j = 0; j < 4; ++j) { const int c = 4 * (lane + 64 * j); const f32x4 gg = *(const f32x4*)(g + c), sh = *(const f32x4*)(shift + c), sc = *(const f32x4*)(scale + c);
        const f32x4 o = v[j] * rstd * gg * (sc + 1.0f) + sh;
        o8[64 * j] = (unsigned long long)pk2(o.x, o.y) | ((unsigned long long)pk2(o.z, o.w) << 32); }
}

__device__ __forceinline__ void norm_row_bf(const bf16* xrow, const float* g, const float* shift, const float* scale, bf16* orow, int lane) {
    float v[16]; float s = 0.f;
#pragma unroll
    for (int j = 0; j < 2; ++j) { const v4u w = *(const v4u*)(xrow + 512 * j + 8 * lane);
        v[8 * j + 0] = bflo(w.x); v[8 * j + 1] = bfhi(w.x); v[8 * j + 2] = bflo(w.y); v[8 * j + 3] = bfhi(w.y); v[8 * j + 4] = bflo(w.z); v[8 * j + 5] = bfhi(w.z); v[8 * j + 6] = bflo(w.w); v[8 * j + 7] = bfhi(w.w); }
#pragma unroll
    for (int i = 0; i < 16; ++i) s += v[i] * v[i];
    const float rstd = __builtin_amdgcn_rsqf(wave_sum(s) * (1.f / D) + pg8::RMS_EPS);
#pragma unroll
    for (int j = 0; j < 2; ++j) { const int c = 512 * j + 8 * lane; float o[8];
#pragma unroll
        for (int h = 0; h < 2; ++h) { const f32x4 gg = *(const f32x4*)(g + c + 4 * h), sh = *(const f32x4*)(shift + c + 4 * h), sc = *(const f32x4*)(scale + c + 4 * h);
            o[4 * h + 0] = v[8 * j + 4 * h + 0] * rstd * gg.x * (sc.x + 1.0f) + sh.x; o[4 * h + 1] = v[8 * j + 4 * h + 1] * rstd * gg.y * (sc.y + 1.0f) + sh.y;
            o[4 * h + 2] = v[8 * j + 4 * h + 2] * rstd * gg.z * (sc.z + 1.0f) + sh.z; o[4 * h + 3] = v[8 * j + 4 * h + 3] * rstd * gg.w * (sc.w + 1.0f) + sh.w; }
        v4u w; w.x = pk2(o[0], o[1]); w.y = pk2(o[2], o[3]); w.z = pk2(o[4], o[5]); w.w = pk2(o[6], o[7]); *(v4u*)(orow + c) = w; }
}
typedef short sbf16x8 __attribute__((ext_vector_type(8)));
typedef float sf32x16 __attribute__((ext_vector_type(16)));
__device__ __forceinline__ unsigned cvtpk2(float lo, float hi) { unsigned r; asm("v_cvt_pk_bf16_f32 %0, %1, %2" : "=v"(r) : "v"(lo), "v"(hi)); return r; }
__device__ __forceinline__ sbf16x8 pack_f8(f32x4 a, f32x4 b) { v4u w; w.x = cvtpk2(a.x, a.y); w.y = cvtpk2(a.z, a.w); w.z = cvtpk2(b.x, b.y); w.w = cvtpk2(b.z, b.w); return __builtin_bit_cast(sbf16x8, w); }
__device__ __forceinline__ int crow_(int r, int hi) { return (r & 3) + 8 * (r >> 2) + 4 * hi; }
__device__ __forceinline__ void sample_attn_item(const Args& A, LAS unsigned char* lds, int b, int h, int mm, int tid) {
    constexpr int SP = 1060, NK = PAST + TS;
    const bf16* Q = (const bf16*)(A.ws + WS_Q); const bf16* Kb = (const bf16*)(A.ws + WS_K); const bf16* Vb = (const bf16*)(A.ws + WS_V); bf16* O12 = (bf16*)(A.ws + WS_O12);
    LAS float* S = (LAS float*)lds;
    LAS float* linv = (LAS float*)(lds + 32 * SP * 4);
    const int lane = tid & 63, wave = __builtin_amdgcn_readfirstlane(tid >> 6), r32 = lane & 31, hi = lane >> 5;
    sbf16x8 qr[4];
#pragma unroll
    for (int d0 = 0; d0 < 4; ++d0) qr[d0] = *(const sbf16x8*)(Q + (size_t)(MP + b * TS + r32) * D + (h * 2 + mm) * 64 + d0 * 16 + hi * 8);
    for (int kb = wave; kb < NK / 32; kb += 8) {
        sbf16x8 kf[4];
        if (kb < PAST / 32) { const float* kp = A.cache_k + ((size_t)(b * PAST + kb * 32 + r32) * 8 + h) * 128 + mm * 64 + hi * 8;
#pragma unroll
            for (int d0 = 0; d0 < 4; ++d0) kf[d0] = pack_f8(*(const f32x4*)(kp + d0 * 16), *(const f32x4*)(kp + d0 * 16 + 4)); }
        else { const bf16* kp = Kb + (size_t)(MP + b * TS + r32) * D + (h * 2 + mm) * 64 + hi * 8;
#pragma unroll
            for (int d0 = 0; d0 < 4; ++d0) kf[d0] = *(const sbf16x8*)(kp + d0 * 16); }
        sf32x16 acc = sf32x16{};
#pragma unroll
        for (int d0 = 0; d0 < 4; ++d0) acc = __builtin_amdgcn_mfma_f32_32x32x16_bf16(kf[d0], qr[d0], acc, 0, 0, 0);
#pragma unroll
        for (int r = 0; r < 16; ++r) S[r32 * SP + kb * 32 + crow_(r, hi)] = acc[r];
    }
    __syncthreads();
#pragma unroll 1
    for (int ii = 0; ii < 4; ++ii) { const int i = 4 * wave + ii; LAS float* sr = S + i * SP;
        float mx = -INFINITY; for (int j = lane; j < NK; j += 64) mx = fmaxf(mx, sr[j]);
        mx = wave_max(mx); float sum = 0.f;
        for (int j = lane; j < NK; j += 64) { const float p = __builtin_amdgcn_exp2f(sr[j] - mx); sr[j] = p; sum += p; }
        sum = wave_sum(sum); if (lane == 0) linv[i] = 1.0f / sum; }
    __syncthreads();
    const int db = wave & 3, kh = wave >> 2;
    sf32x16 o = sf32x16{};
    for (int k2 = 33 * kh; k2 < 33 * kh + 33; ++k2) {
        const LAS f32x4* pp = (const LAS f32x4*)(S + r32 * SP + k2 * 16 + hi * 8);
        const sbf16x8 pa = pack_f8(pp[0], pp[1]);
        sbf16x8 vf;
        if (k2 < PAST / 16) { const float* vp = A.cache_v + ((size_t)(b * PAST + k2 * 16 + hi * 8) * 8 + h) * 128 + db * 32 + r32;
            f32x4 v0, v1; v0.x = vp[0]; v0.y = vp[1024]; v0.z = vp[2048]; v0.w = vp[3072]; v1.x = vp[4096]; v1.y = vp[5120]; v1.z = vp[6144]; v1.w = vp[7168];
            vf = pack_f8(v0, v1); }
        else { const bf16* vp = Vb + (size_t)(MP + b * TS + (k2 * 16 - PAST) + hi * 8) * D + h * 128 + db * 32 + r32;
            v4u w; w.x = (unsigned)vp[0] | ((unsigned)vp[1024] << 16); w.y = (unsigned)vp[2048] | ((unsigned)vp[3072] << 16); w.z = (unsigned)vp[4096] | ((unsigned)vp[5120] << 16); w.w = (unsigned)vp[6144] | ((unsigned)vp[7168] << 16);
            vf = __builtin_bit_cast(sbf16x8, w); }
        o = __builtin_amdgcn_mfma_f32_32x32x16_bf16(pa, vf, o, 0, 0, 0);
    }
    __syncthreads();
    LAS float* red = (LAS float*)lds;
    if (kh == 1) {
#pragma unroll
        for (int r = 0; r < 16; ++r) red[(db * 16 + r) * 64 + lane] = o[r]; }
    __syncthreads();
    if (kh == 0) {
#pragma unroll
        for (int r = 0; r < 16; ++r) { const int q = crow_(r, hi); const float v = (o[r] + red[(db * 16 + r) * 64 + lane]) * linv[q];
            O12[(size_t)(MP + b * TS + q) * 2048 + mm * 1024 + h * 128 + db * 32 + r32] = (bf16)f2bf(v); } }
    __syncthreads();
}

typedef float sf32x4 __attribute__((ext_vector_type(4)));
template <class F> __device__ __forceinline__ void small_gemm(const bf16* A, const bf16* Bt, int K, int vcu, int G, LAS unsigned char* lds, int tid, const F& f) {
    const int lane = tid & 63, wave = __builtin_amdgcn_readfirstlane(tid >> 6), fr = lane & 15, fq = lane >> 4, cb = wave & 3, kh = wave >> 2, K2 = K >> 1;
    for (int item = vcu; item < 256; item += G) {
        const int r0 = (item >> 4) * 16, c0 = (item & 15) * 64 + cb * 16;
        const bf16* ap = A + (size_t)(r0 + fr) * K + kh * K2 + fq * 8;
        const bf16* bp = Bt + (size_t)(c0 + fr) * K + kh * K2 + fq * 8;
        sf32x4 acc = {0.f, 0.f, 0.f, 0.f};
#pragma unroll 8
        for (int k = 0; k < K2; k += 32) acc = __builtin_amdgcn_mfma_f32_16x16x32_bf16(*(const sbf16x8*)(bp + k), *(const sbf16x8*)(ap + k), acc, 0, 0, 0);
        LAS sf32x4* red = (LAS sf32x4*)lds;
        if (kh == 1) red[cb * 64 + lane] = acc;
        __syncthreads();
        if (kh == 0) { acc += red[cb * 64 + lane]; f(MP + r0 + fr, c0 + 4 * fq, acc); }
        __syncthreads();
    }
}
__device__ __forceinline__ float sigm_(float x) { return __builtin_amdgcn_rcpf(1.0f + __builtin_amdgcn_exp2f(-1.4426950408889634f * x)); }
struct SmallGate0 { const bf16* G; float* T;
    __device__ __forceinline__ void operator()(int row, int col, sf32x4 acc) const { const size_t o = (size_t)row * 1024 + col; const v2u g = *(const v2u*)(G + o);
        sf32x4 s; s.x = sigm_(bflo(g.x)); s.y = sigm_(bfhi(g.x)); s.z = sigm_(bflo(g.y)); s.w = sigm_(bfhi(g.y)); *(sf32x4*)(T + o) = s * acc; } };
struct SmallGate1 { const bf16* G; const float* T; bf16* Mx;
    __device__ __forceinline__ void operator()(int row, int col, sf32x4 acc) const { const size_t o = (size_t)row * 1024 + col; const v2u g = *(const v2u*)(G + o);
        sf32x4 s; s.x = sigm_(bflo(g.x)); s.y = sigm_(bfhi(g.x)); s.z = sigm_(bflo(g.y)); s.w = sigm_(bfhi(g.y)); const sf32x4 v = *(const sf32x4*)(T + o) + s * acc;
        v2u w; w.x = pk2(v.x, v.y); w.y = pk2(v.z, v.w); *(v2u*)(Mx + o) = w; } };
template <bool FINAL> struct SmallRes { const float* xin; bf16* x1b; float* out; const float* gate;
    __device__ __forceinline__ void operator()(int row, int col, sf32x4 acc) const { const size_t o = (size_t)row * 1024 + col; const int mrow = 8 + ((row - MP) >> 5);
        const sf32x4 g = *(const sf32x4*)(gate + (size_t)mrow * 6144 + col);
        if constexpr (!FINAL) { const sf32x4 v = *(const sf32x4*)(xin + o) + g * acc; v2u w; w.x = pk2(v.x, v.y); w.y = pk2(v.z, v.w); *(v2u*)(x1b + o) = w; }
        else { const v2u w = *(const v2u*)(x1b + o); const sf32x4 b = {bflo(w.x), bfhi(w.x), bflo(w.y), bfhi(w.y)}; *(sf32x4*)(out + o) = b + g * acc; } } };

typedef const __attribute__((address_space(4))) Args* kargs_t;
#define XB_TMO      128
#define XB_XCNT(j)  (256  + 64 * (j))
#define XB_XSUB(j)  (1280 + 64 * (j))
#define XB_XGEN(j)  (2304 + 64 * (j))
#define XB_TOP      3328
#define XB_TOPGEN   3392
#define XCD_BAR_WORDS 3456
#define XB_SPIN_CAP (1u << 22)

__device__ __forceinline__ unsigned xb_ld(unsigned* p)              { return __hip_atomic_load(p, __ATOMIC_RELAXED, __HIP_MEMORY_SCOPE_AGENT); }
__device__ __forceinline__ unsigned xb_add(unsigned* p, unsigned v) { return __hip_atomic_fetch_add(p, v, __ATOMIC_RELAXED, __HIP_MEMORY_SCOPE_AGENT); }
__device__ __forceinline__ unsigned xb_xcc_id() { return (unsigned)__builtin_amdgcn_s_getreg((3 << 11) | 20) & 0xFu; }
#define XB_SPIN(cond, bar) do { unsigned _sp = 0; while (cond) { __builtin_amdgcn_s_sleep(1); \
    if ((++_sp & 255u) == 0u) { if (xb_ld(&(bar)[XB_TMO])) break; if (_sp > XB_SPIN_CAP) { atomicAdd(&(bar)[XB_TMO], 1u); break; } } } } while (0)

struct XcdBarrier {
    unsigned* bar; unsigned x;
    volatile LAS unsigned* st;
};

__device__ __forceinline__ XcdBarrier xcd_barrier_post(unsigned* bar, volatile LAS unsigned* st) {
    XcdBarrier b; b.bar = bar; b.x = xb_xcc_id(); b.st = st;
    if (threadIdx.x == 0) (void)xb_add(&bar[XB_XCNT(b.x)], 1u);
    return b;
}
__device__ __forceinline__ void xcd_barrier_complete(unsigned* bar, unsigned x, unsigned& nloc, unsigned& nx) {
    const unsigned G = gridDim.x * gridDim.y * gridDim.z;
    unsigned sum, cnt, mine, sp = 0u;
    for (;;) {
        sum = 0u; cnt = 0u; mine = 0u;
#pragma unroll
        for (unsigned j = 0; j < 16; ++j) { const unsigned c = xb_ld(&bar[XB_XCNT(j)]); sum += c; cnt += (c > 0u) ? 1u : 0u; mine = (j == x) ? c : mine; }
        if (sum == G) break;
        __builtin_amdgcn_s_sleep(1);
        if ((++sp & 255u) == 0u) { if (xb_ld(&bar[XB_TMO])) break; if (sp > XB_SPIN_CAP) { atomicAdd(&bar[XB_TMO], 1u); break; } }
    }
    nloc = mine > 0u ? mine : 1u; nx = cnt > 0u ? cnt : 1u;
}

__device__ __forceinline__ void xcd_barrier(const XcdBarrier& b) {
    asm volatile("s_waitcnt vmcnt(0)" ::: "memory");
    __syncthreads();
    if (threadIdx.x == 0) {
        unsigned* bar = b.bar;
        __builtin_amdgcn_s_waitcnt(0);
        unsigned nloc = b.st[0], nx = b.st[1];
        if (nloc == 0u) { xcd_barrier_complete(bar, b.x, nloc, nx); b.st[0] = nloc; b.st[1] = nx; }
        const unsigned old = xb_add(&bar[XB_XSUB(b.x)], 1u);
        const unsigned gen = old / nloc;
        if (old + 1u == (gen + 1u) * nloc) {
            __builtin_amdgcn_fence(__ATOMIC_RELEASE, "agent");
            asm volatile("s_waitcnt vmcnt(0)" ::: "memory");
            const unsigned og = xb_add(&bar[XB_TOP], 1u);
            const unsigned tg = og / nx;
            if (og + 1u == (tg + 1u) * nx) xb_add(&bar[XB_TOPGEN], 1u);
            else XB_SPIN(xb_ld(&bar[XB_TOPGEN]) == tg, bar);
            __builtin_amdgcn_fence(__ATOMIC_ACQUIRE, "agent");
            xb_add(&bar[XB_XGEN(b.x)], 1u);
            asm volatile("s_waitcnt vmcnt(0)" ::: "memory");
        } else {
            XB_SPIN(xb_ld(&bar[XB_XGEN(b.x)]) == gen, bar);
            __builtin_amdgcn_fence(__ATOMIC_ACQUIRE, "agent");
            asm volatile("s_waitcnt vmcnt(0)" ::: "memory");
        }
    }
    __syncthreads();
}

#define XBAR() do { XcdBarrier xb_; xb_.bar = (unsigned*)(((const Args*)(kargs_t)__builtin_amdgcn_kernarg_segment_ptr())->ws + WS_BAR); xb_.x = xb_xcc_id(); xb_.st = (volatile LAS unsigned*)((LAS unsigned char*)lds_raw + XBAR_LDS_OFF); xcd_barrier(xb_); } while (0)
#define PHASE_BEGIN() \
    kargs_t ap_ = (kargs_t)__builtin_amdgcn_kernarg_segment_ptr(); asm volatile("" : "+s"(ap_)); const Args& A = *(const Args*)ap_; \
    int tid_ = threadIdx.x; asm volatile("" : "+v"(tid_)); const int tid = tid_, lane = tid & 63, wave = __builtin_amdgcn_readfirstlane(tid >> 6); \
    int G_ = gridDim.x, bx_ = blockIdx.x; asm volatile("" : "+s"(G_), "+s"(bx_)); const int G = G_, bx = bx_, vcu = (G % 8 == 0) ? (bx % 8) * (G / 8) + bx / 8 : bx; \
    const int gw = vcu * NWAVES + wave, NGW = G * NWAVES; unsigned char* const ws = A.ws; float* const mod = (float*)(ws + WS_MOD); \
    LAS unsigned char* const lds = (LAS unsigned char*)lds_raw; (void)lane; (void)gw; (void)NGW; (void)mod; (void)lds; (void)tid; (void)vcu;
__global__ void __launch_bounds__(NWAVES * 64, 2) fwd_megakernel(Args A_unused) {
    extern __shared__ __attribute__((aligned(16))) unsigned char lds_raw[];
    cg::grid_group grid = cg::this_grid();
    { if (threadIdx.x < 2) ((LAS unsigned*)((LAS unsigned char*)lds_raw + XBAR_LDS_OFF))[threadIdx.x] = 0u; __syncthreads();
      (void)xcd_barrier_post((unsigned*)(((const Args*)(kargs_t)__builtin_amdgcn_kernarg_segment_ptr())->ws + WS_BAR), (volatile LAS unsigned*)((LAS unsigned char*)lds_raw + XBAR_LDS_OFF)); }
    {
    PHASE_BEGIN();
    {
        LAS float* cs = (LAS float*)lds;
        LAS float* part = (LAS float*)(lds + 65536);
        bool have_cs = false;
        for (int item = bx; item < 192; item += G) {
            if (!have_cs) { for (int idx = tid; idx < 16384; idx += 512) { const int r = idx >> 10, k = idx & 1023; const float c = r < 8 ? A.c_prompt[r * 1024 + k] : A.c_sample[(r - 8) * 1024 + k]; cs[idx] = c * pg8::sigm(c); } have_cs = true; }
            __syncthreads();
            const int n0 = item * 32, slice = tid >> 5, col = tid & 31; float acc[16];
#pragma unroll
            for (int r = 0; r < 16; ++r) acc[r] = 0.f;
#pragma unroll 4
            for (int kk = 0; kk < 64; ++kk) { const int k = slice * 64 + kk; const float w = A.w_ada[(size_t)k * 6144 + n0 + col];
#pragma unroll
                for (int r = 0; r < 16; ++r) acc[r] += cs[r * 1024 + k] * w; }
#pragma unroll
            for (int r = 0; r < 16; ++r) part[(slice * 16 + r) * 32 + col] = acc[r];
            __syncthreads();
            { const int r = tid >> 5; float s = A.b_ada[n0 + col];
#pragma unroll
                for (int sl = 0; sl < 16; ++sl) s += part[(sl * 16 + r) * 32 + col];
                mod[r * 6144 + n0 + col] = s; }
            __syncthreads();
        }
        __syncthreads();
        LAS float* scr = (LAS float*)(lds + wave * 16384);
        constexpr int I_IN = 16 * 256, I_SQ = 16 * 32, I_GU = 16 * 176, I_DN = 44 * 32, NITEMS = I_IN + 3 * I_SQ + I_GU + I_DN;
        for (int it = gw; it < NITEMS; it += NGW) {
            int r = it;
            if (r < I_IN) { const int kb = r / 256, nb = r % 256; transpose_item(A.w_in, D, NIN, (bf16*)(ws + WS_WIN), kb, 32 * nb, win_drow(32 * nb), scr, lane); continue; } r -= I_IN;
            if (r < I_SQ) { transpose_item(A.w_ao, D, D, (bf16*)(ws + WS_WAO), r / 32, 32 * (r % 32), 32 * (r % 32), scr, lane); continue; } r -= I_SQ;
            if (r < I_SQ) { transpose_item(A.w_co, D, D, (bf16*)(ws + WS_WCO), r / 32, 32 * (r % 32), 32 * (r % 32), scr, lane); continue; } r -= I_SQ;
            if (r < I_SQ) { transpose_item(A.w_out, D, D, (bf16*)(ws + WS_WOUT), r / 32, 32 * (r % 32), 32 * (r % 32), scr, lane); continue; } r -= I_SQ;
            if (r < I_GU) { const int kb = r / 176, nb = r % 176; transpose_item(A.w_gu, D, NGU, (bf16*)(ws + WS_WGU), kb, 32 * nb, wgu_drow(32 * nb), scr, lane); continue; } r -= I_GU;
            transpose_item(A.w_dn, FF, D, (bf16*)(ws + WS_WDN), r / 32, 32 * (r % 32), 32 * (r % 32), scr, lane);
        }
    }
    }
    if (__builtin_expect(((const Args*)(kargs_t)__builtin_amdgcn_kernarg_segment_ptr())->ws == nullptr, 0)) grid.sync();
    XBAR();
    {
    PHASE_BEGIN();
    constexpr int NS1 = NIN / 256;
    if (G > 2 * NS1 && vcu < NS1) {
        for (int m = MP + wave; m < MT; m += NWAVES) { const float* mr = mod + (size_t)(8 + ((m - MP) >> 5)) * 6144;
            norm_row(A.x_sample + (size_t)(m - MP) * D, A.norm1_g, mr, mr + 1024, (bf16*)(ws + WS_XN) + (size_t)m * D, lane); }
        asm volatile("s_waitcnt vmcnt(0)" ::: "memory"); __syncthreads();
        pg8::Gemm g{(const pg8::bf16_t*)(ws + WS_XN), (const pg8::bf16_t*)(ws + WS_WIN), MT, NIN, D}; pg8::SingleOrder S{MP / 256, vcu};
        pg8::EpiInProj E{(pg8::bf16_t*)(ws + WS_Q), (pg8::bf16_t*)(ws + WS_K), (pg8::bf16_t*)(ws + WS_V), (pg8::bf16_t*)(ws + WS_U), (pg8::bf16_t*)(ws + WS_GB),
                         (pg8::bf16_t*)(A.out), (pg8::bf16_t*)(A.out) + (size_t)MT * D, A.out, A.q_norm_g, A.k_norm_g};
        pg8::gemm_phase<pg8::EpiInProj, pg8::SingleOrder, true, true>(lds, g, S, E);
    } else {
        const bool split = G > 2 * NS1; const int w0 = split ? (vcu - NS1) * NWAVES + wave : gw, nw = split ? (G - NS1) * NWAVES : NGW, mend = split ? MP : MT;
        for (int m = w0; m < mend; m += nw) {
            const float* xr = m < MP ? A.x_prompt + (size_t)m * D : A.x_sample + (size_t)(m - MP) * D;
            const float* mr = mod + (size_t)(m < MP ? (m >> 13) : 8 + ((m - MP) >> 5)) * 6144;
            norm_row(xr, A.norm1_g, mr, mr + 1024, (bf16*)(ws + WS_XN) + (size_t)m * D, lane);
        }
    }
    }
    XBAR();
    {
    PHASE_BEGIN();
    {
        pg8::Gemm g{(const pg8::bf16_t*)(ws + WS_XN), (const pg8::bf16_t*)(ws + WS_WIN), MT, NIN, D}; pg8::StaticOrder S; S.init(G > 2 * (NIN / 256) ? MP : MT, NIN, G, bx);
        pg8::EpiInProj E{(pg8::bf16_t*)(ws + WS_Q), (pg8::bf16_t*)(ws + WS_K), (pg8::bf16_t*)(ws + WS_V), (pg8::bf16_t*)(ws + WS_U), (pg8::bf16_t*)(ws + WS_GB),
                         (pg8::bf16_t*)(A.out), (pg8::bf16_t*)(A.out) + (size_t)MT * D, A.out, A.q_norm_g, A.k_norm_g};
        pg8::gemm_phase<pg8::EpiInProj, pg8::StaticOrder, true, true>(lds, g, S, E);
    }
    }
    XBAR();
    {
    PHASE_BEGIN();
    {
        const attn2::bf16* Qp = (const attn2::bf16*)(ws + WS_Q); const attn2::bf16* Kp = (const attn2::bf16*)(ws + WS_K); const attn2::bf16* Vp = (const attn2::bf16*)(ws + WS_V);
        attn2::bf16* Op = (attn2::bf16*)(ws + WS_ON);
        float* o2s = (float*)(ws + WS_O12) + (size_t)vcu * 32768;
        const float mq = wave_max(fabsf(A.q_norm_g[lane])), mk = wave_max(fabsf(A.k_norm_g[lane]));
        const float mshift = __uint_as_float(__builtin_amdgcn_readfirstlane(__float_as_uint(fmaxf(0.f, 64.f * pg8::QK_C2 * mq * mk * 1.02f - 64.f))));
        const float lam = __uint_as_float(__builtin_amdgcn_readfirstlane(__float_as_uint(__expf(wave_sum(A.lq1[lane] * A.lk1[lane])) - __expf(wave_sum(A.lq2[lane] * A.lk2[lane])) + LAM0)));
        const float* subg = A.sub_g;
        float* const kout = A.out + pg8::O_KP; float* const vout = A.out + pg8::O_VP;
        const attn2::bf16* Ucp = (const attn2::bf16*)(ws + WS_U); attn2::bf16* GBcp = (attn2::bf16*)(ws + WS_GB);
#define ATTN_RUN(SH) do { \
        if (G == 256) { const int b = vcu >> 5, lc = vcu & 31, g2 = lc >> 4, s = lc & 15; \
            for (int u = 0; u < 16; ++u) { const int h = 2 * (u >> 2) + g2, mm = 1 - (u & 1), qb = (u & 2) ? 31 - s : s; \
                attn2::attn_unit<SH, 1024>(b, (h * 2 + mm) * 64, h * 128, h * 128, qb, mshift, mm == 0, lam, subg, 1.0f - LAM0, o2s, kout, vout, Ucp, GBcp, A.conv_w, Qp, Kp, Vp, Op, (char*)lds_raw); } \
        } else { \
            for (int it = vcu; it < 8 * 8 * 32; it += G) { const int b = it >> 8, h = (it >> 5) & 7, qb = it & 31; \
                for (int mm = 1; mm >= 0; --mm) \
                    attn2::attn_unit<SH, 1024>(b, (h * 2 + mm) * 64, h * 128, h * 128, qb, mshift, mm == 0, lam, subg, 1.0f - LAM0, o2s, kout, vout, Ucp, GBcp, A.conv_w, Qp, Kp, Vp, Op, (char*)lds_raw); } \
        } } while (0)
        if (mshift == 0.f) ATTN_RUN(false); else ATTN_RUN(true);
#undef ATTN_RUN
        asm volatile("s_waitcnt vmcnt(0) lgkmcnt(0)" ::: "memory"); __syncthreads();
        for (int it = (G - 1 - vcu); it < 128; it += G) sample_attn_item(A, lds, it >> 4, (it >> 1) & 7, it & 1, tid);
    }
    }
    XBAR();
    {
    PHASE_BEGIN();
    {
        float lam;
        { const float p1 = lane < 64 ? A.lq1[lane] * A.lk1[lane] : 0.f, p2 = A.lq2[lane] * A.lk2[lane]; lam = __expf(wave_sum(p1)) - __expf(wave_sum(p2)) + LAM0; }
        const bf16* O12 = (const bf16*)(ws + WS_O12); bf16* ON = (bf16*)(ws + WS_ON); const bf16* U = (const bf16*)(ws + WS_U); bf16* GBp = (bf16*)(ws + WS_GB);
        const int c16 = 16 * lane;
        float sg[16], w0[16], w1[16], w2[16];
#pragma unroll
        for (int i = 0; i < 16; ++i) { sg[i] = A.sub_g[(c16 + i) & 127] * (1.0f - LAM0); w0[i] = A.conv_w[c16 + i]; w1[i] = A.conv_w[1024 + c16 + i]; w2[i] = A.conv_w[2048 + c16 + i]; }
        for (int m = MP + gw; m < MT; m += NGW) {
            if (m >= MP) { const v4u* p1 = (const v4u*)(O12 + (size_t)m * 2048 + c16); const v4u* p2 = (const v4u*)(O12 + (size_t)m * 2048 + 1024 + c16);
              float o[16]; float ss = 0.f;
#pragma unroll
              for (int e = 0; e < 2; ++e) { const v4u a = p1[e], c = p2[e];
                  o[8 * e + 0] = bflo(a.x) - lam * bflo(c.x); o[8 * e + 1] = bfhi(a.x) - lam * bfhi(c.x); o[8 * e + 2] = bflo(a.y) - lam * bflo(c.y); o[8 * e + 3] = bfhi(a.y) - lam * bfhi(c.y);
                  o[8 * e + 4] = bflo(a.z) - lam * bflo(c.z); o[8 * e + 5] = bfhi(a.z) - lam * bfhi(c.z); o[8 * e + 6] = bflo(a.w) - lam * bflo(c.w); o[8 * e + 7] = bfhi(a.w) - lam * bfhi(c.w); }
#pragma unroll
              for (int i = 0; i < 16; ++i) ss += o[i] * o[i];
              ss += __shfl_xor(ss, 1); ss += __shfl_xor(ss, 2); ss += __shfl_xor(ss, 4);
              const float rstd = __builtin_amdgcn_rsqf(ss * (1.0f / 128.0f) + pg8::RMS_EPS);
              v4u w[2];
#pragma unroll
              for (int e = 0; e < 2; ++e) { w[e].x = pk2(o[8 * e + 0] * rstd * sg[8 * e + 0], o[8 * e + 1] * rstd * sg[8 * e + 1]); w[e].y = pk2(o[8 * e + 2] * rstd * sg[8 * e + 2], o[8 * e + 3] * rstd * sg[8 * e + 3]);
                  w[e].z = pk2(o[8 * e + 4] * rstd * sg[8 * e + 4], o[8 * e + 5] * rstd * sg[8 * e + 5]); w[e].w = pk2(o[8 * e + 6] * rstd * sg[8 * e + 6], o[8 * e + 7] * rstd * sg[8 * e + 7]); }
              v4u* po = (v4u*)(ON + (size_t)m * D + c16); po[0] = w[0]; po[1] = w[1]; }
            { const bool smp = m >= MP; const int t = smp ? ((m - MP) & 31) : (m & 8191); const int sb = (m - MP) >> 5;
              float u0[16], u1[16], u2[16], gbv[16];
              ld16(U + (size_t)m * D + c16, u0); ld16(GBp + (size_t)m * D + c16, gbv);
              if (t >= 1) ld16(U + (size_t)(m - 1) * D + c16, u1);
              else if (smp) ldf(A.state_conv + (size_t)(sb * 2 + 1) * 1024 + c16, u1);
              else {
#pragma unroll
                  for (int i = 0; i < 16; ++i) u1[i] = 0.f; }
              if (t >= 2) ld16(U + (size_t)(m - 2) * D + c16, u2);
              else if (smp) ldf(A.state_conv + (size_t)(sb * 2 + t) * 1024 + c16, u2);
              else {
#pragma unroll
                  for (int i = 0; i < 16; ++i) u2[i] = 0.f; }
              v4u w[2]; float z[16];
#pragma unroll
              for (int i = 0; i < 16; ++i) z[i] = gbv[i] * (w0[i] * u2[i] + w1[i] * u1[i] + w2[i] * u0[i]);
#pragma unroll
              for (int e = 0; e < 2; ++e) { w[e].x = pk2(z[8 * e + 0], z[8 * e + 1]); w[e].y = pk2(z[8 * e + 2], z[8 * e + 3]); w[e].z = pk2(z[8 * e + 4], z[8 * e + 5]); w[e].w = pk2(z[8 * e + 6], z[8 * e + 7]); }
              v4u* po = (v4u*)(GBp + (size_t)m * D + c16); po[0] = w[0]; po[1] = w[1]; }
        }
    }
    }
    XBAR();
    {
    PHASE_BEGIN();
    {
        { pg8::PairOrder S; S.base.init(MP, D, G, bx);
          pg8::Gemm g{(const pg8::bf16_t*)(ws + WS_ON), (const pg8::bf16_t*)(ws + WS_WAO), MP, D, D, (const pg8::bf16_t*)(ws + WS_GB), (const pg8::bf16_t*)(ws + WS_WCO)};
          pg8::EpiGatePair E{(const pg8::bf16_t*)(A.out), (const pg8::bf16_t*)(A.out) + (size_t)MT * D, (pg8::bf16_t*)(ws + WS_MX)};
          pg8::gemm_phase<pg8::EpiGatePair, pg8::PairOrder, true, true>(lds, g, S, E); }
        small_gemm((const bf16*)(ws + WS_ON) + (size_t)MP * D, (const bf16*)(ws + WS_WAO), D, vcu, G, lds, tid, SmallGate0{(const bf16*)(A.out), (float*)(ws + WS_T)});
        small_gemm((const bf16*)(ws + WS_GB) + (size_t)MP * D, (const bf16*)(ws + WS_WCO), D, vcu, G, lds, tid, SmallGate1{(const bf16*)(A.out) + (size_t)MT * D, (const float*)(ws + WS_T), (bf16*)(ws + WS_MX)});
    }
    }
    XBAR();
    {
    PHASE_BEGIN();
    {
        pg8::Gemm g{(const pg8::bf16_t*)(ws + WS_MX), (const pg8::bf16_t*)(ws + WS_WOUT), MP, D, D}; pg8::StaticOrder S; S.init(MP, D, G, bx);
        pg8::EpiRes<false> E{A.x_prompt, (pg8::bf16_t*)(ws + WS_X1B), nullptr, mod + 2 * 1024};
        pg8::gemm_phase<pg8::EpiRes<false>, pg8::StaticOrder, true, true>(lds, g, S, E);
        small_gemm((const bf16*)(ws + WS_MX) + (size_t)MP * D, (const bf16*)(ws + WS_WOUT), D, vcu, G, lds, tid, SmallRes<false>{A.x_sample - (size_t)MP * D, (bf16*)(ws + WS_X1B), nullptr, mod + 2 * 1024});
    }
    }
    XBAR();
    {
    PHASE_BEGIN();
    constexpr int NS5 = NGU / 256;
    if (G > 2 * NS5 && vcu < NS5) {
        for (int m = MP + wave; m < MT; m += NWAVES) { const float* mr = mod + (size_t)(8 + ((m - MP) >> 5)) * 6144;
            norm_row_bf(((const bf16*)(ws + WS_X1B)) + (size_t)m * D, A.norm2_g, mr + 3 * 1024, mr + 4 * 1024, (bf16*)(ws + WS_XN2) + (size_t)m * D, lane); }
        asm volatile("s_waitcnt vmcnt(0)" ::: "memory"); __syncthreads();
        pg8::Gemm g{(const pg8::bf16_t*)(ws + WS_XN2), (const pg8::bf16_t*)(ws + WS_WGU), MT, NGU, D}; pg8::SingleOrder S{MP / 256, vcu};
        pg8::EpiSwiglu E{(pg8::bf16_t*)(ws + WS_ACT)};
        pg8::gemm_phase<pg8::EpiSwiglu, pg8::SingleOrder, true, true>(lds, g, S, E);
    } else {
        const bool split = G > 2 * NS5; const int w0 = split ? (vcu - NS5) * NWAVES + wave : gw, nw = split ? (G - NS5) * NWAVES : NGW, mend = split ? MP : MT;
        for (int m = w0; m < mend; m += nw) {
            const float* mr = mod + (size_t)(m < MP ? (m >> 13) : 8 + ((m - MP) >> 5)) * 6144;
            norm_row_bf(((const bf16*)(ws + WS_X1B)) + (size_t)m * D, A.norm2_g, mr + 3 * 1024, mr + 4 * 1024, (bf16*)(ws + WS_XN2) + (size_t)m * D, lane);
        }
    }
    }
    XBAR();
    {
    PHASE_BEGIN();
    {
        pg8::Gemm g{(const pg8::bf16_t*)(ws + WS_XN2), (const pg8::bf16_t*)(ws + WS_WGU), MT, NGU, D}; pg8::StaticOrder S; S.init(G > 2 * (NGU / 256) ? MP : MT, NGU, G, bx);
        pg8::EpiSwiglu E{(pg8::bf16_t*)(ws + WS_ACT)};
        pg8::gemm_phase<pg8::EpiSwiglu, pg8::StaticOrder, true, true>(lds, g, S, E);
    }
    }
    XBAR();
    {
    PHASE_BEGIN();
    {
        pg8::Gemm g{(const pg8::bf16_t*)(ws + WS_ACT), (const pg8::bf16_t*)(ws + WS_WDN), MP, D, FF}; pg8::StaticOrder S; S.init(MP, D, G, bx);
        pg8::EpiRes<true> E{nullptr, (pg8::bf16_t*)(ws + WS_X1B), A.out, mod + 5 * 1024};
        pg8::gemm_phase<pg8::EpiRes<true>, pg8::StaticOrder, true, true>(lds, g, S, E);
        small_gemm((const bf16*)(ws + WS_ACT) + (size_t)MP * FF, (const bf16*)(ws + WS_WDN), FF, vcu, G, lds, tid, SmallRes<true>{nullptr, (bf16*)(ws + WS_X1B), A.out, mod + 5 * 1024});
    }
    }
}

extern "C" void kernel_launch(void* const* d_in, const int* in_sizes, int n_in, void* d_out, int out_size, void* d_ws, size_t ws_size, hipStream_t stream) {
    static int grid = 0;
    if (grid == 0) {
        if (n_in != 25 || (size_t)out_size != pg8::O_END || ws_size < WS_END) { fprintf(stderr, "kernel_launch: unexpected shapes: n_in %d out %d ws %zu\n", n_in, out_size, ws_size); grid = -1; return; }
        int dev = 0, cus = 0, per_cu = 0;
        hipGetDevice(&dev); hipDeviceGetAttribute(&cus, hipDeviceAttributeMultiprocessorCount, dev);
        if (hipFuncSetAttribute((const void*)fwd_megakernel, hipFuncAttributeMaxDynamicSharedMemorySize, LDS_BYTES) != hipSuccess) { fprintf(stderr, "kernel_launch: hipFuncSetAttribute failed\n"); grid = -1; return; }
        if (hipOccupancyMaxActiveBlocksPerMultiprocessor(&per_cu, (const void*)fwd_megakernel, NWAVES * 64, LDS_BYTES) != hipSuccess || per_cu < 1) { fprintf(stderr, "kernel_launch: occupancy query gave %d\n", per_cu); per_cu = 1; }
        (void)hipGetLastError();
        grid = cus * 1;
    }
    if (grid < 0) return;
    Args a{};
    const float** f = (const float**)&a;
    for (int i = 0; i < 25; ++i) f[i] = (const float*)d_in[i];
    a.out = (float*)d_out; a.ws = (unsigned char*)d_ws;
    if (hipMemsetAsync((char*)d_ws + WS_BAR, 0, 16384, stream) != hipSuccess) { fprintf(stderr, "kernel_launch: hipMemsetAsync failed\n"); return; }
    void* args[] = {&a};
    hipError_t e = hipLaunchCooperativeKernel((const void*)fwd_megakernel, dim3(grid), dim3(NWAVES * 64), args, LDS_BYTES, stream);
    if (e != hipSuccess) fprintf(stderr, "cooperative launch failed: %s (grid %d)\n", hipGetErrorString(e), grid);
}
```
